# Optimizing an MI355X kernel written in HIP

```python
import math
import jax, jax.numpy as jnp
from jax import lax
import numpy as np

D_MODEL = 1024
BATCH = 2
SEQ = 8192
DEPTH = 1

Q_BLOCK = 128
DA_HEADS = 4
DA_DIM = 64
NSA_HEADS = 8
NSA_GROUPS = 2
NSA_DIM = 64
NSA_CMP_BLOCK = 32
NSA_SEL_BLOCK = 64
NSA_TOPN = 16
NSA_WINDOW = 512
NSA_CMP_HIDDEN = 256
MEM_LEN = 256
CA_HEADS = 4
CA_DIM = 128
PEER_HEADS = 8
PEER_NKEYS = 128
PEER_EXPERTS = PEER_NKEYS * PEER_NKEYS
PEER_DKEY = 256
PEER_TOPK = 16
PEER_CHUNK = 128

DA_QK = DA_HEADS * 2 * DA_DIM
DA_V = DA_HEADS * 2 * DA_DIM
NSA_Q = NSA_HEADS * NSA_DIM
NSA_KV = 6 * NSA_GROUPS * NSA_DIM
NSA_G = NSA_HEADS * 3
IN_SIZES = (DA_QK, DA_QK, DA_V, NSA_Q, NSA_KV, NSA_G, D_MODEL, D_MODEL)
IN_TOTAL = DA_QK * 2 + DA_V + NSA_Q + NSA_KV + NSA_G + 2 * D_MODEL

kernel_name = "hybrid_diffattn_nsa_peer_block"


def rms_norm(x, g, eps=1e-6):
    xf = x.astype(jnp.float32)
    y = xf * lax.rsqrt(jnp.mean(xf * xf, axis=-1, keepdims=True) + eps)
    return (y * g.astype(jnp.float32)).astype(x.dtype)


def alibi_slopes(n_heads):
    return 2.0 ** (-8.0 * jnp.arange(1, n_heads + 1, dtype=jnp.float32) / n_heads)


def diff_attention(q, k, v, lam_params, subln_g, lambda_init):
    B, S, H, _, d = q.shape
    nqb = S // Q_BLOCK
    lam = (jnp.exp(jnp.sum(lam_params[0] * lam_params[1]).astype(jnp.float32))
           - jnp.exp(jnp.sum(lam_params[2] * lam_params[3]).astype(jnp.float32)) + lambda_init)
    slopes = alibi_slopes(H)
    scale = d ** -0.5
    kpos = jnp.arange(S)
    qb = q.reshape(B, nqb, Q_BLOCK, H, 2, d).transpose(1, 0, 2, 3, 4, 5)

    def block(args):
        qi, i = args
        qpos = i * Q_BLOCK + jnp.arange(Q_BLOCK)
        dist = (qpos[:, None] - kpos[None, :]).astype(jnp.float32)
        s = jnp.einsum('bqhcd,bkhcd->bhcqk', qi, k).astype(jnp.float32) * scale
        s = s - slopes[None, :, None, None, None] * dist
        s = jnp.where(dist >= 0, s, -jnp.inf)
        p = jax.nn.softmax(s, axis=-1)
        a = p[:, :, 0] - lam * p[:, :, 1]
        return jnp.einsum('bhqk,bkhe->bqhe', a.astype(v.dtype), v)

    o = lax.map(block, (qb, jnp.arange(nqb)))
    o = o.transpose(1, 0, 2, 3, 4).reshape(B, S, H, 2 * d)
    o = rms_norm(o, subln_g) * (1.0 - lambda_init)
    return o.reshape(B, S, H * 2 * d)


def nsa_attention(q, kv, gates, cmp_pos, ck_w1, ck_w2, cv_w1, cv_w2):
    B, S, G, R, dh = q.shape
    slopes = alibi_slopes(G * R).reshape(G, R)
    scale = dh ** -0.5
    pos = jnp.arange(S)
    k_c, v_c, k_s, v_s, k_w, v_w = [kv[:, :, j] for j in range(6)]

    nc = S // NSA_CMP_BLOCK

    def compress(t, w1, w2):
        tb = t.reshape(B, nc, NSA_CMP_BLOCK, G, dh) + cmp_pos[None, None, :, None, :]
        tb = tb.transpose(0, 1, 3, 2, 4).reshape(B, nc, G, NSA_CMP_BLOCK * dh)
        return jax.nn.gelu(tb @ w1, approximate=False) @ w2

    kc = compress(k_c, ck_w1, ck_w2)
    vc = compress(v_c, cv_w1, cv_w2)
    cpos = jnp.arange(nc) * NSA_CMP_BLOCK + (NSA_CMP_BLOCK - 1)
    dist_c = (pos[:, None] - cpos[None, :]).astype(jnp.float32)
    valid_c = dist_c >= 0
    s = jnp.einsum('bsgrd,bcgd->bgrsc', q, kc).astype(jnp.float32) * scale
    s = s - slopes[None, :, :, None, None] * dist_c
    s = jnp.where(valid_c, s, -1e30)
    p_cmp = jax.nn.softmax(s, axis=-1) * valid_c
    o_cmp = jnp.einsum('bgrsc,bcgd->bsgrd', p_cmp.astype(vc.dtype), vc)

    nsb = S // NSA_SEL_BLOCK
    ratio = NSA_SEL_BLOCK // NSA_CMP_BLOCK
    p_slc = p_cmp.sum(axis=2).reshape(B, G, S, nsb, ratio).sum(-1)
    blk = jnp.arange(nsb)
    cur = pos // NSA_SEL_BLOCK
    valid_b = blk[None, :] <= cur[:, None]
    forced = (blk[None, :] == 0) | (blk[None, :] == cur[:, None]) | (blk[None, :] == cur[:, None] - 1)
    score = jnp.where(forced, 1e4, jnp.where(valid_b, p_slc, -1e9))
    n_sel = min(NSA_TOPN, nsb)
    _, idx = lax.top_k(score, n_sel)

    nqb = S // Q_BLOCK
    ksb = k_s.reshape(B, nsb, NSA_SEL_BLOCK, G, dh).transpose(0, 3, 1, 2, 4)
    vsb = v_s.reshape(B, nsb, NSA_SEL_BLOCK, G, dh).transpose(0, 3, 1, 2, 4)
    q_blocks = q.reshape(B, nqb, Q_BLOCK, G, R, dh).transpose(1, 0, 2, 3, 4, 5)
    idx_blocks = idx.reshape(B, G, nqb, Q_BLOCK, n_sel).transpose(2, 0, 1, 3, 4)
    b_ix = jnp.arange(B)[:, None, None, None]
    g_ix = jnp.arange(G)[None, :, None, None]
    off = jnp.arange(NSA_SEL_BLOCK)

    def sel_block(args):
        qi, ii, i = args
        kg = ksb[b_ix, g_ix, ii]
        vg = vsb[b_ix, g_ix, ii]
        qpos = i * Q_BLOCK + jnp.arange(Q_BLOCK)
        kpos = ii[..., None] * NSA_SEL_BLOCK + off
        dist = (qpos[None, None, :, None, None] - kpos).astype(jnp.float32)[:, :, None]
        ss = jnp.einsum('bqgrd,bgqnld->bgrqnl', qi, kg).astype(jnp.float32) * scale
        ss = ss - slopes[None, :, :, None, None, None] * dist
        ss = jnp.where(dist >= 0, ss, -jnp.inf)
        pp = jax.nn.softmax(ss.reshape(B, G, R, Q_BLOCK, n_sel * NSA_SEL_BLOCK), axis=-1)
        pp = pp.reshape(B, G, R, Q_BLOCK, n_sel, NSA_SEL_BLOCK).astype(vg.dtype)
        return jnp.einsum('bgrqnl,bgqnld->bqgrd', pp, vg)

    o_slc = lax.map(sel_block, (q_blocks, idx_blocks, jnp.arange(nqb)))
    o_slc = o_slc.transpose(1, 0, 2, 3, 4, 5).reshape(B, S, G, R, dh)

    wb = NSA_WINDOW // Q_BLOCK
    pad = jnp.zeros((B, NSA_WINDOW, G, dh), k_w.dtype)
    kwp = jnp.concatenate([pad, k_w], axis=1).reshape(B, nqb + wb, Q_BLOCK, G, dh)
    vwp = jnp.concatenate([pad, v_w], axis=1).reshape(B, nqb + wb, Q_BLOCK, G, dh)
    kwin = jnp.concatenate([kwp[:, j:j + nqb] for j in range(wb + 1)], axis=2)
    vwin = jnp.concatenate([vwp[:, j:j + nqb] for j in range(wb + 1)], axis=2)
    qblk = q.reshape(B, nqb, Q_BLOCK, G, R, dh)
    qpos = jnp.arange(nqb)[:, None] * Q_BLOCK + jnp.arange(Q_BLOCK)
    kpos = jnp.arange(nqb)[:, None] * Q_BLOCK - NSA_WINDOW + jnp.arange((wb + 1) * Q_BLOCK)
    dist = (qpos[:, :, None] - kpos[:, None, :]).astype(jnp.float32)
    valid = (dist >= 0) & (dist < NSA_WINDOW) & (kpos[:, None, :] >= 0)
    sw = jnp.einsum('bnqgrd,bnkgd->bngrqk', qblk, kwin).astype(jnp.float32) * scale
    sw = sw - slopes[None, None, :, :, None, None] * dist[None, :, None, None]
    sw = jnp.where(valid[None, :, None, None], sw, -jnp.inf)
    pw = jax.nn.softmax(sw, axis=-1).astype(vwin.dtype)
    o_win = jnp.einsum('bngrqk,bnkgd->bnqgrd', pw, vwin).reshape(B, S, G, R, dh)

    o = gates[..., 0:1] * o_cmp + gates[..., 1:2] * o_slc + gates[..., 2:3] * o_win
    return o.reshape(B, S, G * R * dh)


def memory_cross_attention(u, m, wq, wkv, wo):
    B, S, _ = u.shape
    M = m.shape[1]
    q = (u @ wq).reshape(B, S, CA_HEADS, CA_DIM)
    kv = (m @ wkv).reshape(B, M, 2, CA_HEADS, CA_DIM)
    s = jnp.einsum('bshd,bmhd->bhsm', q, kv[:, :, 0]).astype(jnp.float32) * (CA_DIM ** -0.5)
    p = jax.nn.softmax(s, axis=-1).astype(u.dtype)
    o = jnp.einsum('bhsm,bmhd->bshd', p, kv[:, :, 1]).reshape(B, S, CA_HEADS * CA_DIM)
    return o @ wo


def peer_ffn(u, w_q, sub_keys, u_tab, v_tab):
    B, S, D = u.shape
    T = B * S
    K = PEER_TOPK
    H = PEER_HEADS
    xt = u.reshape(T, D)
    q = (xt @ w_q).reshape(T, H, 2, PEER_DKEY // 2)
    s = jnp.einsum('thcd,hcnd->thcn', q, sub_keys).astype(jnp.float32)
    top_s, top_i = lax.top_k(s, K)
    cand = (top_s[:, :, 0, :, None] + top_s[:, :, 1, None, :]).reshape(T, H, K * K)
    cand_i = (top_i[:, :, 0, :, None] * PEER_NKEYS + top_i[:, :, 1, None, :]).reshape(T, H, K * K)
    best_s, best_j = lax.top_k(cand, K)
    expert = jnp.take_along_axis(cand_i, best_j, axis=-1)
    g = jax.nn.softmax(best_s, axis=-1).astype(u.dtype)
    nch = T // PEER_CHUNK

    def chunk(args):
        xc, ec, gc = args
        act = jax.nn.gelu(jnp.einsum('cd,chkd->chk', xc, u_tab[ec]), approximate=False)
        return jnp.einsum('chk,chkd->cd', gc * act, v_tab[ec])

    out = lax.map(chunk, (xt.reshape(nch, PEER_CHUNK, D),
                          expert.reshape(nch, PEER_CHUNK, H, K),
                          g.reshape(nch, PEER_CHUNK, H, K)))
    return out.reshape(B, S, D)


def setup_inputs(seed: int = 0) -> dict:
    key = jax.random.key(seed)
    ks = jax.random.split(key, 32)
    L, D = DEPTH, D_MODEL

    def nrm(k, shape, scale):
        return jax.random.normal(k, shape, jnp.float32) * scale

    def gain(k, shape):
        return 1.0 + 0.02 * jax.random.normal(k, shape, jnp.float32)

    return {
        "x": nrm(ks[0], (BATCH, SEQ, D), 1.0),
        "mem": nrm(ks[1], (BATCH, MEM_LEN, D), 1.0),
        "norm_mix": gain(ks[2], (L, D)),
        "w_in": nrm(ks[3], (L, D, IN_TOTAL), D ** -0.5),
        "diff_lambda": nrm(ks[4], (L, 4, DA_DIM), 0.1),
        "diff_subln": gain(ks[5], (L, 2 * DA_DIM)),
        "nsa_cmp_pos": nrm(ks[6], (L, NSA_CMP_BLOCK, NSA_DIM), 0.1),
        "nsa_ck_w1": nrm(ks[7], (L, NSA_CMP_BLOCK * NSA_DIM, NSA_CMP_HIDDEN), (NSA_CMP_BLOCK * NSA_DIM) ** -0.5),
        "nsa_ck_w2": nrm(ks[8], (L, NSA_CMP_HIDDEN, NSA_DIM), NSA_CMP_HIDDEN ** -0.5),
        "nsa_cv_w1": nrm(ks[9], (L, NSA_CMP_BLOCK * NSA_DIM, NSA_CMP_HIDDEN), (NSA_CMP_BLOCK * NSA_DIM) ** -0.5),
        "nsa_cv_w2": nrm(ks[10], (L, NSA_CMP_HIDDEN, NSA_DIM), NSA_CMP_HIDDEN ** -0.5),
        "w_branch_a": nrm(ks[11], (L, DA_V, D), DA_V ** -0.5),
        "w_branch_b": nrm(ks[12], (L, NSA_Q, D), NSA_Q ** -0.5),
        "w_out": nrm(ks[13], (L, D, D), D ** -0.5),
        "norm_cross": gain(ks[14], (L, D)),
        "norm_mem": gain(ks[15], (L, D)),
        "w_cross_q": nrm(ks[16], (L, D, CA_HEADS * CA_DIM), D ** -0.5),
        "w_cross_kv": nrm(ks[17], (L, D, 2 * CA_HEADS * CA_DIM), D ** -0.5),
        "w_cross_o": nrm(ks[18], (L, CA_HEADS * CA_DIM, D), (CA_HEADS * CA_DIM) ** -0.5),
        "norm_ffn": gain(ks[19], (L, D)),
        "peer_wq": nrm(ks[20], (L, D, PEER_HEADS * PEER_DKEY), D ** -0.5),
        "peer_subkeys": nrm(ks[21], (L, PEER_HEADS, 2, PEER_NKEYS, PEER_DKEY // 2), (PEER_DKEY // 2) ** -0.5),
        "peer_u": nrm(ks[22], (L, PEER_EXPERTS, D), D ** -0.5),
        "peer_v": nrm(ks[23], (L, PEER_EXPERTS, D), (PEER_HEADS * PEER_TOPK) ** -0.5),
        "norm_final": gain(ks[24], (D,)),
    }


def reference(x, mem, norm_mix, w_in, diff_lambda, diff_subln, nsa_cmp_pos, nsa_ck_w1, nsa_ck_w2,
              nsa_cv_w1, nsa_cv_w2, w_branch_a, w_branch_b, w_out, norm_cross, norm_mem,
              w_cross_q, w_cross_kv, w_cross_o, norm_ffn, peer_wq, peer_subkeys, peer_u, peer_v,
              norm_final):
    B, S, D = x.shape
    split_at = np.cumsum(IN_SIZES)[:-1].tolist()
    h = x
    for l in range(DEPTH):
        lambda_init = 0.8 - 0.6 * math.exp(-0.3 * l)
        u = rms_norm(h, norm_mix[l])
        qa, ka, va, qb, kvb, gb, gate_a, gate_b = jnp.split(u @ w_in[l], split_at, axis=-1)
        o_a = diff_attention(qa.reshape(B, S, DA_HEADS, 2, DA_DIM),
                             ka.reshape(B, S, DA_HEADS, 2, DA_DIM),
                             va.reshape(B, S, DA_HEADS, 2 * DA_DIM),
                             diff_lambda[l], diff_subln[l], lambda_init)
        R = NSA_HEADS // NSA_GROUPS
        o_b = nsa_attention(qb.reshape(B, S, NSA_GROUPS, R, NSA_DIM),
                            kvb.reshape(B, S, 6, NSA_GROUPS, NSA_DIM),
                            jax.nn.sigmoid(gb).reshape(B, S, NSA_GROUPS, R, 3),
                            nsa_cmp_pos[l], nsa_ck_w1[l], nsa_ck_w2[l], nsa_cv_w1[l], nsa_cv_w2[l])
        merged = (jax.nn.sigmoid(gate_a) * (o_a @ w_branch_a[l])
                  + jax.nn.sigmoid(gate_b) * (o_b @ w_branch_b[l]))
        h = h + merged @ w_out[l]
        h = h + memory_cross_attention(rms_norm(h, norm_cross[l]), rms_norm(mem, norm_mem[l]),
                                       w_cross_q[l], w_cross_kv[l], w_cross_o[l])
        h = h + peer_ffn(rms_norm(h, norm_ffn[l]), peer_wq[l], peer_subkeys[l], peer_u[l], peer_v[l])
    return rms_norm(h, norm_final)
```

```cpp
#include <hip/hip_runtime.h>
#include <hip/hip_cooperative_groups.h>
#include <cstdio>
#include <cstdint>
namespace cg = cooperative_groups;
namespace pg8 {
#define PG8_LAS __attribute__((address_space(3)))
typedef unsigned short bf16_t;
typedef short bf16x8 __attribute__((ext_vector_type(8)));
typedef float f32x4 __attribute__((ext_vector_type(4)));
typedef unsigned u32x4 __attribute__((ext_vector_type(4)));
constexpr int BM = 256, BK = 64, HALF = 128, HTB = HALF * BK * 2  , STAGE_BYTES = 8 * HTB, NXCD = 8, WGM = 8;

__host__ __device__ __forceinline__ int lds_byte(int r, int c) { const int st = (r >> 4) * 2 + (c >> 5), rr = r & 15, cc = c & 31, ob = rr * 64 + cc * 2; return st * 1024 + (ob ^ (((ob >> 9) & 1) << 5)); }
__host__ __device__ __forceinline__ void stage_rc(int b, int& R, int& C) { const int st = b / 1024, sb = b % 1024, swz = sb ^ (((sb >> 9) & 1) << 5); R = (st >> 1) * 16 + swz / 64; C = (st & 1) * 32 + (swz % 64) / 2; }
__host__ __device__ __forceinline__ int perm32(int rho) { const int n = rho >> 4, i = rho & 15; return 8 * (i >> 2) + 4 * n + (i & 3); }

struct Unit { int pm, pn; };
struct Gemm { const bf16_t* A; const bf16_t* Bt; int M, N, K, ld; };

struct StaticOrder {
    int nM, nN, nwg, G, c;
    __host__ __device__ void init(int M, int N, int G_, int c_) { nM = M / BM; nN = N / BM; nwg = nM * nN; G = G_; c = c_; }
    __host__ __device__ bool next(int i, Unit& u) const {
        const long L = (long)i * G + c; if (L >= nwg) return false;
        int wgid = (int)L; { const int q = nwg / NXCD, r = nwg % NXCD, xcd = wgid % NXCD, off = wgid / NXCD; wgid = (xcd < r ? xcd * (q + 1) : r * (q + 1) + (xcd - r) * q) + off; }
        const int nig = WGM * nN, gid = wgid / nig, fm = gid * WGM, gsz = (nM - fm) < WGM ? (nM - fm) : WGM;
        u.pm = fm + ((wgid % nig) % gsz); u.pn = (wgid % nig) / gsz; return true;
    }
    __device__ __forceinline__ void a_ready(const Unit&) const {}
    __device__ __forceinline__ void done(const Unit&) const {}
};

__device__ __forceinline__ unsigned cvt_pk_bf16(float lo, float hi) { unsigned r; asm volatile("v_cvt_pk_bf16_f32 %0, %1, %2" : "=v"(r) : "v"(lo), "v"(hi)); return r; }
template <class F> struct EpiF {
    static constexpr bool PERM = true, AFTER_DRAIN = false;
    F f;
    __device__ __forceinline__ void operator()(const f32x4 (&acc)[2][2][4][2], const Unit& u, int wr, int wc, int fr, int fq) const {
        const int row0 = u.pm * BM + wr * 64 + fr, col0 = u.pn * BM + wc * 32 + 8 * fq;
#pragma unroll
        for (int ai = 0; ai < 2; ++ai)
#pragma unroll
            for (int m = 0; m < 4; ++m)
#pragma unroll
                for (int bj = 0; bj < 2; ++bj) f(row0 + ai * HALF + m * 16, col0 + bj * HALF, acc[ai][bj][m][0], acc[ai][bj][m][1]);
    }
};
template <class Epi, class Sched, bool ALIGN_EPI = false, bool SP2 = false>
__device__ __forceinline__ void gemm_phase(PG8_LAS unsigned char* lds, const Gemm g, const Sched& S, const Epi& E) {
    const int tid = threadIdx.x, wid = __builtin_amdgcn_readfirstlane(tid >> 6), lane = tid & 63, wr = wid >> 2, wc = wid & 3, fr = lane & 15, fq = lane >> 4;
    const int K = g.K, nt = K / BK;
    unsigned voffA[2], voffB[2];
#pragma unroll
    for (int i = 0; i < 2; ++i) { int R, C; stage_rc(tid * 16 + i * 8192, R, C); const int Rb = Epi::PERM ? ((R & ~31) + perm32(R & 31)) : R;
        voffA[i] = (unsigned)(R * g.ld + C) * 2u; voffB[i] = (unsigned)(Rb * g.ld + C) * 2u; }
    const size_t kstep = (size_t)(BK * 2);
    const size_t hstep = (size_t)HALF * g.ld * 2;
    const size_t tstep = 2 * hstep;
    const unsigned ldsw = (unsigned)wid * 1024u;
    const int aoff = lds_byte(wr * 64 + fr, fq * 8), boff = lds_byte(wc * 32 + fr, fq * 8);
#define PG8_SA(b, h) (((b) * 2 + (h)) * HTB)
#define PG8_SB(b, h) ((4 + (b) * 2 + (h)) * HTB)
#define PG8_STAGE(bufoff, gbase, voff) do { _Pragma("unroll") for (int _i = 0; _i < 2; ++_i) \
        __builtin_amdgcn_global_load_lds((const unsigned*)((const char*)(gbase) + (voff)[_i]), (PG8_LAS unsigned*)(lds + (bufoff) + ldsw + _i * 8192), 16, 0, 0); } while (0)
#define PG8_LDA(dst, b, h) do { _Pragma("unroll") for (int m = 0; m < 4; ++m) _Pragma("unroll") for (int k = 0; k < 2; ++k) dst[m][k] = *(const PG8_LAS bf16x8*)(lds + PG8_SA(b, h) + aoff + m * 2048 + k * 1024); } while (0)
#define PG8_LDB(dst, b, h) do { _Pragma("unroll") for (int n = 0; n < 2; ++n) _Pragma("unroll") for (int k = 0; k < 2; ++k) dst[n][k] = *(const PG8_LAS bf16x8*)(lds + PG8_SB(b, h) + boff + n * 2048 + k * 1024); } while (0)
#define PG8_MMA(ai, bj, At, Bt) do { __builtin_amdgcn_s_setprio(1); _Pragma("unroll") for (int m = 0; m < 4; ++m) _Pragma("unroll") for (int n = 0; n < 2; ++n) _Pragma("unroll") for (int k = 0; k < 2; ++k) \
        acc[ai][bj][m][n] = __builtin_amdgcn_mfma_f32_16x16x32_bf16(Bt[n][k], At[m][k], acc[ai][bj][m][n], 0, 0, 0); __builtin_amdgcn_s_setprio(0); } while (0)
#define PG8_WAIT_V(n) asm volatile("s_waitcnt vmcnt(" #n ")" ::: "memory")
#define PG8_WAIT_L(n) asm volatile("s_waitcnt lgkmcnt(" #n ")" ::: "memory")
#define PG8_BAR __builtin_amdgcn_s_barrier()
#define PG8_SCHED __builtin_amdgcn_sched_barrier(0)
    Unit cur, nxt; int ui = 0;
    if (!S.next(0, cur)) return;
    f32x4 acc[2][2][4][2];
#pragma unroll
    for (int a = 0; a < 2; ++a)
#pragma unroll
        for (int b = 0; b < 2; ++b)
#pragma unroll
            for (int m = 0; m < 4; ++m)
#pragma unroll
                for (int n = 0; n < 2; ++n) acc[a][b][m][n] = (f32x4){0.f, 0.f, 0.f, 0.f};
    bf16x8 At[4][2], B0[2][2], B1[2][2];
    const char* cA = (const char*)g.A + (size_t)cur.pm * tstep; const char* cB = (const char*)g.Bt + (size_t)cur.pn * tstep;
    S.a_ready(cur);
    if constexpr (SP2) {
        PG8_STAGE(PG8_SB(0, 0), cB, voffB); PG8_STAGE(PG8_SB(0, 1), cB + hstep, voffB); PG8_STAGE(PG8_SA(0, 0), cA, voffA); PG8_STAGE(PG8_SA(0, 1), cA + hstep, voffA);
        if (wr == 1) PG8_BAR;
        PG8_WAIT_V(2); PG8_BAR;
        PG8_STAGE(PG8_SB(1, 0), cB + kstep, voffB); PG8_STAGE(PG8_SA(1, 0), cA + kstep, voffA); PG8_STAGE(PG8_SB(1, 1), cB + hstep + kstep, voffB);
        PG8_WAIT_V(6); PG8_BAR;
    } else {
        PG8_STAGE(PG8_SB(0, 0), cB, voffB); PG8_STAGE(PG8_SA(0, 0), cA, voffA); PG8_STAGE(PG8_SB(0, 1), cB + hstep, voffB); PG8_STAGE(PG8_SA(0, 1), cA + hstep, voffA);
        if (wr == 1) PG8_BAR;
        PG8_WAIT_V(4); PG8_BAR;
        PG8_STAGE(PG8_SB(1, 0), cB + kstep, voffB); PG8_STAGE(PG8_SA(1, 0), cA + kstep, voffA); PG8_STAGE(PG8_SB(1, 1), cB + hstep + kstep, voffB);
        PG8_WAIT_V(6); PG8_BAR;
    }
    for (;;) {
        const bool has_next = S.next(ui + 1, nxt);
        const char* nA = has_next ? (const char*)g.A + (size_t)nxt.pm * tstep : cA; const char* nB = has_next ? (const char*)g.Bt + (size_t)nxt.pn * tstep : cB;
        for (int t = 0; t < nt; t += 2) {
            const bool last = (t == nt - 2);
            const char* a1 = cA + (size_t)(t + 1) * kstep;
            const char* a2 = last ? nA : cA + (size_t)(t + 2) * kstep; const char* b2 = last ? nB : cB + (size_t)(t + 2) * kstep;
            const char* a3 = a2 + kstep; const char* b3 = b2 + kstep;
            if (last && has_next) S.a_ready(nxt);
            if constexpr (SP2) {
            PG8_LDB(B0, 0, 0); PG8_LDB(B1, 0, 1); PG8_SCHED; PG8_LDA(At, 0, 0); PG8_STAGE(PG8_SA(1, 1), a1 + hstep, voffA);
            PG8_WAIT_V(8); PG8_WAIT_L(0); PG8_BAR; PG8_MMA(0, 0, At, B0); PG8_MMA(0, 1, At, B1); PG8_BAR; PG8_SCHED;
            PG8_LDA(At, 0, 1); PG8_STAGE(PG8_SB(0, 0), b2, voffB); PG8_STAGE(PG8_SB(0, 1), b2 + hstep, voffB); PG8_STAGE(PG8_SA(0, 0), a2, voffA);
            PG8_WAIT_V(8); PG8_WAIT_L(0); PG8_BAR; PG8_MMA(1, 0, At, B0); PG8_MMA(1, 1, At, B1); PG8_BAR; PG8_SCHED;
            PG8_LDB(B0, 1, 0); PG8_LDB(B1, 1, 1); PG8_SCHED; PG8_LDA(At, 1, 0); PG8_STAGE(PG8_SA(0, 1), a2 + hstep, voffA);
            PG8_WAIT_V(8); PG8_WAIT_L(0); PG8_BAR; PG8_MMA(0, 0, At, B0); PG8_MMA(0, 1, At, B1); PG8_BAR; PG8_SCHED;
            PG8_LDA(At, 1, 1); PG8_STAGE(PG8_SB(1, 0), b3, voffB); PG8_STAGE(PG8_SB(1, 1), b3 + hstep, voffB); PG8_STAGE(PG8_SA(1, 0), a3, voffA);
            PG8_WAIT_V(8); PG8_WAIT_L(0); PG8_BAR; PG8_MMA(1, 0, At, B0); PG8_MMA(1, 1, At, B1); PG8_BAR; PG8_SCHED;
            } else {
            PG8_LDB(B0, 0, 0); PG8_SCHED; PG8_LDA(At, 0, 0); PG8_STAGE(PG8_SA(1, 1), a1 + hstep, voffA);
            PG8_WAIT_L(8); PG8_BAR; PG8_WAIT_L(0); PG8_MMA(0, 0, At, B0); PG8_BAR; PG8_SCHED;
            PG8_LDB(B1, 0, 1); PG8_STAGE(PG8_SB(0, 0), b2, voffB);
            PG8_BAR; PG8_WAIT_L(0); PG8_MMA(0, 1, At, B1); PG8_BAR;
            PG8_LDA(At, 0, 1); PG8_STAGE(PG8_SA(0, 0), a2, voffA);
            PG8_BAR; PG8_WAIT_L(0); PG8_MMA(1, 0, At, B0); PG8_BAR; PG8_SCHED;
            PG8_STAGE(PG8_SB(0, 1), b2 + hstep, voffB);
            PG8_WAIT_V(6); PG8_BAR; PG8_MMA(1, 1, At, B1); PG8_BAR;
            PG8_LDB(B0, 1, 0); PG8_SCHED; PG8_LDA(At, 1, 0); PG8_STAGE(PG8_SA(0, 1), a2 + hstep, voffA);
            PG8_WAIT_L(8); PG8_BAR; PG8_WAIT_L(0); PG8_MMA(0, 0, At, B0); PG8_BAR; PG8_SCHED;
            PG8_LDB(B1, 1, 1); PG8_STAGE(PG8_SB(1, 0), b3, voffB);
            PG8_BAR; PG8_WAIT_L(0); PG8_MMA(0, 1, At, B1); PG8_BAR;
            PG8_LDA(At, 1, 1); PG8_STAGE(PG8_SA(1, 0), a3, voffA);
            PG8_BAR; PG8_WAIT_L(0); PG8_MMA(1, 0, At, B0); PG8_BAR; PG8_SCHED;
            PG8_STAGE(PG8_SB(1, 1), b3 + hstep, voffB);
            PG8_WAIT_V(6); PG8_BAR; PG8_MMA(1, 1, At, B1); PG8_BAR;
            }
        }
        if constexpr (ALIGN_EPI) { if (wr == 0) PG8_BAR; }
        if constexpr (!Epi::AFTER_DRAIN) { E(acc, cur, wr, wc, fr, fq); S.done(cur); }
        if (!has_next) break;
#pragma unroll
        for (int a = 0; a < 2; ++a)
#pragma unroll
            for (int b = 0; b < 2; ++b)
#pragma unroll
                for (int m = 0; m < 4; ++m)
#pragma unroll
                    for (int n = 0; n < 2; ++n) acc[a][b][m][n] = (f32x4){0.f, 0.f, 0.f, 0.f};
        cur = nxt; cA = nA; cB = nB; ++ui;
        if constexpr (ALIGN_EPI) { if (wr == 1) PG8_BAR; }
    }
    PG8_WAIT_V(0);
    if constexpr (!ALIGN_EPI) { if (wr == 0) PG8_BAR; }
    PG8_BAR;
    if constexpr (Epi::AFTER_DRAIN) { E.fused(acc, cur, wr, wc, fr, fq, lds, wid, lane); S.done(cur); }
#undef PG8_SA
#undef PG8_SB
#undef PG8_STAGE
#undef PG8_LDA
#undef PG8_LDB
#undef PG8_MMA
#undef PG8_WAIT_V
#undef PG8_WAIT_L
#undef PG8_BAR
#undef PG8_SCHED
}
}

#define LAS __attribute__((address_space(3)))
typedef unsigned short bf16;
typedef unsigned v4u __attribute__((ext_vector_type(4)));
typedef unsigned v2u __attribute__((ext_vector_type(2)));
typedef float f32x4 __attribute__((ext_vector_type(4)));
typedef short bf16x8 __attribute__((ext_vector_type(8)));
#define LDS_WAIT() asm volatile("s_waitcnt lgkmcnt(0)" ::: "memory")
#define MFMA16(a, b, c) __builtin_amdgcn_mfma_f32_16x16x32_bf16((a), (b), (c), 0, 0, 0)

constexpr int NWAVES = 8, NTHR = 512;
constexpr int NB = 2, S = 8192, T = NB * S, D = 1024;
constexpr int LDS_BYTES = 147456;
constexpr float LOG2E = 1.4426950408889634f;
constexpr int NIN = 4888, NIN_PAD = 5120;

constexpr size_t MiB = 1u << 20;
constexpr size_t WS_CTL = 0, CTL_BYTES = 1 * MiB;
constexpr size_t WS_MEMN = 1 * MiB, WS_WIN_T = 2 * MiB, WS_CKW1_T = 12 * MiB, WS_CVW1_T = 13 * MiB, WS_WA_T = 14 * MiB, WS_WB_T = 15 * MiB, WS_WOUT_T = 16 * MiB,
                 WS_WCQ_T = 18 * MiB, WS_WCKV_T = 19 * MiB, WS_WCO_T = 21 * MiB, WS_WPS_T = 22 * MiB;
constexpr size_t WS_KCMP = 26 * MiB, WS_VCMP_T = 26 * MiB + 256 * 1024, WS_KMEM = 27 * MiB, WS_VMEM_T = 27 * MiB + 512 * 1024, WS_GB = 28 * MiB;
constexpr size_t WS_U = 32 * MiB;
constexpr size_t WS_QA = 64 * MiB, WS_KA = 80 * MiB, WS_VAT = 96 * MiB, WS_QB = 112 * MiB;
constexpr size_t WS_PU = 64 * MiB, WS_PV = 96 * MiB;
constexpr size_t WS_KCI = 128 * MiB, WS_VCI = 132 * MiB, WS_KS = 136 * MiB, WS_VST = 140 * MiB, WS_KW = 144 * MiB, WS_VWT = 148 * MiB;
constexpr size_t WS_OA = 152 * MiB, WS_OB = 168 * MiB, WS_HIDP = 152 * MiB;
constexpr size_t WS_GA = 184 * MiB, WS_GBT = 216 * MiB;
constexpr size_t WS_H = 192 * MiB;
constexpr size_t WS_QC = 128 * MiB, WS_OC = 144 * MiB, WS_SCORES = 128 * MiB;
constexpr size_t WS_END = 256 * MiB;

__device__ __forceinline__ unsigned pk2(float lo, float hi) { return pg8::cvt_pk_bf16(lo, hi); }
__device__ __forceinline__ unsigned short f2bf1(float f) { return (unsigned short)(pk2(f, 0.f) & 0xffffu); }
__device__ __forceinline__ float bflo(unsigned u) { return __builtin_bit_cast(float, u << 16); }
__device__ __forceinline__ float bfhi(unsigned u) { return __builtin_bit_cast(float, u & 0xffff0000u); }
__device__ __forceinline__ float wave_sum(float v) {
#pragma unroll
    for (int o = 1; o < 64; o <<= 1) v += __shfl_xor(v, o);
    return v;
}
__device__ __forceinline__ float sigm(float x) { return 1.f / (1.f + __expf(-x)); }
__device__ __forceinline__ float gelu_erf(float x) { return 0.5f * x * (1.f + erff(x * 0.70710678118654752f)); }
__device__ __forceinline__ float ex2(float x) { return __builtin_amdgcn_exp2f(x); }
__device__ __forceinline__ void store8bf(bf16* dst, const float* v) { v4u w; w.x = pk2(v[0], v[1]); w.y = pk2(v[2], v[3]); w.z = pk2(v[4], v[5]); w.w = pk2(v[6], v[7]); *(v4u*)dst = w; }
__device__ __forceinline__ bf16x8 ldg8(const bf16* p) { return *(const bf16x8*)p; }
__device__ __forceinline__ bf16x8 pack8(float a0, float a1, float a2, float a3, float a4, float a5, float a6, float a7) {
    v4u w; w.x = pk2(a0, a1); w.y = pk2(a2, a3); w.z = pk2(a4, a5); w.w = pk2(a6, a7); return __builtin_bit_cast(bf16x8, w);
}

struct Args { const float* in[25]; float* out; unsigned char* ws; int ph_lo, ph_hi; };

enum { EM_G1 = 0, EM_PART, EM_KVMEM, EM_MA, EM_MB, EM_H1, EM_QC, EM_H2, EM_SC };
struct EpiAll {
    int mode; unsigned char* ws; const float* x; const float* cmp_pos; float* part;
    __device__ __forceinline__ void operator()(int row, int col, const f32x4& v0, const f32x4& v1) const {
        float v[8] = {v0[0], v0[1], v0[2], v0[3], v1[0], v1[1], v1[2], v1[3]};
        switch (mode) {
        case EM_G1: {
            if (col >= NIN) return;
            const int b = row >> 13, s = row & (S - 1);
            if (col < 1024) {
                const bool isq = col < 512; bf16* dst = (bf16*)(ws + (isq ? WS_QA : WS_KA)) + (size_t)row * 512 + (col & 511);
                const float sc = isq ? 0.125f : 1.f;
#pragma unroll
                for (int i = 0; i < 8; ++i) v[i] *= sc;
                store8bf(dst, v);
            } else if (col < 1536) {
                bf16* dst = (bf16*)(ws + WS_VAT) + (size_t)(b * 512 + (col - 1024)) * S + s;
#pragma unroll
                for (int i = 0; i < 8; ++i) dst[(size_t)i * S] = f2bf1(v[i]);
            } else if (col < 2048) {
#pragma unroll
                for (int i = 0; i < 8; ++i) v[i] *= 0.125f;
                store8bf((bf16*)(ws + WS_QB) + (size_t)row * 512 + (col - 1536), v);
            } else if (col < 2816) {
                const int c2 = col - 2048, j = c2 >> 7, gg = (c2 >> 6) & 1, d = c2 & 63; const size_t bg = (size_t)(b * 2 + gg);
                if (j == 0 || j == 1) {
                    const float* cp = cmp_pos + (s & 31) * 64 + d;
#pragma unroll
                    for (int i = 0; i < 8; ++i) v[i] += cp[i];
                    store8bf((bf16*)(ws + (j == 0 ? WS_KCI : WS_VCI)) + (bg * S + s) * 64 + d, v);
                } else if (j == 2 || j == 4) {
                    store8bf((bf16*)(ws + (j == 2 ? WS_KS : WS_KW)) + (bg * S + s) * 64 + d, v);
                } else {
                    bf16* dst = (bf16*)(ws + (j == 3 ? WS_VST : WS_VWT)) + (bg * 64 + d) * S + s;
#pragma unroll
                    for (int i = 0; i < 8; ++i) dst[(size_t)i * S] = f2bf1(v[i]);
                }
            } else if (col < 2840) {
                float* dst = (float*)(ws + WS_GB) + (size_t)row * 24 + (col - 2816);
                *(f32x4*)dst = (f32x4){sigm(v[0]), sigm(v[1]), sigm(v[2]), sigm(v[3])}; *(f32x4*)(dst + 4) = (f32x4){sigm(v[4]), sigm(v[5]), sigm(v[6]), sigm(v[7])};
            } else {
                const bool ia = col < 3864; bf16* dst = (bf16*)(ws + (ia ? WS_GA : WS_GBT)) + (size_t)row * 1024 + (col - (ia ? 2840 : 3864));
#pragma unroll
                for (int i = 0; i < 8; ++i) v[i] = sigm(v[i]);
                store8bf(dst, v);
            }
        } break;
        case EM_PART: { float* dst = part + (size_t)row * 256 + col; *(f32x4*)dst = v0; *(f32x4*)(dst + 4) = v1; } break;
        case EM_KVMEM: {
            const int b = row >> 8, m = row & 255, c2 = col & 511, h = c2 >> 7, d = c2 & 127;
            if (col < 512) store8bf((bf16*)(ws + WS_KMEM) + ((size_t)((b * 4 + h) * 256 + m)) * 128 + d, v);
            else { bf16* dst = (bf16*)(ws + WS_VMEM_T) + ((size_t)((b * 4 + h) * 128 + d)) * 256 + m;
#pragma unroll
                for (int i = 0; i < 8; ++i) dst[i * 256] = f2bf1(v[i]); }
        } break;
        case EM_MA: {
            const v4u gq = *(const v4u*)((const bf16*)(ws + WS_GA) + (size_t)row * 1024 + col);
            const float g[8] = {bflo(gq.x), bfhi(gq.x), bflo(gq.y), bfhi(gq.y), bflo(gq.z), bfhi(gq.z), bflo(gq.w), bfhi(gq.w)};
#pragma unroll
            for (int i = 0; i < 8; ++i) v[i] *= g[i];
            store8bf((bf16*)(ws + WS_U) + (size_t)row * 1024 + col, v);
        } break;
        case EM_MB: {
            const v4u gq = *(const v4u*)((const bf16*)(ws + WS_GBT) + (size_t)row * 1024 + col);
            bf16* mp = (bf16*)(ws + WS_U) + (size_t)row * 1024 + col; const v4u mq = *(const v4u*)mp;
            const float g[8] = {bflo(gq.x), bfhi(gq.x), bflo(gq.y), bfhi(gq.y), bflo(gq.z), bfhi(gq.z), bflo(gq.w), bfhi(gq.w)};
            const float mm[8] = {bflo(mq.x), bfhi(mq.x), bflo(mq.y), bfhi(mq.y), bflo(mq.z), bfhi(mq.z), bflo(mq.w), bfhi(mq.w)};
#pragma unroll
            for (int i = 0; i < 8; ++i) v[i] = mm[i] + g[i] * v[i];
            store8bf(mp, v);
        } break;
        case EM_H1: {
            const float* xp = x + (size_t)row * 1024 + col; float* hp = (float*)(ws + WS_H) + (size_t)row * 1024 + col;
            const f32x4 x0 = *(const f32x4*)xp, x1 = *(const f32x4*)(xp + 4);
            *(f32x4*)hp = x0 + v0; *(f32x4*)(hp + 4) = x1 + v1;
        } break;
        case EM_QC: {
#pragma unroll
            for (int i = 0; i < 8; ++i) v[i] *= 0.08838834764831845f;
            store8bf((bf16*)(ws + WS_QC) + (size_t)row * 512 + col, v);
        } break;
        case EM_H2: {
            float* hp = (float*)(ws + WS_H) + (size_t)row * 1024 + col;
            const f32x4 x0 = *(const f32x4*)hp, x1 = *(const f32x4*)(hp + 4);
            *(f32x4*)hp = x0 + v0; *(f32x4*)(hp + 4) = x1 + v1;
        } break;
        default: {
            store8bf((bf16*)(ws + WS_SCORES) + (size_t)row * 2048 + col, v);
        } break;
        }
    }
};
typedef pg8::EpiF<EpiAll> EpiT;

__device__ __forceinline__ void run_gemm(LAS unsigned char* lds, const bf16* A, const bf16* Bt, int M, int N, int K, int ld, int G, int c, const EpiAll& ea) {
    pg8::Gemm g{A, Bt, M, N, K, ld}; pg8::StaticOrder So; So.init(M, N, G, c);
    EpiT E{ea};
    pg8::gemm_phase<EpiT, pg8::StaticOrder, true, true>(lds, g, So, E);
}

__device__ __forceinline__ void transpose_item(const float* W, int K, int Nsrc, int nblk, bf16* WT, LAS float* scr, int item, int lane) {
    const int kb = item / nblk, nb = item % nblk, k0 = 64 * kb, n0 = 32 * nb; const int n = n0 + (lane & 31);
#pragma unroll 8
    for (int i = 0; i < 32; ++i) { const int kk = 2 * i + (lane >> 5); scr[kk * 33 + (lane & 31)] = (n < Nsrc) ? W[(size_t)(k0 + kk) * Nsrc + n] : 0.f; }
    LDS_WAIT();
    const int c = lane & 7;
#pragma unroll
    for (int j = 0; j < 4; ++j) { const int nn = (lane >> 3) + 8 * j; const LAS float* s = scr + (8 * c) * 33 + nn;
        v4u o; o.x = pk2(s[0 * 33], s[1 * 33]); o.y = pk2(s[2 * 33], s[3 * 33]); o.z = pk2(s[4 * 33], s[5 * 33]); o.w = pk2(s[6 * 33], s[7 * 33]);
        *(v4u*)(WT + (size_t)(n0 + nn) * K + k0 + 8 * c) = o; }
    LDS_WAIT();
}
__device__ __forceinline__ void rms_row_to_bf16(const float* xrow, const float* g, bf16* orow, int lane) {
    const f32x4* xr = (const f32x4*)xrow + lane; const f32x4* gr = (const f32x4*)g + lane;
    f32x4 v[4]; float s = 0.f;
#pragma unroll
    for (int j = 0; j < 4; ++j) { v[j] = xr[64 * j]; s += (v[j].x * v[j].x + v[j].y * v[j].y) + (v[j].z * v[j].z + v[j].w * v[j].w); }
    const float rstd = rsqrtf(wave_sum(s) * (1.f / D) + 1e-6f);
    v2u* o8 = (v2u*)orow + lane;
#pragma unroll
    for (int j = 0; j < 4; ++j) { const f32x4 gg = gr[64 * j]; v2u w; w.x = pk2(v[j].x * rstd * gg.x, v[j].y * rstd * gg.y); w.y = pk2(v[j].z * rstd * gg.z, v[j].w * rstd * gg.w); o8[64 * j] = w; }
}


__device__ __forceinline__ void diff_item(unsigned char* ws, const float* lamp, const float* subln, int bh, int qt, LAS float* park, int lane) {
    const int b = bh >> 2, h = bh & 3, fr = lane & 15, fq = lane >> 4, q0 = qt * 32;
    float lam;
    { const float a = lamp[lane] * lamp[64 + lane], c = lamp[128 + lane] * lamp[192 + lane]; lam = __expf(wave_sum(a)) - __expf(wave_sum(c)) + 0.2f; }
    const float slope2 = ex2(-2.f * (float)(h + 1)) * LOG2E;
    const bf16* Qb = (const bf16*)(ws + WS_QA) + (size_t)(b * S) * 512 + h * 128;
    const bf16* Kb = (const bf16*)(ws + WS_KA) + (size_t)(b * S) * 512 + h * 128;
    const bf16* Vb = (const bf16*)(ws + WS_VAT) + (size_t)((b * 4 + h) * 128) * S;
    const int kr0 = 8 * (fr >> 2) + (fr & 3);
    const int nsteps = qt + 1;
    for (int c = 0; c < 2; ++c) {
        bf16x8 Qf[2][2];
#pragma unroll
        for (int nt = 0; nt < 2; ++nt)
#pragma unroll
            for (int ks = 0; ks < 2; ++ks) Qf[nt][ks] = ldg8(Qb + (size_t)(q0 + nt * 16 + fr) * 512 + c * 64 + ks * 32 + fq * 8);
        f32x4 O[8][2];
#pragma unroll
        for (int mt = 0; mt < 8; ++mt) { O[mt][0] = (f32x4){0.f, 0.f, 0.f, 0.f}; O[mt][1] = (f32x4){0.f, 0.f, 0.f, 0.f}; }
        float mrun[2] = {-1e30f, -1e30f}, lrun[2] = {0.f, 0.f};
        const bf16* kp = Kb + (size_t)kr0 * 512 + c * 64 + fq * 8;
        bf16x8 Kc[2][2];
#pragma unroll
        for (int t = 0; t < 2; ++t)
#pragma unroll
            for (int ks = 0; ks < 2; ++ks) Kc[t][ks] = ldg8(kp + (size_t)(4 * t) * 512 + ks * 32);
        for (int kb = 0; kb < nsteps; ++kb) {
            bf16x8 Vf[8];
#pragma unroll
            for (int mt = 0; mt < 8; ++mt) Vf[mt] = ldg8(Vb + (size_t)(mt * 16 + fr) * S + kb * 32 + fq * 8);
            const int kbn = (kb + 1 < nsteps) ? kb + 1 : kb;
            bf16x8 Kn[2][2];
#pragma unroll
            for (int t = 0; t < 2; ++t)
#pragma unroll
                for (int ks = 0; ks < 2; ++ks) Kn[t][ks] = ldg8(kp + (size_t)(kbn * 32 + 4 * t) * 512 + ks * 32);
            f32x4 Sx[2][2];
#pragma unroll
            for (int t = 0; t < 2; ++t)
#pragma unroll
                for (int nt = 0; nt < 2; ++nt) { f32x4 z = {0.f, 0.f, 0.f, 0.f}; z = MFMA16(Kc[t][0], Qf[nt][0], z); Sx[t][nt] = MFMA16(Kc[t][1], Qf[nt][1], z); }
            bf16x8 Pf[2];
#pragma unroll
            for (int nt = 0; nt < 2; ++nt) {
                const int qpos = q0 + nt * 16 + fr;
                const float base = (float)(kb * 32 + fq * 8 - qpos);
                float sv[8]; float mx = -1e30f;
#pragma unroll
                for (int t = 0; t < 2; ++t)
#pragma unroll
                    for (int r = 0; r < 4; ++r) { const float kd = base + (float)(4 * t + r); const float val = Sx[t][nt][r] * LOG2E + slope2 * kd; const float s_ = (kd <= 0.f) ? val : -1e30f; sv[t * 4 + r] = s_; mx = fmaxf(mx, s_); }
                mx = fmaxf(mx, __shfl_xor(mx, 16)); mx = fmaxf(mx, __shfl_xor(mx, 32));
                const float mnew = fmaxf(mrun[nt], mx), alpha = ex2(mrun[nt] - mnew); mrun[nt] = mnew;
                float ps = 0.f;
#pragma unroll
                for (int i = 0; i < 8; ++i) { sv[i] = (sv[i] > -1e29f) ? ex2(sv[i] - mnew) : 0.f; ps += sv[i]; }
                lrun[nt] = lrun[nt] * alpha + ps;
#pragma unroll
                for (int mt = 0; mt < 8; ++mt) O[mt][nt] *= alpha;
                Pf[nt] = pack8(sv[0], sv[1], sv[2], sv[3], sv[4], sv[5], sv[6], sv[7]);
            }
#pragma unroll
            for (int mt = 0; mt < 8; ++mt) { O[mt][0] = MFMA16(Vf[mt], Pf[0], O[mt][0]); O[mt][1] = MFMA16(Vf[mt], Pf[1], O[mt][1]); }
#pragma unroll
            for (int t = 0; t < 2; ++t) { Kc[t][0] = Kn[t][0]; Kc[t][1] = Kn[t][1]; }
        }
        float inv[2];
#pragma unroll
        for (int nt = 0; nt < 2; ++nt) { float l = lrun[nt]; l += __shfl_xor(l, 16); l += __shfl_xor(l, 32); inv[nt] = 1.f / l; }
        if (c == 0) {
#pragma unroll
            for (int mt = 0; mt < 8; ++mt)
#pragma unroll
                for (int nt = 0; nt < 2; ++nt)
#pragma unroll
                    for (int r = 0; r < 4; ++r) park[((mt * 2 + nt) * 4 + r) * 64 + lane] = O[mt][nt][r] * inv[nt];
        } else {
            LDS_WAIT();
            float ss[2] = {0.f, 0.f};
#pragma unroll
            for (int mt = 0; mt < 8; ++mt)
#pragma unroll
                for (int nt = 0; nt < 2; ++nt)
#pragma unroll
                    for (int r = 0; r < 4; ++r) { const float v_ = park[((mt * 2 + nt) * 4 + r) * 64 + lane] - lam * (O[mt][nt][r] * inv[nt]); O[mt][nt][r] = v_; ss[nt] += v_ * v_; }
#pragma unroll
            for (int nt = 0; nt < 2; ++nt) {
                float s_ = ss[nt]; s_ += __shfl_xor(s_, 16); s_ += __shfl_xor(s_, 32);
                const float rstd = rsqrtf(s_ * (1.f / 128.f) + 1e-6f) * 0.8f;
                bf16* op = (bf16*)(ws + WS_OA) + (size_t)(b * S + q0 + nt * 16 + fr) * 512 + h * 128 + fq * 4;
#pragma unroll
                for (int mt = 0; mt < 8; ++mt) { const f32x4 gg = *(const f32x4*)(subln + mt * 16 + fq * 4);
                    v2u w; w.x = pk2(O[mt][nt][0] * rstd * gg.x, O[mt][nt][1] * rstd * gg.y); w.y = pk2(O[mt][nt][2] * rstd * gg.z, O[mt][nt][3] * rstd * gg.w);
                    *(v2u*)(op + mt * 16) = w; }
            }
            LDS_WAIT();
        }
    }
}

template <int MODE>
__device__ __forceinline__ void nsa_step(const bf16* Kp, const bf16* Vp, int kbase, const bf16x8 (&Qf)[2], int qpos, float slope2, bool blkok, int fr, int fq, int kr0,
                                         float& mrun, float& lrun, f32x4 (&O)[4]) {
    bf16x8 Ka[2][2];
#pragma unroll
    for (int t = 0; t < 2; ++t)
#pragma unroll
        for (int ks = 0; ks < 2; ++ks) Ka[t][ks] = ldg8(Kp + (size_t)(kbase + kr0 + 4 * t) * 64 + ks * 32 + fq * 8);
    bf16x8 Vf[4];
#pragma unroll
    for (int mt = 0; mt < 4; ++mt) Vf[mt] = ldg8(Vp + (size_t)(mt * 16 + fr) * S + kbase + fq * 8);
    f32x4 Sx[2];
#pragma unroll
    for (int t = 0; t < 2; ++t) { f32x4 z = {0.f, 0.f, 0.f, 0.f}; z = MFMA16(Ka[t][0], Qf[0], z); Sx[t] = MFMA16(Ka[t][1], Qf[1], z); }
    const int kd0 = kbase + fq * 8 - qpos;
    float sv[8]; float mx = -1e30f;
#pragma unroll
    for (int t = 0; t < 2; ++t)
#pragma unroll
        for (int r = 0; r < 4; ++r) { const int kd = kd0 + 4 * t + r; const bool ok = (MODE == 0) ? (blkok && kd <= 0) : (kd <= 0 && kd > -512);
            const float val = Sx[t][r] * LOG2E + slope2 * (float)kd; const float s_ = ok ? val : -1e30f; sv[t * 4 + r] = s_; mx = fmaxf(mx, s_); }
    mx = fmaxf(mx, __shfl_xor(mx, 16)); mx = fmaxf(mx, __shfl_xor(mx, 32));
    const float mnew = fmaxf(mrun, mx), alpha = ex2(mrun - mnew); mrun = mnew;
    float ps = 0.f;
#pragma unroll
    for (int i = 0; i < 8; ++i) { sv[i] = (sv[i] > -1e29f) ? ex2(sv[i] - mnew) : 0.f; ps += sv[i]; }
    lrun = lrun * alpha + ps;
    const bf16x8 Pf = pack8(sv[0], sv[1], sv[2], sv[3], sv[4], sv[5], sv[6], sv[7]);
#pragma unroll
    for (int mt = 0; mt < 4; ++mt) { O[mt] *= alpha; O[mt] = MFMA16(Vf[mt], Pf, O[mt]); }
}

__device__ __forceinline__ void cmp_scores(const bf16* Kc, int u, const bf16x8 (&Qf)[2], int qpos, int nv, float slope2, int fq, int kr0, float (&sv)[8]) {
#pragma unroll
    for (int t = 0; t < 2; ++t) {
        const bf16* kp = Kc + (size_t)(32 * u + kr0 + 4 * t) * 64 + fq * 8;
        f32x4 z = {0.f, 0.f, 0.f, 0.f}; z = MFMA16(ldg8(kp), Qf[0], z); z = MFMA16(ldg8(kp + 32), Qf[1], z);
#pragma unroll
        for (int rr = 0; rr < 4; ++rr) { const int cidx = 32 * u + 8 * fq + 4 * t + rr; const float dist = (float)(qpos - (cidx * 32 + 31));
            sv[t * 4 + rr] = (cidx < nv) ? (z[rr] * LOG2E - slope2 * dist) : -1e30f; }
    }
}

__device__ __forceinline__ void nsa_item(unsigned char* ws, int bg, int it, LAS float* wl, int lane) {
    const int b = bg >> 1, g = bg & 1, fr = lane & 15, fq = lane >> 4, i = fr >> 2, r = fr & 3, s0 = it * 4, qpos = s0 + i;
    const int kr0 = 8 * (fr >> 2) + (fr & 3);
    const float slope2 = ex2(-(float)(g * 4 + r + 1)) * LOG2E;
    bf16x8 Qf[2];
    { const bf16* qp = (const bf16*)(ws + WS_QB) + (size_t)(b * S + qpos) * 512 + (g * 4 + r) * 64 + fq * 8; Qf[0] = ldg8(qp); Qf[1] = ldg8(qp + 32); }
    const float* gp = (const float*)(ws + WS_GB) + (size_t)(b * S + qpos) * 24 + g * 12 + r * 3;
    const float g0 = gp[0], g1 = gp[1], g2 = gp[2];
    f32x4 Oacc[4];
#pragma unroll
    for (int mt = 0; mt < 4; ++mt) Oacc[mt] = (f32x4){0.f, 0.f, 0.f, 0.f};
#pragma unroll
    for (int e = 0; e < 8; ++e) wl[e * 64 + lane] = 0.f;
    const int nv = (qpos + 1) >> 5, nvmax = (s0 + 4) >> 5;
    if (nvmax > 0) {
        const bf16* Kc = (const bf16*)(ws + WS_KCMP) + (size_t)(bg * 256) * 64;
        const bf16* Vc = (const bf16*)(ws + WS_VCMP_T) + (size_t)(bg * 64) * 256;
        const int nu = (nvmax + 31) >> 5;
        float mloc = -1e30f, lloc = 0.f;
#pragma unroll 1
        for (int u = 0; u < nu; ++u) {
            float sv[8]; cmp_scores(Kc, u, Qf, qpos, nv, slope2, fq, kr0, sv);
            float mx = mloc;
#pragma unroll
            for (int e = 0; e < 8; ++e) mx = fmaxf(mx, sv[e]);
            float ps = 0.f;
#pragma unroll
            for (int e = 0; e < 8; ++e) ps += (sv[e] > -1e29f) ? ex2(sv[e] - mx) : 0.f;
            lloc = lloc * ex2(mloc - mx) + ps; mloc = mx;
        }
        float mx = fmaxf(mloc, __shfl_xor(mloc, 16)); mx = fmaxf(mx, __shfl_xor(mx, 32));
        float ls = lloc * ex2(mloc - mx); ls += __shfl_xor(ls, 16); ls += __shfl_xor(ls, 32);
        const float inv = (ls > 0.f) ? 1.f / ls : 0.f;
        f32x4 Oc[4];
#pragma unroll
        for (int mt = 0; mt < 4; ++mt) Oc[mt] = (f32x4){0.f, 0.f, 0.f, 0.f};
#pragma unroll 1
        for (int u = 0; u < nu; ++u) {
            float sv[8]; cmp_scores(Kc, u, Qf, qpos, nv, slope2, fq, kr0, sv);
#pragma unroll
            for (int e = 0; e < 8; ++e) sv[e] = (sv[e] > -1e29f) ? ex2(sv[e] - mx) * inv : 0.f;
#pragma unroll
            for (int t = 0; t < 2; ++t) {
                float e0 = sv[t * 4 + 0] + sv[t * 4 + 1], e1 = sv[t * 4 + 2] + sv[t * 4 + 3];
                e0 += __shfl_xor(e0, 1); e0 += __shfl_xor(e0, 2); e1 += __shfl_xor(e1, 1); e1 += __shfl_xor(e1, 2);
                if (r == 0) { const int j = 16 * u + 4 * fq + 2 * t; wl[i * 128 + j] = e0; wl[i * 128 + j + 1] = e1; }
            }
            const bf16x8 Pf = pack8(sv[0], sv[1], sv[2], sv[3], sv[4], sv[5], sv[6], sv[7]);
#pragma unroll
            for (int mt = 0; mt < 4; ++mt) Oc[mt] = MFMA16(ldg8(Vc + (size_t)(mt * 16 + fr) * 256 + 32 * u + fq * 8), Pf, Oc[mt]);
        }
#pragma unroll
        for (int mt = 0; mt < 4; ++mt) Oacc[mt] = Oc[mt] * g0;
    }
    LDS_WAIT();
    unsigned msk[4] = {0u, 0u, 0u, 0u};
    {
        const int q16 = r + 4 * fq, cur = qpos >> 6;
        float cv[8];
#pragma unroll
        for (int e = 0; e < 8; ++e) { const int j = q16 + 16 * e; const bool forced = (j == 0) || (j == cur) || (j == cur - 1);
            cv[e] = forced ? 1e4f : ((j <= cur) ? wl[i * 128 + j] : -1e9f); }
        for (int round = 0; round < 16; ++round) {
            float best = cv[0]; int be = 0;
#pragma unroll
            for (int e = 1; e < 8; ++e) if (cv[e] > best) { best = cv[e]; be = e; }
            int bj = q16 + 16 * be;
#pragma unroll
            for (int oi = 0; oi < 4; ++oi) { const int off = (oi == 0) ? 1 : (oi == 1) ? 2 : (oi == 2) ? 16 : 32;
                const float ov = __shfl_xor(best, off); const int oj = __shfl_xor(bj, off);
                const bool take = (ov > best) || (ov == best && oj < bj); best = take ? ov : best; bj = take ? oj : bj; }
            const unsigned bit = 1u << (bj & 31); const int w = bj >> 5;
            msk[0] |= (w == 0) ? bit : 0u; msk[1] |= (w == 1) ? bit : 0u; msk[2] |= (w == 2) ? bit : 0u; msk[3] |= (w == 3) ? bit : 0u;
#pragma unroll
            for (int e = 0; e < 8; ++e) if (bj == q16 + 16 * e) cv[e] = -3e38f;
        }
    }
    {
        const bf16* Kp = (const bf16*)(ws + WS_KS) + (size_t)(bg * S) * 64;
        const bf16* Vp = (const bf16*)(ws + WS_VST) + (size_t)(bg * 64) * S;
        float mrun = -1e30f, lrun = 0.f; f32x4 O[4];
#pragma unroll
        for (int mt = 0; mt < 4; ++mt) O[mt] = (f32x4){0.f, 0.f, 0.f, 0.f};
        const int curmax = (s0 + 3) >> 6;
#pragma unroll
        for (int w = 0; w < 4; ++w) {
            unsigned u_ = msk[w]; u_ |= __shfl_xor(u_, 4); u_ |= __shfl_xor(u_, 8);
            unsigned uu = (unsigned)__builtin_amdgcn_readfirstlane((int)u_);
            const int hi = curmax - 32 * w;
            const unsigned vm = (hi < 0) ? 0u : (hi >= 31 ? 0xffffffffu : ((2u << hi) - 1u));
            uu &= vm;
            while (uu) {
                const int jb = __builtin_ctz(uu); uu &= uu - 1u;
                const bool blkok = (msk[w] >> jb) & 1u;
                const int kbase = (32 * w + jb) * 64;
                nsa_step<0>(Kp, Vp, kbase, Qf, qpos, slope2, blkok, fr, fq, kr0, mrun, lrun, O);
                nsa_step<0>(Kp, Vp, kbase + 32, Qf, qpos, slope2, blkok, fr, fq, kr0, mrun, lrun, O);
            }
        }
        float l = lrun; l += __shfl_xor(l, 16); l += __shfl_xor(l, 32);
        const float sc_ = g1 / l;
#pragma unroll
        for (int mt = 0; mt < 4; ++mt) Oacc[mt] += O[mt] * sc_;
    }
    {
        const bf16* Kp = (const bf16*)(ws + WS_KW) + (size_t)(bg * S) * 64;
        const bf16* Vp = (const bf16*)(ws + WS_VWT) + (size_t)(bg * 64) * S;
        float mrun = -1e30f, lrun = 0.f; f32x4 O[4];
#pragma unroll
        for (int mt = 0; mt < 4; ++mt) O[mt] = (f32x4){0.f, 0.f, 0.f, 0.f};
        const int kstart = (s0 - 511 > 0) ? (s0 - 511) : 0;
        for (int k32 = kstart >> 5; k32 <= ((s0 + 3) >> 5); ++k32)
            nsa_step<1>(Kp, Vp, k32 * 32, Qf, qpos, slope2, true, fr, fq, kr0, mrun, lrun, O);
        float l = lrun; l += __shfl_xor(l, 16); l += __shfl_xor(l, 32);
        const float sc_ = g2 / l;
#pragma unroll
        for (int mt = 0; mt < 4; ++mt) Oacc[mt] += O[mt] * sc_;
    }
    bf16* op = (bf16*)(ws + WS_OB) + (size_t)(b * S + qpos) * 512 + (g * 4 + r) * 64 + fq * 4;
#pragma unroll
    for (int mt = 0; mt < 4; ++mt) { v2u w; w.x = pk2(Oacc[mt][0], Oacc[mt][1]); w.y = pk2(Oacc[mt][2], Oacc[mt][3]); *(v2u*)(op + mt * 16) = w; }
    LDS_WAIT();
}

__device__ __forceinline__ void cross_item(unsigned char* ws, int rt, int h, int lane) {
    const int fr = lane & 15, fq = lane >> 4, row = rt * 16 + fr, b = (rt * 16) >> 13;
    const int kr0 = 8 * (fr >> 2) + (fr & 3);
    bf16x8 Qf[4];
    { const bf16* qp = (const bf16*)(ws + WS_QC) + (size_t)row * 512 + h * 128 + fq * 8;
#pragma unroll
      for (int ks = 0; ks < 4; ++ks) Qf[ks] = ldg8(qp + ks * 32); }
    const bf16* Kc = (const bf16*)(ws + WS_KMEM) + (size_t)((b * 4 + h) * 256) * 128;
    const bf16* Vc = (const bf16*)(ws + WS_VMEM_T) + (size_t)((b * 4 + h) * 128) * 256;
    f32x4 sc[16]; float mx = -1e30f;
#pragma unroll
    for (int kt = 0; kt < 16; ++kt) {
        const int u = kt >> 1, t = kt & 1;
        const bf16* kp = Kc + (size_t)(32 * u + kr0 + 4 * t) * 128 + fq * 8;
        f32x4 z = {0.f, 0.f, 0.f, 0.f};
#pragma unroll
        for (int ks = 0; ks < 4; ++ks) z = MFMA16(ldg8(kp + ks * 32), Qf[ks], z);
        z *= LOG2E; sc[kt] = z;
        mx = fmaxf(mx, fmaxf(fmaxf(z[0], z[1]), fmaxf(z[2], z[3])));
    }
    mx = fmaxf(mx, __shfl_xor(mx, 16)); mx = fmaxf(mx, __shfl_xor(mx, 32));
    float ls = 0.f;
#pragma unroll
    for (int kt = 0; kt < 16; ++kt)
#pragma unroll
        for (int rr = 0; rr < 4; ++rr) { const float p = ex2(sc[kt][rr] - mx); sc[kt][rr] = p; ls += p; }
    ls += __shfl_xor(ls, 16); ls += __shfl_xor(ls, 32);
    const float inv = 1.f / ls;
    f32x4 O[8];
#pragma unroll
    for (int mt = 0; mt < 8; ++mt) O[mt] = (f32x4){0.f, 0.f, 0.f, 0.f};
#pragma unroll
    for (int u = 0; u < 8; ++u) {
        const bf16x8 Pf = pack8(sc[2 * u][0], sc[2 * u][1], sc[2 * u][2], sc[2 * u][3], sc[2 * u + 1][0], sc[2 * u + 1][1], sc[2 * u + 1][2], sc[2 * u + 1][3]);
#pragma unroll
        for (int mt = 0; mt < 8; ++mt) O[mt] = MFMA16(ldg8(Vc + (size_t)(mt * 16 + fr) * 256 + 32 * u + fq * 8), Pf, O[mt]);
    }
    bf16* op = (bf16*)(ws + WS_OC) + (size_t)row * 512 + h * 128 + fq * 4;
#pragma unroll
    for (int mt = 0; mt < 8; ++mt) { v2u w; w.x = pk2(O[mt][0] * inv, O[mt][1] * inv); w.y = pk2(O[mt][2] * inv, O[mt][3] * inv); *(v2u*)(op + mt * 16) = w; }
}

__device__ __forceinline__ void peer_token(unsigned char* ws, const float* gfin, float* outp, int tok, int lane) {
    const bf16* scp = (const bf16*)(ws + WS_SCORES) + (size_t)tok * 2048;
    const int l16 = lane & 15, grp = lane >> 4;
    float tsv[4]; int tsi[4];
#pragma unroll
    for (int gi = 0; gi < 4; ++gi) {
        const int hc = gi * 4 + grp;
        const v4u raw = *(const v4u*)(scp + hc * 128 + l16 * 8);
        float cv[8] = {bflo(raw.x), bfhi(raw.x), bflo(raw.y), bfhi(raw.y), bflo(raw.z), bfhi(raw.z), bflo(raw.w), bfhi(raw.w)};
        float myv = 0.f; int myi = 0;
        for (int round = 0; round < 16; ++round) {
            float best = cv[0]; int be = 0;
#pragma unroll
            for (int e = 1; e < 8; ++e) if (cv[e] > best) { best = cv[e]; be = e; }
            int bk = l16 * 8 + be;
#pragma unroll
            for (int off = 1; off < 16; off <<= 1) { const float ov = __shfl_xor(best, off); const int ok = __shfl_xor(bk, off);
                const bool take = (ov > best) || (ov == best && ok < bk); best = take ? ov : best; bk = take ? ok : bk; }
            if (l16 == round) { myv = best; myi = bk; }
#pragma unroll
            for (int e = 0; e < 8; ++e) if (bk == l16 * 8 + e) cv[e] = -3e38f;
        }
        tsv[gi] = myv; tsi[gi] = myi;
    }
    float gsel[4]; int esel[4];
    const int half = lane >> 5, L = lane & 31, hb = half * 32, a = L & 15, bb = (L >> 4) * 8;
#pragma unroll
    for (int gi = 0; gi < 4; ++gi) {
        const float s0a = __shfl(tsv[gi], hb + a);
        float cand[8];
#pragma unroll
        for (int e = 0; e < 8; ++e) cand[e] = s0a + __shfl(tsv[gi], hb + 16 + bb + e);
        float selv = 0.f; int self_ = 0;
        for (int round = 0; round < 16; ++round) {
            float best = cand[0]; int be = 0;
#pragma unroll
            for (int e = 1; e < 8; ++e) if (cand[e] > best) { best = cand[e]; be = e; }
            int bfi = a * 16 + bb + be;
#pragma unroll
            for (int off = 1; off < 32; off <<= 1) { const float ov = __shfl_xor(best, off); const int oi = __shfl_xor(bfi, off);
                const bool take = (ov > best) || (ov == best && oi < bfi); best = take ? ov : best; bfi = take ? oi : bfi; }
            if (L == round) { selv = best; self_ = bfi; }
#pragma unroll
            for (int e = 0; e < 8; ++e) if (bfi == a * 16 + bb + e) cand[e] = -3e38f;
        }
        const int i0 = __shfl(tsi[gi], hb + (self_ >> 4)), i1 = __shfl(tsi[gi], hb + 16 + (self_ & 15));
        const float mxv = __shfl(selv, hb);
        float ev = (L < 16) ? __expf(selv - mxv) : 0.f;
        float sm = ev;
#pragma unroll
        for (int off = 1; off < 16; off <<= 1) sm += __shfl_xor(sm, off);
        gsel[gi] = (L < 16) ? ev / sm : 0.f; esel[gi] = i0 * 128 + i1;
    }
    float xf[16];
    { const bf16* up = (const bf16*)(ws + WS_U) + (size_t)tok * 1024 + lane * 8; const v4u a0 = *(const v4u*)up, a1 = *(const v4u*)(up + 512);
      xf[0] = bflo(a0.x); xf[1] = bfhi(a0.x); xf[2] = bflo(a0.y); xf[3] = bfhi(a0.y); xf[4] = bflo(a0.z); xf[5] = bfhi(a0.z); xf[6] = bflo(a0.w); xf[7] = bfhi(a0.w);
      xf[8] = bflo(a1.x); xf[9] = bfhi(a1.x); xf[10] = bflo(a1.y); xf[11] = bfhi(a1.y); xf[12] = bflo(a1.z); xf[13] = bfhi(a1.z); xf[14] = bflo(a1.w); xf[15] = bfhi(a1.w); }
    float oacc[16];
#pragma unroll
    for (int e = 0; e < 16; ++e) oacc[e] = 0.f;
    const bf16* PU = (const bf16*)(ws + WS_PU); const bf16* PV = (const bf16*)(ws + WS_PV);
#pragma unroll
    for (int gi = 0; gi < 4; ++gi) {
        for (int hk = 0; hk < 4; ++hk) {
            const int lbase = (hk >> 1) * 32 + (hk & 1) * 8;
            v4u ua[8], ub[8]; int eid[8]; float gt[8];
#pragma unroll
            for (int kk = 0; kk < 8; ++kk) {
                eid[kk] = __builtin_amdgcn_readfirstlane(__shfl(esel[gi], lbase + kk));
                gt[kk] = __builtin_bit_cast(float, __builtin_amdgcn_readfirstlane(__builtin_bit_cast(int, __shfl(gsel[gi], lbase + kk))));
                const bf16* up = PU + (size_t)eid[kk] * 1024 + lane * 8; ua[kk] = *(const v4u*)up; ub[kk] = *(const v4u*)(up + 512);
            }
            float wgt[8];
#pragma unroll
            for (int kk = 0; kk < 8; ++kk) {
                float d = xf[0] * bflo(ua[kk].x) + xf[1] * bfhi(ua[kk].x) + xf[2] * bflo(ua[kk].y) + xf[3] * bfhi(ua[kk].y)
                        + xf[4] * bflo(ua[kk].z) + xf[5] * bfhi(ua[kk].z) + xf[6] * bflo(ua[kk].w) + xf[7] * bfhi(ua[kk].w)
                        + xf[8] * bflo(ub[kk].x) + xf[9] * bfhi(ub[kk].x) + xf[10] * bflo(ub[kk].y) + xf[11] * bfhi(ub[kk].y)
                        + xf[12] * bflo(ub[kk].z) + xf[13] * bfhi(ub[kk].z) + xf[14] * bflo(ub[kk].w) + xf[15] * bfhi(ub[kk].w);
                d = wave_sum(d);
                wgt[kk] = gt[kk] * gelu_erf(d);
            }
#pragma unroll
            for (int kk = 0; kk < 8; ++kk) { const bf16* vp = PV + (size_t)eid[kk] * 1024 + lane * 8; ua[kk] = *(const v4u*)vp; ub[kk] = *(const v4u*)(vp + 512); }
#pragma unroll
            for (int kk = 0; kk < 8; ++kk) { const float w_ = wgt[kk];
                oacc[0] += w_ * bflo(ua[kk].x); oacc[1] += w_ * bfhi(ua[kk].x); oacc[2] += w_ * bflo(ua[kk].y); oacc[3] += w_ * bfhi(ua[kk].y);
                oacc[4] += w_ * bflo(ua[kk].z); oacc[5] += w_ * bfhi(ua[kk].z); oacc[6] += w_ * bflo(ua[kk].w); oacc[7] += w_ * bfhi(ua[kk].w);
                oacc[8] += w_ * bflo(ub[kk].x); oacc[9] += w_ * bfhi(ub[kk].x); oacc[10] += w_ * bflo(ub[kk].y); oacc[11] += w_ * bfhi(ub[kk].y);
                oacc[12] += w_ * bflo(ub[kk].z); oacc[13] += w_ * bfhi(ub[kk].z); oacc[14] += w_ * bflo(ub[kk].w); oacc[15] += w_ * bfhi(ub[kk].w); }
        }
    }
    const float* hp = (const float*)(ws + WS_H) + (size_t)tok * 1024 + lane * 8;
    const f32x4 h0 = *(const f32x4*)hp, h1 = *(const f32x4*)(hp + 4), h2 = *(const f32x4*)(hp + 512), h3 = *(const f32x4*)(hp + 516);
    float y[16] = {h0.x + oacc[0], h0.y + oacc[1], h0.z + oacc[2], h0.w + oacc[3], h1.x + oacc[4], h1.y + oacc[5], h1.z + oacc[6], h1.w + oacc[7],
                   h2.x + oacc[8], h2.y + oacc[9], h2.z + oacc[10], h2.w + oacc[11], h3.x + oacc[12], h3.y + oacc[13], h3.z + oacc[14], h3.w + oacc[15]};
    float ss = 0.f;
#pragma unroll
    for (int e = 0; e < 16; ++e) ss += y[e] * y[e];
    const float rstd = rsqrtf(wave_sum(ss) * (1.f / D) + 1e-6f);
    const float* gp = gfin + lane * 8; float* op = outp + (size_t)tok * 1024 + lane * 8;
    const f32x4 ga = *(const f32x4*)gp, gb = *(const f32x4*)(gp + 4), gc = *(const f32x4*)(gp + 512), gd = *(const f32x4*)(gp + 516);
    *(f32x4*)op = (f32x4){y[0] * rstd * ga.x, y[1] * rstd * ga.y, y[2] * rstd * ga.z, y[3] * rstd * ga.w};
    *(f32x4*)(op + 4) = (f32x4){y[4] * rstd * gb.x, y[5] * rstd * gb.y, y[6] * rstd * gb.z, y[7] * rstd * gb.w};
    *(f32x4*)(op + 512) = (f32x4){y[8] * rstd * gc.x, y[9] * rstd * gc.y, y[10] * rstd * gc.z, y[11] * rstd * gc.w};
    *(f32x4*)(op + 516) = (f32x4){y[12] * rstd * gd.x, y[13] * rstd * gd.y, y[14] * rstd * gd.z, y[15] * rstd * gd.w};
}

constexpr int NPHASE = 14;
__global__ void __launch_bounds__(NTHR, 2) hybrid_fwd(Args args) {
    extern __shared__ __attribute__((aligned(16))) unsigned char lds_raw[];
    LAS unsigned char* lds = (LAS unsigned char*)lds_raw;
    unsigned char* ws = args.ws;
    const int tid = threadIdx.x, lane = tid & 63, wave = __builtin_amdgcn_readfirstlane(tid >> 6);
    const int G = gridDim.x, bx = blockIdx.x;
    const int gw = bx * NWAVES + wave, NGW = G * NWAVES;
    const int lo = args.ph_lo, hi = args.ph_hi;
    const bool coop = (hi - lo) > 1;
#ifndef PH_MASK
#define PH_MASK 0x3fff
#endif
#define IN(k) (((PH_MASK >> (k)) & 1) && lo <= (k) && (k) < hi)
#define SEAM(k) do { if (coop && IN(k) && IN((k) + 1)) cg::this_grid().sync(); } while (0)
    const float* x = args.in[0];
    EpiAll ea; ea.mode = 0; ea.ws = ws; ea.x = x; ea.cmp_pos = args.in[6]; ea.part = nullptr;

    if (IN(0)) {
        LAS float* scr = (LAS float*)(lds + wave * 16384);
        constexpr int I_WIN = 16 * 160, I_C1 = 32 * 8, I_AB = 8 * 32, I_OUT = 16 * 32, I_CQ = 16 * 16, I_CKV = 16 * 32, I_CO = 8 * 32;
        constexpr int NIT = I_WIN + 2 * I_C1 + 2 * I_AB + I_OUT + I_CQ + I_CKV + I_CO;
        for (int it = gw; it < NIT; it += NGW) {
            int r = it;
            if (r < I_WIN) { transpose_item(args.in[3], 1024, NIN, 160, (bf16*)(ws + WS_WIN_T), scr, r, lane); continue; } r -= I_WIN;
            if (r < I_C1) { transpose_item(args.in[7], 2048, 256, 8, (bf16*)(ws + WS_CKW1_T), scr, r, lane); continue; } r -= I_C1;
            if (r < I_C1) { transpose_item(args.in[9], 2048, 256, 8, (bf16*)(ws + WS_CVW1_T), scr, r, lane); continue; } r -= I_C1;
            if (r < I_AB) { transpose_item(args.in[11], 512, 1024, 32, (bf16*)(ws + WS_WA_T), scr, r, lane); continue; } r -= I_AB;
            if (r < I_AB) { transpose_item(args.in[12], 512, 1024, 32, (bf16*)(ws + WS_WB_T), scr, r, lane); continue; } r -= I_AB;
            if (r < I_OUT) { transpose_item(args.in[13], 1024, 1024, 32, (bf16*)(ws + WS_WOUT_T), scr, r, lane); continue; } r -= I_OUT;
            if (r < I_CQ) { transpose_item(args.in[16], 1024, 512, 16, (bf16*)(ws + WS_WCQ_T), scr, r, lane); continue; } r -= I_CQ;
            if (r < I_CKV) { transpose_item(args.in[17], 1024, 1024, 32, (bf16*)(ws + WS_WCKV_T), scr, r, lane); continue; } r -= I_CKV;
            transpose_item(args.in[18], 512, 1024, 32, (bf16*)(ws + WS_WCO_T), scr, r, lane);
        }
        for (int m = gw; m < T; m += NGW) rms_row_to_bf16(x + (size_t)m * D, args.in[2], (bf16*)(ws + WS_U) + (size_t)m * D, lane);
        for (int m = gw; m < 512; m += NGW) rms_row_to_bf16(args.in[1] + (size_t)m * D, args.in[15], (bf16*)(ws + WS_MEMN) + (size_t)m * D, lane);
        __syncthreads();
        {
            LAS float* skl = (LAS float*)lds;
            LAS float* wql = (LAS float*)(lds + 128 * 132 * 4);
            const float* SK = args.in[21]; const float* WQ = args.in[20];
            for (int item = bx; item < 256; item += G) {
                const int hc = item >> 4, k0 = (item & 15) * 64;
                for (int e = tid; e < 128 * 128; e += NTHR) { const int key = e >> 7, d = e & 127; skl[d * 132 + key] = SK[(size_t)(hc * 128 + key) * 128 + d]; }
                for (int e = tid; e < 64 * 128; e += NTHR) { const int k = e >> 7, d = e & 127; wql[d * 68 + k] = WQ[(size_t)(k0 + k) * 2048 + hc * 128 + d]; }
                __syncthreads();
                const int key4 = (tid & 31) * 4, kk4 = (tid >> 5) * 4;
                float acc[4][4];
#pragma unroll
                for (int i = 0; i < 4; ++i)
#pragma unroll
                    for (int j = 0; j < 4; ++j) acc[i][j] = 0.f;
                for (int d = 0; d < 128; ++d) {
                    const f32x4 av = *(const LAS f32x4*)(skl + d * 132 + key4), bv = *(const LAS f32x4*)(wql + d * 68 + kk4);
#pragma unroll
                    for (int i = 0; i < 4; ++i)
#pragma unroll
                        for (int j = 0; j < 4; ++j) acc[i][j] += av[i] * bv[j];
                }
#pragma unroll
                for (int i = 0; i < 4; ++i) { v2u w; w.x = pk2(acc[i][0], acc[i][1]); w.y = pk2(acc[i][2], acc[i][3]);
                    *(v2u*)((bf16*)(ws + WS_WPS_T) + (size_t)(hc * 128 + key4 + i) * 1024 + k0 + kk4) = w; }
                __syncthreads();
            }
        }
    }
    SEAM(0);
    if (IN(1)) { ea.mode = EM_G1; run_gemm(lds, (const bf16*)(ws + WS_U), (const bf16*)(ws + WS_WIN_T), T, NIN_PAD, 1024, 1024, G, bx, ea); }
    SEAM(1);
    if (IN(2)) {
        if (bx < 64) {
            const int ci = bx >> 2, kv = ci >> 3, sp = ci & 7;
            ea.mode = EM_PART; ea.part = (float*)(ws + WS_HIDP) + (size_t)ci * 1024 * 256;
            run_gemm(lds, (const bf16*)(ws + (kv ? WS_VCI : WS_KCI)) + sp * 256, (const bf16*)(ws + (kv ? WS_CVW1_T : WS_CKW1_T)) + sp * 256, 1024, 256, 256, 2048, G, bx & 3, ea);
        } else {
            ea.mode = EM_KVMEM;
            run_gemm(lds, (const bf16*)(ws + WS_MEMN), (const bf16*)(ws + WS_WCKV_T), 512, 1024, 1024, 1024, G, (bx >= 128 && bx < 136) ? bx - 128 : 1 << 20, ea);
        }
    }
    SEAM(2);
    if (IN(3)) {
        LAS float* hl = (LAS float*)lds;
        const float* HP = (const float*)(ws + WS_HIDP);
        for (int it = bx; it < 256; it += G) {
            for (int e = tid; e < 2048; e += NTHR) { const int kv = e >> 10, rr = (e >> 8) & 3, c = e & 255, row = it * 4 + rr; float s_ = 0.f;
#pragma unroll
                for (int sp = 0; sp < 8; ++sp) s_ += HP[((size_t)((kv * 8 + sp) * 1024 + row)) * 256 + c];
                hl[e] = gelu_erf(s_); }
            __syncthreads();
            { const int kv = tid >> 8, rr = (tid >> 6) & 3, d = tid & 63, row = it * 4 + rr; const float* w2 = kv ? args.in[10] : args.in[8]; float a_ = 0.f;
              for (int j = 0; j < 256; ++j) a_ += hl[(kv * 4 + rr) * 256 + j] * w2[j * 64 + d];
              if (kv == 0) ((bf16*)(ws + WS_KCMP))[(size_t)row * 64 + d] = f2bf1(a_);
              else ((bf16*)(ws + WS_VCMP_T))[((size_t)((row >> 8) * 64 + d)) * 256 + (row & 255)] = f2bf1(a_); }
            __syncthreads();
        }
    }
    SEAM(3);
    if (IN(4)) {
        unsigned* qctr = (unsigned*)(ws + WS_CTL) + 1024 + 64 * (bx & 7);
        LAS float* wl = (LAS float*)(lds + wave * 16384);
        const int xq = bx & 7;
        for (;;) {
            int n = 0;
            if (lane == 0) n = (int)atomicAdd(qctr, 1u);
            n = __builtin_amdgcn_readfirstlane(n);
            if (n >= 256 + 1024) break;
#ifndef NO_DIFF
            if (n < 256) diff_item(ws, args.in[4], args.in[5], xq, 255 - n, wl, lane);
#else
            if (n < 256) {}
#endif
#ifndef NO_NSA
            else { const int idx = n - 256; nsa_item(ws, xq >> 1, 2047 - (2 * idx + (xq & 1)), wl, lane); }
#endif
        }
    }
    SEAM(4);
    if (IN(5)) {
        ea.mode = EM_MA; run_gemm(lds, (const bf16*)(ws + WS_OA), (const bf16*)(ws + WS_WA_T), T, 1024, 512, 512, G, bx, ea);
        ea.mode = EM_MB; run_gemm(lds, (const bf16*)(ws + WS_OB), (const bf16*)(ws + WS_WB_T), T, 1024, 512, 512, G, bx, ea);
    }
    SEAM(5);
    if (IN(6)) { ea.mode = EM_H1; run_gemm(lds, (const bf16*)(ws + WS_U), (const bf16*)(ws + WS_WOUT_T), T, 1024, 1024, 1024, G, bx, ea); }
    SEAM(6);
    if (IN(7)) {
        for (int m = gw; m < T; m += NGW) rms_row_to_bf16((const float*)(ws + WS_H) + (size_t)m * D, args.in[14], (bf16*)(ws + WS_U) + (size_t)m * D, lane);
        const size_t NV = (size_t)16384 * 1024 / 8;
        for (size_t e = (size_t)gw * 64 + lane; e < 2 * NV; e += (size_t)NGW * 64) {
            const bool second = e >= NV; const size_t ee = second ? e - NV : e;
            const float* src = (second ? args.in[23] : args.in[22]) + ee * 8; bf16* dst = (bf16*)(ws + (second ? WS_PV : WS_PU)) + ee * 8;
            const f32x4 a0 = *(const f32x4*)src, a1 = *(const f32x4*)(src + 4);
            v4u w; w.x = pk2(a0.x, a0.y); w.y = pk2(a0.z, a0.w); w.z = pk2(a1.x, a1.y); w.w = pk2(a1.z, a1.w); *(v4u*)dst = w;
        }
    }
    SEAM(7);
    if (IN(8)) { ea.mode = EM_QC; run_gemm(lds, (const bf16*)(ws + WS_U), (const bf16*)(ws + WS_WCQ_T), T, 512, 1024, 1024, G, bx, ea); }
    SEAM(8);
    if (IN(9)) { for (int it = gw; it < 4096; it += NGW) cross_item(ws, it >> 2, it & 3, lane); }
    SEAM(9);
    if (IN(10)) { ea.mode = EM_H2; run_gemm(lds, (const bf16*)(ws + WS_OC), (const bf16*)(ws + WS_WCO_T), T, 1024, 512, 512, G, bx, ea); }
    SEAM(10);
    if (IN(11)) { for (int m = gw; m < T; m += NGW) rms_row_to_bf16((const float*)(ws + WS_H) + (size_t)m * D, args.in[19], (bf16*)(ws + WS_U) + (size_t)m * D, lane); }
    SEAM(11);
    if (IN(12)) { ea.mode = EM_SC; run_gemm(lds, (const bf16*)(ws + WS_U), (const bf16*)(ws + WS_WPS_T), T, 2048, 1024, 1024, G, bx, ea); }
    SEAM(12);
    if (IN(13)) { for (int tok = gw; tok < T; tok += NGW) peer_token(ws, args.in[24], args.out, tok, lane); }
#undef IN
#undef SEAM
}

#ifndef N_LAUNCH_MODE
#define N_LAUNCH_MODE 1
#endif
extern "C" void kernel_launch(void* const* d_in, const int* in_sizes, int n_in, void* d_out, int out_size, void* d_ws, size_t ws_size, hipStream_t stream) {
    static int grid = 0;
    if (grid == 0) {
        if (n_in != 25 || out_size != T * D || ws_size < WS_END) { fprintf(stderr, "kernel_launch: unexpected shapes (n_in %d out %d ws %zu)\n", n_in, out_size, ws_size); grid = -1; return; }
        int dev = 0, cus = 0, per_cu = 0;
        hipGetDevice(&dev); hipDeviceGetAttribute(&cus, hipDeviceAttributeMultiprocessorCount, dev);
        if (hipFuncSetAttribute((const void*)hybrid_fwd, hipFuncAttributeMaxDynamicSharedMemorySize, LDS_BYTES) != hipSuccess) { fprintf(stderr, "kernel_launch: hipFuncSetAttribute failed\n"); grid = -1; return; }
        if (hipOccupancyMaxActiveBlocksPerMultiprocessor(&per_cu, (const void*)hybrid_fwd, NTHR, LDS_BYTES) != hipSuccess || per_cu < 1) { fprintf(stderr, "kernel_launch: occupancy query says %d\n", per_cu); per_cu = 1; }
        (void)hipGetLastError();
        grid = cus * 1;
        if (grid > 256) grid = 256;
    }
    if (grid < 0) return;
    hipMemsetAsync((char*)d_ws + WS_CTL, 0, CTL_BYTES, stream);
    Args a{};
    for (int i = 0; i < 25; ++i) a.in[i] = (const float*)d_in[i];
    a.out = (float*)d_out; a.ws = (unsigned char*)d_ws;
#if N_LAUNCH_MODE == 1
    a.ph_lo = 0; a.ph_hi = NPHASE;
    void* kargs[] = {&a};
    hipError_t e = hipLaunchCooperativeKernel((const void*)hybrid_fwd, dim3(grid), dim3(NTHR), kargs, LDS_BYTES, stream);
    if (e != hipSuccess) fprintf(stderr, "cooperative launch failed: %s (grid %d)\n", hipGetErrorString(e), grid);
#else
    for (int p = 0; p < NPHASE; ++p) { a.ph_lo = p; a.ph_hi = p + 1; hipLaunchKernelGGL(hybrid_fwd, dim3(grid), dim3(NTHR), LDS_BYTES, stream, a); }
#endif
}
```

```cpp
#include <hip/hip_runtime.h>
#include <hip/hip_cooperative_groups.h>
#include <cstdio>
#include <cstdint>
namespace cg = cooperative_groups;
namespace pg8 {
#define PG8_LAS __attribute__((address_space(3)))
typedef unsigned short bf16_t;
typedef short bf16x8 __attribute__((ext_vector_type(8)));
typedef float f32x4 __attribute__((ext_vector_type(4)));
typedef unsigned u32x4 __attribute__((ext_vector_type(4)));
constexpr int BM = 256, BK = 64, HALF = 128, HTB = HALF * BK * 2  , STAGE_BYTES = 8 * HTB, NXCD = 8, WGM = 8;

__host__ __device__ __forceinline__ int lds_byte(int r, int c) { const int st = (r >> 4) * 2 + (c >> 5), rr = r & 15, cc = c & 31, ob = rr * 64 + cc * 2; return st * 1024 + (ob ^ (((ob >> 9) & 1) << 5)); }
__host__ __device__ __forceinline__ void stage_rc(int b, int& R, int& C) { const int st = b / 1024, sb = b % 1024, swz = sb ^ (((sb >> 9) & 1) << 5); R = (st >> 1) * 16 + swz / 64; C = (st & 1) * 32 + (swz % 64) / 2; }
__host__ __device__ __forceinline__ int perm32(int rho) { const int n = rho >> 4, i = rho & 15; return 8 * (i >> 2) + 4 * n + (i & 3); }

struct Unit { int pm, pn; };
struct Gemm { const bf16_t* A; const bf16_t* Bt; int M, N, K, ld; };

struct StaticOrder {
    int nM, nN, nwg, G, c;
    __host__ __device__ void init(int M, int N, int G_, int c_) { nM = M / BM; nN = N / BM; nwg = nM * nN; G = G_; c = c_; }
    __host__ __device__ bool next(int i, Unit& u) const {
        const long L = (long)i * G + c; if (L >= nwg) return false;
        int wgid = (int)L; { const int q = nwg / NXCD, r = nwg % NXCD, xcd = wgid % NXCD, off = wgid / NXCD; wgid = (xcd < r ? xcd * (q + 1) : r * (q + 1) + (xcd - r) * q) + off; }
        const int nig = WGM * nN, gid = wgid / nig, fm = gid * WGM, gsz = (nM - fm) < WGM ? (nM - fm) : WGM;
        u.pm = fm + ((wgid % nig) % gsz); u.pn = (wgid % nig) / gsz; return true;
    }
    __device__ __forceinline__ void a_ready(const Unit&) const {}
    __device__ __forceinline__ void done(const Unit&) const {}
};

__device__ __forceinline__ unsigned cvt_pk_bf16(float lo, float hi) { unsigned r; asm volatile("v_cvt_pk_bf16_f32 %0, %1, %2" : "=v"(r) : "v"(lo), "v"(hi)); return r; }
template <class F> struct EpiF {
    static constexpr bool PERM = true, AFTER_DRAIN = false;
    F f;
    __device__ __forceinline__ void operator()(const f32x4 (&acc)[2][2][4][2], const Unit& u, int wr, int wc, int fr, int fq) const {
        const int row0 = u.pm * BM + wr * 64 + fr, col0 = u.pn * BM + wc * 32 + 8 * fq;
#pragma unroll
        for (int ai = 0; ai < 2; ++ai)
#pragma unroll
            for (int m = 0; m < 4; ++m)
#pragma unroll
                for (int bj = 0; bj < 2; ++bj) f(row0 + ai * HALF + m * 16, col0 + bj * HALF, acc[ai][bj][m][0], acc[ai][bj][m][1]);
    }
};
template <class Epi, class Sched, bool ALIGN_EPI = false, bool SP2 = false>
__device__ __forceinline__ void gemm_phase(PG8_LAS unsigned char* lds, const Gemm g, const Sched& S, const Epi& E) {
    const int tid = threadIdx.x, wid = __builtin_amdgcn_readfirstlane(tid >> 6), lane = tid & 63, wr = wid >> 2, wc = wid & 3, fr = lane & 15, fq = lane >> 4;
    const int K = g.K, nt = K / BK;
    unsigned voffA[2], voffB[2];
#pragma unroll
    for (int i = 0; i < 2; ++i) { int R, C; stage_rc(tid * 16 + i * 8192, R, C); const int Rb = Epi::PERM ? ((R & ~31) + perm32(R & 31)) : R;
        voffA[i] = (unsigned)(R * g.ld + C) * 2u; voffB[i] = (unsigned)(Rb * g.ld + C) * 2u; }
    const size_t kstep = (size_t)(BK * 2);
    const size_t hstep = (size_t)HALF * g.ld * 2;
    const size_t tstep = 2 * hstep;
    const unsigned ldsw = (unsigned)wid * 1024u;
    const int aoff = lds_byte(wr * 64 + fr, fq * 8), boff = lds_byte(wc * 32 + fr, fq * 8);
#define PG8_SA(b, h) (((b) * 2 + (h)) * HTB)
#define PG8_SB(b, h) ((4 + (b) * 2 + (h)) * HTB)
#define PG8_STAGE(bufoff, gbase, voff) do { _Pragma("unroll") for (int _i = 0; _i < 2; ++_i) \
        __builtin_amdgcn_global_load_lds((const unsigned*)((const char*)(gbase) + (voff)[_i]), (PG8_LAS unsigned*)(lds + (bufoff) + ldsw + _i * 8192), 16, 0, 0); } while (0)
#define PG8_LDA(dst, b, h) do { _Pragma("unroll") for (int m = 0; m < 4; ++m) _Pragma("unroll") for (int k = 0; k < 2; ++k) dst[m][k] = *(const PG8_LAS bf16x8*)(lds + PG8_SA(b, h) + aoff + m * 2048 + k * 1024); } while (0)
#define PG8_LDB(dst, b, h) do { _Pragma("unroll") for (int n = 0; n < 2; ++n) _Pragma("unroll") for (int k = 0; k < 2; ++k) dst[n][k] = *(const PG8_LAS bf16x8*)(lds + PG8_SB(b, h) + boff + n * 2048 + k * 1024); } while (0)
#define PG8_MMA(ai, bj, At, Bt) do { __builtin_amdgcn_s_setprio(1); _Pragma("unroll") for (int m = 0; m < 4; ++m) _Pragma("unroll") for (int n = 0; n < 2; ++n) _Pragma("unroll") for (int k = 0; k < 2; ++k) \
        acc[ai][bj][m][n] = __builtin_amdgcn_mfma_f32_16x16x32_bf16(Bt[n][k], At[m][k], acc[ai][bj][m][n], 0, 0, 0); __builtin_amdgcn_s_setprio(0); } while (0)
#define PG8_WAIT_V(n) asm volatile("s_waitcnt vmcnt(" #n ")" ::: "memory")
#define PG8_WAIT_L(n) asm volatile("s_waitcnt lgkmcnt(" #n ")" ::: "memory")
#define PG8_BAR __builtin_amdgcn_s_barrier()
#define PG8_SCHED __builtin_amdgcn_sched_barrier(0)
    Unit cur, nxt; int ui = 0;
    if (!S.next(0, cur)) return;
    f32x4 acc[2][2][4][2];
#pragma unroll
    for (int a = 0; a < 2; ++a)
#pragma unroll
        for (int b = 0; b < 2; ++b)
#pragma unroll
            for (int m = 0; m < 4; ++m)
#pragma unroll
                for (int n = 0; n < 2; ++n) acc[a][b][m][n] = (f32x4){0.f, 0.f, 0.f, 0.f};
    bf16x8 At[4][2], B0[2][2], B1[2][2];
    const char* cA = (const char*)g.A + (size_t)cur.pm * tstep; const char* cB = (const char*)g.Bt + (size_t)cur.pn * tstep;
    S.a_ready(cur);
    if constexpr (SP2) {
        PG8_STAGE(PG8_SB(0, 0), cB, voffB); PG8_STAGE(PG8_SB(0, 1), cB + hstep, voffB); PG8_STAGE(PG8_SA(0, 0), cA, voffA); PG8_STAGE(PG8_SA(0, 1), cA + hstep, voffA);
        if (wr == 1) PG8_BAR;
        PG8_WAIT_V(2); PG8_BAR;
        PG8_STAGE(PG8_SB(1, 0), cB + kstep, voffB); PG8_STAGE(PG8_SA(1, 0), cA + kstep, voffA); PG8_STAGE(PG8_SB(1, 1), cB + hstep + kstep, voffB);
        PG8_WAIT_V(6); PG8_BAR;
    } else {
        PG8_STAGE(PG8_SB(0, 0), cB, voffB); PG8_STAGE(PG8_SA(0, 0), cA, voffA); PG8_STAGE(PG8_SB(0, 1), cB + hstep, voffB); PG8_STAGE(PG8_SA(0, 1), cA + hstep, voffA);
        if (wr == 1) PG8_BAR;
        PG8_WAIT_V(4); PG8_BAR;
        PG8_STAGE(PG8_SB(1, 0), cB + kstep, voffB); PG8_STAGE(PG8_SA(1, 0), cA + kstep, voffA); PG8_STAGE(PG8_SB(1, 1), cB + hstep + kstep, voffB);
        PG8_WAIT_V(6); PG8_BAR;
    }
    for (;;) {
        const bool has_next = S.next(ui + 1, nxt);
        const char* nA = has_next ? (const char*)g.A + (size_t)nxt.pm * tstep : cA; const char* nB = has_next ? (const char*)g.Bt + (size_t)nxt.pn * tstep : cB;
        for (int t = 0; t < nt; t += 2) {
            const bool last = (t == nt - 2);
            const char* a1 = cA + (size_t)(t + 1) * kstep;
            const char* a2 = last ? nA : cA + (size_t)(t + 2) * kstep; const char* b2 = last ? nB : cB + (size_t)(t + 2) * kstep;
            const char* a3 = a2 + kstep; const char* b3 = b2 + kstep;
            if (last && has_next) S.a_ready(nxt);
            if constexpr (SP2) {
            PG8_LDB(B0, 0, 0); PG8_LDB(B1, 0, 1); PG8_SCHED; PG8_LDA(At, 0, 0); PG8_STAGE(PG8_SA(1, 1), a1 + hstep, voffA);
            PG8_WAIT_V(8); PG8_WAIT_L(0); PG8_BAR; PG8_MMA(0, 0, At, B0); PG8_MMA(0, 1, At, B1); PG8_BAR; PG8_SCHED;
            PG8_LDA(At, 0, 1); PG8_STAGE(PG8_SB(0, 0), b2, voffB); PG8_STAGE(PG8_SB(0, 1), b2 + hstep, voffB); PG8_STAGE(PG8_SA(0, 0), a2, voffA);
            PG8_WAIT_V(8); PG8_WAIT_L(0); PG8_BAR; PG8_MMA(1, 0, At, B0); PG8_MMA(1, 1, At, B1); PG8_BAR; PG8_SCHED;
            PG8_LDB(B0, 1, 0); PG8_LDB(B1, 1, 1); PG8_SCHED; PG8_LDA(At, 1, 0); PG8_STAGE(PG8_SA(0, 1), a2 + hstep, voffA);
            PG8_WAIT_V(8); PG8_WAIT_L(0); PG8_BAR; PG8_MMA(0, 0, At, B0); PG8_MMA(0, 1, At, B1); PG8_BAR; PG8_SCHED;
            PG8_LDA(At, 1, 1); PG8_STAGE(PG8_SB(1, 0), b3, voffB); PG8_STAGE(PG8_SB(1, 1), b3 + hstep, voffB); PG8_STAGE(PG8_SA(1, 0), a3, voffA);
            PG8_WAIT_V(8); PG8_WAIT_L(0); PG8_BAR; PG8_MMA(1, 0, At, B0); PG8_MMA(1, 1, At, B1); PG8_BAR; PG8_SCHED;
            } else {
            PG8_LDB(B0, 0, 0); PG8_SCHED; PG8_LDA(At, 0, 0); PG8_STAGE(PG8_SA(1, 1), a1 + hstep, voffA);
            PG8_WAIT_L(8); PG8_BAR; PG8_WAIT_L(0); PG8_MMA(0, 0, At, B0); PG8_BAR; PG8_SCHED;
            PG8_LDB(B1, 0, 1); PG8_STAGE(PG8_SB(0, 0), b2, voffB);
            PG8_BAR; PG8_WAIT_L(0); PG8_MMA(0, 1, At, B1); PG8_BAR;
            PG8_LDA(At, 0, 1); PG8_STAGE(PG8_SA(0, 0), a2, voffA);
            PG8_BAR; PG8_WAIT_L(0); PG8_MMA(1, 0, At, B0); PG8_BAR; PG8_SCHED;
            PG8_STAGE(PG8_SB(0, 1), b2 + hstep, voffB);
            PG8_WAIT_V(6); PG8_BAR; PG8_MMA(1, 1, At, B1); PG8_BAR;
            PG8_LDB(B0, 1, 0); PG8_SCHED; PG8_LDA(At, 1, 0); PG8_STAGE(PG8_SA(0, 1), a2 + hstep, voffA);
            PG8_WAIT_L(8); PG8_BAR; PG8_WAIT_L(0); PG8_MMA(0, 0, At, B0); PG8_BAR; PG8_SCHED;
            PG8_LDB(B1, 1, 1); PG8_STAGE(PG8_SB(1, 0), b3, voffB);
            PG8_BAR; PG8_WAIT_L(0); PG8_MMA(0, 1, At, B1); PG8_BAR;
            PG8_LDA(At, 1, 1); PG8_STAGE(PG8_SA(1, 0), a3, voffA);
            PG8_BAR; PG8_WAIT_L(0); PG8_MMA(1, 0, At, B0); PG8_BAR; PG8_SCHED;
            PG8_STAGE(PG8_SB(1, 1), b3 + hstep, voffB);
            PG8_WAIT_V(6); PG8_BAR; PG8_MMA(1, 1, At, B1); PG8_BAR;
            }
        }
        if constexpr (ALIGN_EPI) { if (wr == 0) PG8_BAR; }
        if constexpr (!Epi::AFTER_DRAIN) { E(acc, cur, wr, wc, fr, fq); S.done(cur); }
        if (!has_next) break;
#pragma unroll
        for (int a = 0; a < 2; ++a)
#pragma unroll
            for (int b = 0; b < 2; ++b)
#pragma unroll
                for (int m = 0; m < 4; ++m)
#pragma unroll
                    for (int n = 0; n < 2; ++n) acc[a][b][m][n] = (f32x4){0.f, 0.f, 0.f, 0.f};
        cur = nxt; cA = nA; cB = nB; ++ui;
        if constexpr (ALIGN_EPI) { if (wr == 1) PG8_BAR; }
    }
    PG8_WAIT_V(0);
    if constexpr (!ALIGN_EPI) { if (wr == 0) PG8_BAR; }
    PG8_BAR;
    if constexpr (Epi::AFTER_DRAIN) { E.fused(acc, cur, wr, wc, fr, fq, lds, wid, lane); S.done(cur); }
#undef PG8_SA
#undef PG8_SB
#undef PG8_STAGE
#undef PG8_LDA
#undef PG8_LDB
#undef PG8_MMA
#undef PG8_WAIT_V
#undef PG8_WAIT_L
#undef PG8_BAR
#undef PG8_SCHED
}
}

#define LAS __attribute__((address_space(3)))
typedef unsigned short bf16;
typedef unsigned v4u __attribute__((ext_vector_type(4)));
typedef unsigned v2u __attribute__((ext_vector_type(2)));
typedef float f32x4 __attribute__((ext_vector_type(4)));
typedef short bf16x8 __attribute__((ext_vector_type(8)));
#define LDS_WAIT() asm volatile("s_waitcnt lgkmcnt(0)" ::: "memory")
#define MFMA16(a, b, c) __builtin_amdgcn_mfma_f32_16x16x32_bf16((a), (b), (c), 0, 0, 0)

constexpr int NWAVES = 8, NTHR = 512;
constexpr int NB = 2, S = 8192, T = NB * S, D = 1024;
constexpr int LDS_BYTES = 147456;
constexpr float LOG2E = 1.4426950408889634f;
constexpr int NIN = 4888, NIN_PAD = 5120;

constexpr size_t MiB = 1u << 20;
constexpr size_t WS_CTL = 0, CTL_BYTES = 1 * MiB;
constexpr size_t WS_MEMN = 1 * MiB, WS_WIN_T = 2 * MiB, WS_CKW1_T = 12 * MiB, WS_CVW1_T = 13 * MiB, WS_WA_T = 14 * MiB, WS_WB_T = 15 * MiB, WS_WOUT_T = 16 * MiB,
                 WS_WCQ_T = 18 * MiB, WS_WCKV_T = 19 * MiB, WS_WCO_T = 21 * MiB, WS_WPS_T = 22 * MiB;
constexpr size_t WS_KCMP = 26 * MiB, WS_VCMP_T = 26 * MiB + 256 * 1024, WS_KMEM = 27 * MiB, WS_VMEM_T = 27 * MiB + 512 * 1024, WS_GB = 28 * MiB;
constexpr size_t WS_U = 32 * MiB;
constexpr size_t WS_QA = 64 * MiB, WS_KA = 80 * MiB, WS_VAT = 96 * MiB, WS_QB = 112 * MiB;
constexpr size_t WS_PU = 64 * MiB, WS_PV = 96 * MiB;
constexpr size_t WS_KCI = 128 * MiB, WS_VCI = 132 * MiB, WS_KS = 136 * MiB, WS_VST = 140 * MiB, WS_KW = 144 * MiB, WS_VWT = 148 * MiB;
constexpr size_t WS_OA = 152 * MiB, WS_OB = 168 * MiB, WS_HIDP = 152 * MiB;
constexpr size_t WS_GA = 184 * MiB, WS_GBT = 216 * MiB;
constexpr size_t WS_H = 192 * MiB;
constexpr size_t WS_QC = 128 * MiB, WS_OC = 144 * MiB, WS_SCORES = 128 * MiB;
constexpr size_t WS_END = 256 * MiB;

__device__ __forceinline__ unsigned pk2(float lo, float hi) { return pg8::cvt_pk_bf16(lo, hi); }
__device__ __forceinline__ unsigned short f2bf1(float f) { return (unsigned short)(pk2(f, 0.f) & 0xffffu); }
__device__ __forceinline__ float bflo(unsigned u) { return __builtin_bit_cast(float, u << 16); }
__device__ __forceinline__ float bfhi(unsigned u) { return __builtin_bit_cast(float, u & 0xffff0000u); }
__device__ __forceinline__ float wave_sum(float v) {
#pragma unroll
    for (int o = 1; o < 64; o <<= 1) v += __shfl_xor(v, o);
    return v;
}
__device__ __forceinline__ float sigm(float x) { return 1.f / (1.f + __expf(-x)); }
__device__ __forceinline__ float gelu_erf(float x) { return 0.5f * x * (1.f + erff(x * 0.70710678118654752f)); }
__device__ __forceinline__ float ex2(float x) { return __builtin_amdgcn_exp2f(x); }
__device__ __forceinline__ void store8bf(bf16* dst, const float* v) { v4u w; w.x = pk2(v[0], v[1]); w.y = pk2(v[2], v[3]); w.z = pk2(v[4], v[5]); w.w = pk2(v[6], v[7]); *(v4u*)dst = w; }
__device__ __forceinline__ bf16x8 ldg8(const bf16* p) { return *(const bf16x8*)p; }
__device__ __forceinline__ bf16x8 pack8(float a0, float a1, float a2, float a3, float a4, float a5, float a6, float a7) {
    v4u w; w.x = pk2(a0, a1); w.y = pk2(a2, a3); w.z = pk2(a4, a5); w.w = pk2(a6, a7); return __builtin_bit_cast(bf16x8, w);
}

struct Args { const float* in[25]; float* out; unsigned char* ws; int ph_lo, ph_hi; };

enum { EM_G1 = 0, EM_PART, EM_KVMEM, EM_MA, EM_MB, EM_H1, EM_QC, EM_H2, EM_SC };
struct EpiAll {
    int mode; unsigned char* ws; const float* x; const float* cmp_pos; float* part;
    __device__ __forceinline__ void operator()(int row, int col, const f32x4& v0, const f32x4& v1) const {
        float v[8] = {v0[0], v0[1], v0[2], v0[3], v1[0], v1[1], v1[2], v1[3]};
        switch (mode) {
        case EM_G1: {
            if (col >= NIN) return;
            const int b = row >> 13, s = row & (S - 1);
            if (col < 1024) {
                const bool isq = col < 512; bf16* dst = (bf16*)(ws + (isq ? WS_QA : WS_KA)) + (size_t)row * 512 + (col & 511);
                const float sc = isq ? 0.125f : 1.f;
#pragma unroll
                for (int i = 0; i < 8; ++i) v[i] *= sc;
                store8bf(dst, v);
            } else if (col < 1536) {
                bf16* dst = (bf16*)(ws + WS_VAT) + (size_t)(b * 512 + (col - 1024)) * S + s;
#pragma unroll
                for (int i = 0; i < 8; ++i) dst[(size_t)i * S] = f2bf1(v[i]);
            } else if (col < 2048) {
#pragma unroll
                for (int i = 0; i < 8; ++i) v[i] *= 0.125f;
                store8bf((bf16*)(ws + WS_QB) + (size_t)row * 512 + (col - 1536), v);
            } else if (col < 2816) {
                const int c2 = col - 2048, j = c2 >> 7, gg = (c2 >> 6) & 1, d = c2 & 63; const size_t bg = (size_t)(b * 2 + gg);
                if (j == 0 || j == 1) {
                    const float* cp = cmp_pos + (s & 31) * 64 + d;
#pragma unroll
                    for (int i = 0; i < 8; ++i) v[i] += cp[i];
                    store8bf((bf16*)(ws + (j == 0 ? WS_KCI : WS_VCI)) + (bg * S + s) * 64 + d, v);
                } else if (j == 2 || j == 4) {
                    store8bf((bf16*)(ws + (j == 2 ? WS_KS : WS_KW)) + (bg * S + s) * 64 + d, v);
                } else {
                    bf16* dst = (bf16*)(ws + (j == 3 ? WS_VST : WS_VWT)) + (bg * 64 + d) * S + s;
#pragma unroll
                    for (int i = 0; i < 8; ++i) dst[(size_t)i * S] = f2bf1(v[i]);
                }
            } else if (col < 2840) {
                float* dst = (float*)(ws + WS_GB) + (size_t)row * 24 + (col - 2816);
                *(f32x4*)dst = (f32x4){sigm(v[0]), sigm(v[1]), sigm(v[2]), sigm(v[3])}; *(f32x4*)(dst + 4) = (f32x4){sigm(v[4]), sigm(v[5]), sigm(v[6]), sigm(v[7])};
            } else {
                const bool ia = col < 3864; bf16* dst = (bf16*)(ws + (ia ? WS_GA : WS_GBT)) + (size_t)row * 1024 + (col - (ia ? 2840 : 3864));
#pragma unroll
                for (int i = 0; i < 8; ++i) v[i] = sigm(v[i]);
                store8bf(dst, v);
            }
        } break;
        case EM_PART: { float* dst = part + (size_t)row * 256 + col; *(f32x4*)dst = v0; *(f32x4*)(dst + 4) = v1; } break;
        case EM_KVMEM: {
            const int b = row >> 8, m = row & 255, c2 = col & 511, h = c2 >> 7, d = c2 & 127;
            if (col < 512) store8bf((bf16*)(ws + WS_KMEM) + ((size_t)((b * 4 + h) * 256 + m)) * 128 + d, v);
            else { bf16* dst = (bf16*)(ws + WS_VMEM_T) + ((size_t)((b * 4 + h) * 128 + d)) * 256 + m;
#pragma unroll
                for (int i = 0; i < 8; ++i) dst[i * 256] = f2bf1(v[i]); }
        } break;
        case EM_MA: {
            const v4u gq = *(const v4u*)((const bf16*)(ws + WS_GA) + (size_t)row * 1024 + col);
            const float g[8] = {bflo(gq.x), bfhi(gq.x), bflo(gq.y), bfhi(gq.y), bflo(gq.z), bfhi(gq.z), bflo(gq.w), bfhi(gq.w)};
#pragma unroll
            for (int i = 0; i < 8; ++i) v[i] *= g[i];
            store8bf((bf16*)(ws + WS_U) + (size_t)row * 1024 + col, v);
        } break;
        case EM_MB: {
            const v4u gq = *(const v4u*)((const bf16*)(ws + WS_GBT) + (size_t)row * 1024 + col);
            bf16* mp = (bf16*)(ws + WS_U) + (size_t)row * 1024 + col; const v4u mq = *(const v4u*)mp;
            const float g[8] = {bflo(gq.x), bfhi(gq.x), bflo(gq.y), bfhi(gq.y), bflo(gq.z), bfhi(gq.z), bflo(gq.w), bfhi(gq.w)};
            const float mm[8] = {bflo(mq.x), bfhi(mq.x), bflo(mq.y), bfhi(mq.y), bflo(mq.z), bfhi(mq.z), bflo(mq.w), bfhi(mq.w)};
#pragma unroll
            for (int i = 0; i < 8; ++i) v[i] = mm[i] + g[i] * v[i];
            store8bf(mp, v);
        } break;
        case EM_H1: {
            const float* xp = x + (size_t)row * 1024 + col; float* hp = (float*)(ws + WS_H) + (size_t)row * 1024 + col;
            const f32x4 x0 = *(const f32x4*)xp, x1 = *(const f32x4*)(xp + 4);
            *(f32x4*)hp = x0 + v0; *(f32x4*)(hp + 4) = x1 + v1;
        } break;
        case EM_QC: {
#pragma unroll
            for (int i = 0; i < 8; ++i) v[i] *= 0.08838834764831845f;
            store8bf((bf16*)(ws + WS_QC) + (size_t)row * 512 + col, v);
        } break;
        case EM_H2: {
            float* hp = (float*)(ws + WS_H) + (size_t)row * 1024 + col;
            const f32x4 x0 = *(const f32x4*)hp, x1 = *(const f32x4*)(hp + 4);
            *(f32x4*)hp = x0 + v0; *(f32x4*)(hp + 4) = x1 + v1;
        } break;
        default: {
            store8bf((bf16*)(ws + WS_SCORES) + (size_t)row * 2048 + col, v);
        } break;
        }
    }
};
typedef pg8::EpiF<EpiAll> EpiT;

__device__ __forceinline__ void run_gemm(LAS unsigned char* lds, const bf16* A, const bf16* Bt, int M, int N, int K, int ld, int G, int c, const EpiAll& ea) {
    pg8::Gemm g{A, Bt, M, N, K, ld}; pg8::StaticOrder So; So.init(M, N, G, c);
    EpiT E{ea};
    pg8::gemm_phase<EpiT, pg8::StaticOrder, true, true>(lds, g, So, E);
}

__device__ __forceinline__ void transpose_item(const float* W, int K, int Nsrc, int nblk, bf16* WT, LAS float* scr, int item, int lane) {
    const int kb = item / nblk, nb = item % nblk, k0 = 64 * kb, n0 = 32 * nb; const int n = n0 + (lane & 31);
#pragma unroll 8
    for (int i = 0; i < 32; ++i) { const int kk = 2 * i + (lane >> 5); scr[kk * 33 + (lane & 31)] = (n < Nsrc) ? W[(size_t)(k0 + kk) * Nsrc + n] : 0.f; }
    LDS_WAIT();
    const int c = lane & 7;
#pragma unroll
    for (int j = 0; j < 4; ++j) { const int nn = (lane >> 3) + 8 * j; const LAS float* s = scr + (8 * c) * 33 + nn;
        v4u o; o.x = pk2(s[0 * 33], s[1 * 33]); o.y = pk2(s[2 * 33], s[3 * 33]); o.z = pk2(s[4 * 33], s[5 * 33]); o.w = pk2(s[6 * 33], s[7 * 33]);
        *(v4u*)(WT + (size_t)(n0 + nn) * K + k0 + 8 * c) = o; }
    LDS_WAIT();
}
__device__ __forceinline__ void rms_row_to_bf16(const float* xrow, const float* g, bf16* orow, int lane) {
    const f32x4* xr = (const f32x4*)xrow + lane; const f32x4* gr = (const f32x4*)g + lane;
    f32x4 v[4]; float s = 0.f;
#pragma unroll
    for (int j = 0; j < 4; ++j) { v[j] = xr[64 * j]; s += (v[j].x * v[j].x + v[j].y * v[j].y) + (v[j].z * v[j].z + v[j].w * v[j].w); }
    const float rstd = rsqrtf(wave_sum(s) * (1.f / D) + 1e-6f);
    v2u* o8 = (v2u*)orow + lane;
#pragma unroll
    for (int j = 0; j < 4; ++j) { const f32x4 gg = gr[64 * j]; v2u w; w.x = pk2(v[j].x * rstd * gg.x, v[j].y * rstd * gg.y); w.y = pk2(v[j].z * rstd * gg.z, v[j].w * rstd * gg.w); o8[64 * j] = w; }
}


__device__ __forceinline__ void diff_item(unsigned char* ws, const float* lamp, const float* subln, int bh, int qt, LAS float* park, int lane) {
    const int b = bh >> 2, h = bh & 3, fr = lane & 15, fq = lane >> 4, q0 = qt * 32;
    float lam;
    { const float a = lamp[lane] * lamp[64 + lane], c = lamp[128 + lane] * lamp[192 + lane]; lam = __expf(wave_sum(a)) - __expf(wave_sum(c)) + 0.2f; }
    const float slope2 = ex2(-2.f * (float)(h + 1)) * LOG2E;
    const bf16* Qb = (const bf16*)(ws + WS_QA) + (size_t)(b * S) * 512 + h * 128;
    const bf16* Kb = (const bf16*)(ws + WS_KA) + (size_t)(b * S) * 512 + h * 128;
    const bf16* Vb = (const bf16*)(ws + WS_VAT) + (size_t)((b * 4 + h) * 128) * S;
    const int kr0 = 8 * (fr >> 2) + (fr & 3);
    const int nsteps = qt + 1;
    for (int c = 0; c < 2; ++c) {
        bf16x8 Qf[2][2];
#pragma unroll
        for (int nt = 0; nt < 2; ++nt)
#pragma unroll
            for (int ks = 0; ks < 2; ++ks) Qf[nt][ks] = ldg8(Qb + (size_t)(q0 + nt * 16 + fr) * 512 + c * 64 + ks * 32 + fq * 8);
        f32x4 O[8][2];
#pragma unroll
        for (int mt = 0; mt < 8; ++mt) { O[mt][0] = (f32x4){0.f, 0.f, 0.f, 0.f}; O[mt][1] = (f32x4){0.f, 0.f, 0.f, 0.f}; }
        float mrun[2] = {-1e30f, -1e30f}, lrun[2] = {0.f, 0.f};
        const bf16* kp = Kb + (size_t)kr0 * 512 + c * 64 + fq * 8;
        bf16x8 Kc[2][2];
#pragma unroll
        for (int t = 0; t < 2; ++t)
#pragma unroll
            for (int ks = 0; ks < 2; ++ks) Kc[t][ks] = ldg8(kp + (size_t)(4 * t) * 512 + ks * 32);
        for (int kb = 0; kb < nsteps; ++kb) {
            bf16x8 Vf[8];
#pragma unroll
            for (int mt = 0; mt < 8; ++mt) Vf[mt] = ldg8(Vb + (size_t)(mt * 16 + fr) * S + kb * 32 + fq * 8);
            const int kbn = (kb + 1 < nsteps) ? kb + 1 : kb;
            bf16x8 Kn[2][2];
#pragma unroll
            for (int t = 0; t < 2; ++t)
#pragma unroll
                for (int ks = 0; ks < 2; ++ks) Kn[t][ks] = ldg8(kp + (size_t)(kbn * 32 + 4 * t) * 512 + ks * 32);
            f32x4 Sx[2][2];
#pragma unroll
            for (int t = 0; t < 2; ++t)
#pragma unroll
                for (int nt = 0; nt < 2; ++nt) { f32x4 z = {0.f, 0.f, 0.f, 0.f}; z = MFMA16(Kc[t][0], Qf[nt][0], z); Sx[t][nt] = MFMA16(Kc[t][1], Qf[nt][1], z); }
            bf16x8 Pf[2];
#pragma unroll
            for (int nt = 0; nt < 2; ++nt) {
                const int qpos = q0 + nt * 16 + fr;
                const float base = (float)(kb * 32 + fq * 8 - qpos);
                float sv[8]; float mx = -1e30f;
#pragma unroll
                for (int t = 0; t < 2; ++t)
#pragma unroll
                    for (int r = 0; r < 4; ++r) { const float kd = base + (float)(4 * t + r); const float val = Sx[t][nt][r] * LOG2E + slope2 * kd; const float s_ = (kd <= 0.f) ? val : -1e30f; sv[t * 4 + r] = s_; mx = fmaxf(mx, s_); }
                mx = fmaxf(mx, __shfl_xor(mx, 16)); mx = fmaxf(mx, __shfl_xor(mx, 32));
                const float mnew = fmaxf(mrun[nt], mx), alpha = ex2(mrun[nt] - mnew); mrun[nt] = mnew;
                float ps = 0.f;
#pragma unroll
                for (int i = 0; i < 8; ++i) { sv[i] = (sv[i] > -1e29f) ? ex2(sv[i] - mnew) : 0.f; ps += sv[i]; }
                lrun[nt] = lrun[nt] * alpha + ps;
#pragma unroll
                for (int mt = 0; mt < 8; ++mt) O[mt][nt] *= alpha;
                Pf[nt] = pack8(sv[0], sv[1], sv[2], sv[3], sv[4], sv[5], sv[6], sv[7]);
            }
#pragma unroll
            for (int mt = 0; mt < 8; ++mt) { O[mt][0] = MFMA16(Vf[mt], Pf[0], O[mt][0]); O[mt][1] = MFMA16(Vf[mt], Pf[1], O[mt][1]); }
#pragma unroll
            for (int t = 0; t < 2; ++t) { Kc[t][0] = Kn[t][0]; Kc[t][1] = Kn[t][1]; }
        }
        float inv[2];
#pragma unroll
        for (int nt = 0; nt < 2; ++nt) { float l = lrun[nt]; l += __shfl_xor(l, 16); l += __shfl_xor(l, 32); inv[nt] = 1.f / l; }
        if (c == 0) {
#pragma unroll
            for (int mt = 0; mt < 8; ++mt)
#pragma unroll
                for (int nt = 0; nt < 2; ++nt)
#pragma unroll
                    for (int r = 0; r < 4; ++r) park[((mt * 2 + nt) * 4 + r) * 64 + lane] = O[mt][nt][r] * inv[nt];
        } else {
            LDS_WAIT();
            float ss[2] = {0.f, 0.f};
#pragma unroll
            for (int mt = 0; mt < 8; ++mt)
#pragma unroll
                for (int nt = 0; nt < 2; ++nt)
#pragma unroll
                    for (int r = 0; r < 4; ++r) { const float v_ = park[((mt * 2 + nt) * 4 + r) * 64 + lane] - lam * (O[mt][nt][r] * inv[nt]); O[mt][nt][r] = v_; ss[nt] += v_ * v_; }
#pragma unroll
            for (int nt = 0; nt < 2; ++nt) {
                float s_ = ss[nt]; s_ += __shfl_xor(s_, 16); s_ += __shfl_xor(s_, 32);
                const float rstd = rsqrtf(s_ * (1.f / 128.f) + 1e-6f) * 0.8f;
                bf16* op = (bf16*)(ws + WS_OA) + (size_t)(b * S + q0 + nt * 16 + fr) * 512 + h * 128 + fq * 4;
#pragma unroll
                for (int mt = 0; mt < 8; ++mt) { const f32x4 gg = *(const f32x4*)(subln + mt * 16 + fq * 4);
                    v2u w; w.x = pk2(O[mt][nt][0] * rstd * gg.x, O[mt][nt][1] * rstd * gg.y); w.y = pk2(O[mt][nt][2] * rstd * gg.z, O[mt][nt][3] * rstd * gg.w);
                    *(v2u*)(op + mt * 16) = w; }
            }
            LDS_WAIT();
        }
    }
}

template <int MODE>
__device__ __forceinline__ void nsa_step(const bf16* Kp, const bf16* Vp, int kbase, const bf16x8 (&Qf)[2], int qpos, float slope2, bool blkok, int fr, int fq, int kr0,
                                         float& mrun, float& lrun, f32x4 (&O)[4]) {
    bf16x8 Ka[2][2];
#pragma unroll
    for (int t = 0; t < 2; ++t)
#pragma unroll
        for (int ks = 0; ks < 2; ++ks) Ka[t][ks] = ldg8(Kp + (size_t)(kbase + kr0 + 4 * t) * 64 + ks * 32 + fq * 8);
    bf16x8 Vf[4];
#pragma unroll
    for (int mt = 0; mt < 4; ++mt) Vf[mt] = ldg8(Vp + (size_t)(mt * 16 + fr) * S + kbase + fq * 8);
    f32x4 Sx[2];
#pragma unroll
    for (int t = 0; t < 2; ++t) { f32x4 z = {0.f, 0.f, 0.f, 0.f}; z = MFMA16(Ka[t][0], Qf[0], z); Sx[t] = MFMA16(Ka[t][1], Qf[1], z); }
    const int kd0 = kbase + fq * 8 - qpos;
    float sv[8]; float mx = -1e30f;
#pragma unroll
    for (int t = 0; t < 2; ++t)
#pragma unroll
        for (int r = 0; r < 4; ++r) { const int kd = kd0 + 4 * t + r; const bool ok = (MODE == 0) ? (blkok && kd <= 0) : (kd <= 0 && kd > -512);
            const float val = Sx[t][r] * LOG2E + slope2 * (float)kd; const float s_ = ok ? val : -1e30f; sv[t * 4 + r] = s_; mx = fmaxf(mx, s_); }
    mx = fmaxf(mx, __shfl_xor(mx, 16)); mx = fmaxf(mx, __shfl_xor(mx, 32));
    const float mnew = fmaxf(mrun, mx), alpha = ex2(mrun - mnew); mrun = mnew;
    float ps = 0.f;
#pragma unroll
    for (int i = 0; i < 8; ++i) { sv[i] = (sv[i] > -1e29f) ? ex2(sv[i] - mnew) : 0.f; ps += sv[i]; }
    lrun = lrun * alpha + ps;
    const bf16x8 Pf = pack8(sv[0], sv[1], sv[2], sv[3], sv[4], sv[5], sv[6], sv[7]);
#pragma unroll
    for (int mt = 0; mt < 4; ++mt) { O[mt] *= alpha; O[mt] = MFMA16(Vf[mt], Pf, O[mt]); }
}

__device__ __forceinline__ void cmp_scores(const bf16* Kc, int u, const bf16x8 (&Qf)[2], int qpos, int nv, float slope2, int fq, int kr0, float (&sv)[8]) {
#pragma unroll
    for (int t = 0; t < 2; ++t) {
        const bf16* kp = Kc + (size_t)(32 * u + kr0 + 4 * t) * 64 + fq * 8;
        f32x4 z = {0.f, 0.f, 0.f, 0.f}; z = MFMA16(ldg8(kp), Qf[0], z); z = MFMA16(ldg8(kp + 32), Qf[1], z);
#pragma unroll
        for (int rr = 0; rr < 4; ++rr) { const int cidx = 32 * u + 8 * fq + 4 * t + rr; const float dist = (float)(qpos - (cidx * 32 + 31));
            sv[t * 4 + rr] = (cidx < nv) ? (z[rr] * LOG2E - slope2 * dist) : -1e30f; }
    }
}

__device__ __forceinline__ void nsa_item(unsigned char* ws, int bg, int it, LAS float* wl, int lane) {
    const int b = bg >> 1, g = bg & 1, fr = lane & 15, fq = lane >> 4, i = fr >> 2, r = fr & 3, s0 = it * 4, qpos = s0 + i;
    const int kr0 = 8 * (fr >> 2) + (fr & 3);
    const float slope2 = ex2(-(float)(g * 4 + r + 1)) * LOG2E;
    bf16x8 Qf[2];
    { const bf16* qp = (const bf16*)(ws + WS_QB) + (size_t)(b * S + qpos) * 512 + (g * 4 + r) * 64 + fq * 8; Qf[0] = ldg8(qp); Qf[1] = ldg8(qp + 32); }
    const float* gp = (const float*)(ws + WS_GB) + (size_t)(b * S + qpos) * 24 + g * 12 + r * 3;
    const float g0 = gp[0], g1 = gp[1], g2 = gp[2];
    f32x4 Oacc[4];
#pragma unroll
    for (int mt = 0; mt < 4; ++mt) Oacc[mt] = (f32x4){0.f, 0.f, 0.f, 0.f};
#pragma unroll
    for (int e = 0; e < 8; ++e) wl[e * 64 + lane] = 0.f;
    const int nv = (qpos + 1) >> 5, nvmax = (s0 + 4) >> 5;
    if (nvmax > 0) {
        const bf16* Kc = (const bf16*)(ws + WS_KCMP) + (size_t)(bg * 256) * 64;
        const bf16* Vc = (const bf16*)(ws + WS_VCMP_T) + (size_t)(bg * 64) * 256;
        const int nu = (nvmax + 31) >> 5;
        float mloc = -1e30f, lloc = 0.f;
#pragma unroll 1
        for (int u = 0; u < nu; ++u) {
            float sv[8]; cmp_scores(Kc, u, Qf, qpos, nv, slope2, fq, kr0, sv);
            float mx = mloc;
#pragma unroll
            for (int e = 0; e < 8; ++e) mx = fmaxf(mx, sv[e]);
            float ps = 0.f;
#pragma unroll
            for (int e = 0; e < 8; ++e) ps += (sv[e] > -1e29f) ? ex2(sv[e] - mx) : 0.f;
            lloc = lloc * ex2(mloc - mx) + ps; mloc = mx;
        }
        float mx = fmaxf(mloc, __shfl_xor(mloc, 16)); mx = fmaxf(mx, __shfl_xor(mx, 32));
        float ls = lloc * ex2(mloc - mx); ls += __shfl_xor(ls, 16); ls += __shfl_xor(ls, 32);
        const float inv = (ls > 0.f) ? 1.f / ls : 0.f;
        f32x4 Oc[4];
#pragma unroll
        for (int mt = 0; mt < 4; ++mt) Oc[mt] = (f32x4){0.f, 0.f, 0.f, 0.f};
#pragma unroll 1
        for (int u = 0; u < nu; ++u) {
            float sv[8]; cmp_scores(Kc, u, Qf, qpos, nv, slope2, fq, kr0, sv);
#pragma unroll
            for (int e = 0; e < 8; ++e) sv[e] = (sv[e] > -1e29f) ? ex2(sv[e] - mx) * inv : 0.f;
#pragma unroll
            for (int t = 0; t < 2; ++t) {
                float e0 = sv[t * 4 + 0] + sv[t * 4 + 1], e1 = sv[t * 4 + 2] + sv[t * 4 + 3];
                e0 += __shfl_xor(e0, 1); e0 += __shfl_xor(e0, 2); e1 += __shfl_xor(e1, 1); e1 += __shfl_xor(e1, 2);
                if (r == 0) { const int j = 16 * u + 4 * fq + 2 * t; wl[i * 128 + j] = e0; wl[i * 128 + j + 1] = e1; }
            }
            const bf16x8 Pf = pack8(sv[0], sv[1], sv[2], sv[3], sv[4], sv[5], sv[6], sv[7]);
#pragma unroll
            for (int mt = 0; mt < 4; ++mt) Oc[mt] = MFMA16(ldg8(Vc + (size_t)(mt * 16 + fr) * 256 + 32 * u + fq * 8), Pf, Oc[mt]);
        }
#pragma unroll
        for (int mt = 0; mt < 4; ++mt) Oacc[mt] = Oc[mt] * g0;
    }
    LDS_WAIT();
    unsigned msk[4] = {0u, 0u, 0u, 0u};
    {
        const int q16 = r + 4 * fq, cur = qpos >> 6;
        float cv[8];
#pragma unroll
        for (int e = 0; e < 8; ++e) { const int j = q16 + 16 * e; const bool forced = (j == 0) || (j == cur) || (j == cur - 1);
            cv[e] = forced ? 1e4f : ((j <= cur) ? wl[i * 128 + j] : -1e9f); }
        for (int round = 0; round < 16; ++round) {
            float best = cv[0]; int be = 0;
#pragma unroll
            for (int e = 1; e < 8; ++e) if (cv[e] > best) { best = cv[e]; be = e; }
            int bj = q16 + 16 * be;
#pragma unroll
            for (int oi = 0; oi < 4; ++oi) { const int off = (oi == 0) ? 1 : (oi == 1) ? 2 : (oi == 2) ? 16 : 32;
                const float ov = __shfl_xor(best, off); const int oj = __shfl_xor(bj, off);
                const bool take = (ov > best) || (ov == best && oj < bj); best = take ? ov : best; bj = take ? oj : bj; }
            const unsigned bit = 1u << (bj & 31); const int w = bj >> 5;
            msk[0] |= (w == 0) ? bit : 0u; msk[1] |= (w == 1) ? bit : 0u; msk[2] |= (w == 2) ? bit : 0u; msk[3] |= (w == 3) ? bit : 0u;
#pragma unroll
            for (int e = 0; e < 8; ++e) if (bj == q16 + 16 * e) cv[e] = -3e38f;
        }
    }
    {
        const bf16* Kp = (const bf16*)(ws + WS_KS) + (size_t)(bg * S) * 64;
        const bf16* Vp = (const bf16*)(ws + WS_VST) + (size_t)(bg * 64) * S;
        float mrun = -1e30f, lrun = 0.f; f32x4 O[4];
#pragma unroll
        for (int mt = 0; mt < 4; ++mt) O[mt] = (f32x4){0.f, 0.f, 0.f, 0.f};
        const int curmax = (s0 + 3) >> 6;
#pragma unroll
        for (int w = 0; w < 4; ++w) {
            unsigned u_ = msk[w]; u_ |= __shfl_xor(u_, 4); u_ |= __shfl_xor(u_, 8);
            unsigned uu = (unsigned)__builtin_amdgcn_readfirstlane((int)u_);
            const int hi = curmax - 32 * w;
            const unsigned vm = (hi < 0) ? 0u : (hi >= 31 ? 0xffffffffu : ((2u << hi) - 1u));
            uu &= vm;
            while (uu) {
                const int jb = __builtin_ctz(uu); uu &= uu - 1u;
                const bool blkok = (msk[w] >> jb) & 1u;
                const int kbase = (32 * w + jb) * 64;
                nsa_step<0>(Kp, Vp, kbase, Qf, qpos, slope2, blkok, fr, fq, kr0, mrun, lrun, O);
                nsa_step<0>(Kp, Vp, kbase + 32, Qf, qpos, slope2, blkok, fr, fq, kr0, mrun, lrun, O);
            }
        }
        float l = lrun; l += __shfl_xor(l, 16); l += __shfl_xor(l, 32);
        const float sc_ = g1 / l;
#pragma unroll
        for (int mt = 0; mt < 4; ++mt) Oacc[mt] += O[mt] * sc_;
    }
    {
        const bf16* Kp = (const bf16*)(ws + WS_KW) + (size_t)(bg * S) * 64;
        const bf16* Vp = (const bf16*)(ws + WS_VWT) + (size_t)(bg * 64) * S;
        float mrun = -1e30f, lrun = 0.f; f32x4 O[4];
#pragma unroll
        for (int mt = 0; mt < 4; ++mt) O[mt] = (f32x4){0.f, 0.f, 0.f, 0.f};
        const int kstart = (s0 - 511 > 0) ? (s0 - 511) : 0;
        for (int k32 = kstart >> 5; k32 <= ((s0 + 3) >> 5); ++k32)
            nsa_step<1>(Kp, Vp, k32 * 32, Qf, qpos, slope2, true, fr, fq, kr0, mrun, lrun, O);
        float l = lrun; l += __shfl_xor(l, 16); l += __shfl_xor(l, 32);
        const float sc_ = g2 / l;
#pragma unroll
        for (int mt = 0; mt < 4; ++mt) Oacc[mt] += O[mt] * sc_;
    }
    bf16* op = (bf16*)(ws + WS_OB) + (size_t)(b * S + qpos) * 512 + (g * 4 + r) * 64 + fq * 4;
#pragma unroll
    for (int mt = 0; mt < 4; ++mt) { v2u w; w.x = pk2(Oacc[mt][0], Oacc[mt][1]); w.y = pk2(Oacc[mt][2], Oacc[mt][3]); *(v2u*)(op + mt * 16) = w; }
    LDS_WAIT();
}

__device__ __forceinline__ void cross_item(unsigned char* ws, int rt, int h, int lane) {
    const int fr = lane & 15, fq = lane >> 4, row = rt * 16 + fr, b = (rt * 16) >> 13;
    const int kr0 = 8 * (fr >> 2) + (fr & 3);
    bf16x8 Qf[4];
    { const bf16* qp = (const bf16*)(ws + WS_QC) + (size_t)row * 512 + h * 128 + fq * 8;
#pragma unroll
      for (int ks = 0; ks < 4; ++ks) Qf[ks] = ldg8(qp + ks * 32); }
    const bf16* Kc = (const bf16*)(ws + WS_KMEM) + (size_t)((b * 4 + h) * 256) * 128;
    const bf16* Vc = (const bf16*)(ws + WS_VMEM_T) + (size_t)((b * 4 + h) * 128) * 256;
    f32x4 sc[16]; float mx = -1e30f;
#pragma unroll
    for (int kt = 0; kt < 16; ++kt) {
        const int u = kt >> 1, t = kt & 1;
        const bf16* kp = Kc + (size_t)(32 * u + kr0 + 4 * t) * 128 + fq * 8;
        f32x4 z = {0.f, 0.f, 0.f, 0.f};
#pragma unroll
        for (int ks = 0; ks < 4; ++ks) z = MFMA16(ldg8(kp + ks * 32), Qf[ks], z);
        z *= LOG2E; sc[kt] = z;
        mx = fmaxf(mx, fmaxf(fmaxf(z[0], z[1]), fmaxf(z[2], z[3])));
    }
    mx = fmaxf(mx, __shfl_xor(mx, 16)); mx = fmaxf(mx, __shfl_xor(mx, 32));
    float ls = 0.f;
#pragma unroll
    for (int kt = 0; kt < 16; ++kt)
#pragma unroll
        for (int rr = 0; rr < 4; ++rr) { const float p = ex2(sc[kt][rr] - mx); sc[kt][rr] = p; ls += p; }
    ls += __shfl_xor(ls, 16); ls += __shfl_xor(ls, 32);
    const float inv = 1.f / ls;
    f32x4 O[8];
#pragma unroll
    for (int mt = 0; mt < 8; ++mt) O[mt] = (f32x4){0.f, 0.f, 0.f, 0.f};
#pragma unroll
    for (int u = 0; u < 8; ++u) {
        const bf16x8 Pf = pack8(sc[2 * u][0], sc[2 * u][1], sc[2 * u][2], sc[2 * u][3], sc[2 * u + 1][0], sc[2 * u + 1][1], sc[2 * u + 1][2], sc[2 * u + 1][3]);
#pragma unroll
        for (int mt = 0; mt < 8; ++mt) O[mt] = MFMA16(ldg8(Vc + (size_t)(mt * 16 + fr) * 256 + 32 * u + fq * 8), Pf, O[mt]);
    }
    bf16* op = (bf16*)(ws + WS_OC) + (size_t)row * 512 + h * 128 + fq * 4;
#pragma unroll
    for (int mt = 0; mt < 8; ++mt) { v2u w; w.x = pk2(O[mt][0] * inv, O[mt][1] * inv); w.y = pk2(O[mt][2] * inv, O[mt][3] * inv); *(v2u*)(op + mt * 16) = w; }
}

__device__ __forceinline__ void peer_token(unsigned char* ws, const float* gfin, float* outp, int tok, int lane) {
    const bf16* scp = (const bf16*)(ws + WS_SCORES) + (size_t)tok * 2048;
    const int l16 = lane & 15, grp = lane >> 4;
    float tsv[4]; int tsi[4];
#pragma unroll
    for (int gi = 0; gi < 4; ++gi) {
        const int hc = gi * 4 + grp;
        const v4u raw = *(const v4u*)(scp + hc * 128 + l16 * 8);
        float cv[8] = {bflo(raw.x), bfhi(raw.x), bflo(raw.y), bfhi(raw.y), bflo(raw.z), bfhi(raw.z), bflo(raw.w), bfhi(raw.w)};
        float myv = 0.f; int myi = 0;
        for (int round = 0; round < 16; ++round) {
            float best = cv[0]; int be = 0;
#pragma unroll
            for (int e = 1; e < 8; ++e) if (cv[e] > best) { best = cv[e]; be = e; }
            int bk = l16 * 8 + be;
#pragma unroll
            for (int off = 1; off < 16; off <<= 1) { const float ov = __shfl_xor(best, off); const int ok = __shfl_xor(bk, off);
                const bool take = (ov > best) || (ov == best && ok < bk); best = take ? ov : best; bk = take ? ok : bk; }
            if (l16 == round) { myv = best; myi = bk; }
#pragma unroll
            for (int e = 0; e < 8; ++e) if (bk == l16 * 8 + e) cv[e] = -3e38f;
        }
        tsv[gi] = myv; tsi[gi] = myi;
    }
    float gsel[4]; int esel[4];
    const int half = lane >> 5, L = lane & 31, hb = half * 32, a = L & 15, bb = (L >> 4) * 8;
#pragma unroll
    for (int gi = 0; gi < 4; ++gi) {
        const float s0a = __shfl(tsv[gi], hb + a);
        float cand[8];
#pragma unroll
        for (int e = 0; e < 8; ++e) cand[e] = s0a + __shfl(tsv[gi], hb + 16 + bb + e);
        float selv = 0.f; int self_ = 0;
        for (int round = 0; round < 16; ++round) {
            float best = cand[0]; int be = 0;
#pragma unroll
            for (int e = 1; e < 8; ++e) if (cand[e] > best) { best = cand[e]; be = e; }
            int bfi = a * 16 + bb + be;
#pragma unroll
            for (int off = 1; off < 32; off <<= 1) { const float ov = __shfl_xor(best, off); const int oi = __shfl_xor(bfi, off);
                const bool take = (ov > best) || (ov == best && oi < bfi); best = take ? ov : best; bfi = take ? oi : bfi; }
            if (L == round) { selv = best; self_ = bfi; }
#pragma unroll
            for (int e = 0; e < 8; ++e) if (bfi == a * 16 + bb + e) cand[e] = -3e38f;
        }
        const int i0 = __shfl(tsi[gi], hb + (self_ >> 4)), i1 = __shfl(tsi[gi], hb + 16 + (self_ & 15));
        const float mxv = __shfl(selv, hb);
        float ev = (L < 16) ? __expf(selv - mxv) : 0.f;
        float sm = ev;
#pragma unroll
        for (int off = 1; off < 16; off <<= 1) sm += __shfl_xor(sm, off);
        gsel[gi] = (L < 16) ? ev / sm : 0.f; esel[gi] = i0 * 128 + i1;
    }
    float xf[16];
    { const bf16* up = (const bf16*)(ws + WS_U) + (size_t)tok * 1024 + lane * 8; const v4u a0 = *(const v4u*)up, a1 = *(const v4u*)(up + 512);
      xf[0] = bflo(a0.x); xf[1] = bfhi(a0.x); xf[2] = bflo(a0.y); xf[3] = bfhi(a0.y); xf[4] = bflo(a0.z); xf[5] = bfhi(a0.z); xf[6] = bflo(a0.w); xf[7] = bfhi(a0.w);
      xf[8] = bflo(a1.x); xf[9] = bfhi(a1.x); xf[10] = bflo(a1.y); xf[11] = bfhi(a1.y); xf[12] = bflo(a1.z); xf[13] = bfhi(a1.z); xf[14] = bflo(a1.w); xf[15] = bfhi(a1.w); }
    float oacc[16];
#pragma unroll
    for (int e = 0; e < 16; ++e) oacc[e] = 0.f;
    const bf16* PU = (const bf16*)(ws + WS_PU); const bf16* PV = (const bf16*)(ws + WS_PV);
#pragma unroll
    for (int gi = 0; gi < 4; ++gi) {
        for (int hk = 0; hk < 4; ++hk) {
            const int lbase = (hk >> 1) * 32 + (hk & 1) * 8;
            v4u ua[8], ub[8]; int eid[8]; float gt[8];
#pragma unroll
            for (int kk = 0; kk < 8; ++kk) {
                eid[kk] = __builtin_amdgcn_readfirstlane(__shfl(esel[gi], lbase + kk));
                gt[kk] = __builtin_bit_cast(float, __builtin_amdgcn_readfirstlane(__builtin_bit_cast(int, __shfl(gsel[gi], lbase + kk))));
                const bf16* up = PU + (size_t)eid[kk] * 1024 + lane * 8; ua[kk] = *(const v4u*)up; ub[kk] = *(const v4u*)(up + 512);
            }
            float wgt[8];
#pragma unroll
            for (int kk = 0; kk < 8; ++kk) {
                float d = xf[0] * bflo(ua[kk].x) + xf[1] * bfhi(ua[kk].x) + xf[2] * bflo(ua[kk].y) + xf[3] * bfhi(ua[kk].y)
                        + xf[4] * bflo(ua[kk].z) + xf[5] * bfhi(ua[kk].z) + xf[6] * bflo(ua[kk].w) + xf[7] * bfhi(ua[kk].w)
                        + xf[8] * bflo(ub[kk].x) + xf[9] * bfhi(ub[kk].x) + xf[10] * bflo(ub[kk].y) + xf[11] * bfhi(ub[kk].y)
                        + xf[12] * bflo(ub[kk].z) + xf[13] * bfhi(ub[kk].z) + xf[14] * bflo(ub[kk].w) + xf[15] * bfhi(ub[kk].w);
                d = wave_sum(d);
                wgt[kk] = gt[kk] * gelu_erf(d);
            }
#pragma unroll
            for (int kk = 0; kk < 8; ++kk) { const bf16* vp = PV + (size_t)eid[kk] * 1024 + lane * 8; ua[kk] = *(const v4u*)vp; ub[kk] = *(const v4u*)(vp + 512); }
#pragma unroll
            for (int kk = 0; kk < 8; ++kk) { const float w_ = wgt[kk];
                oacc[0] += w_ * bflo(ua[kk].x); oacc[1] += w_ * bfhi(ua[kk].x); oacc[2] += w_ * bflo(ua[kk].y); oacc[3] += w_ * bfhi(ua[kk].y);
                oacc[4] += w_ * bflo(ua[kk].z); oacc[5] += w_ * bfhi(ua[kk].z); oacc[6] += w_ * bflo(ua[kk].w); oacc[7] += w_ * bfhi(ua[kk].w);
                oacc[8] += w_ * bflo(ub[kk].x); oacc[9] += w_ * bfhi(ub[kk].x); oacc[10] += w_ * bflo(ub[kk].y); oacc[11] += w_ * bfhi(ub[kk].y);
                oacc[12] += w_ * bflo(ub[kk].z); oacc[13] += w_ * bfhi(ub[kk].z); oacc[14] += w_ * bflo(ub[kk].w); oacc[15] += w_ * bfhi(ub[kk].w); }
        }
    }
    const float* hp = (const float*)(ws + WS_H) + (size_t)tok * 1024 + lane * 8;
    const f32x4 h0 = *(const f32x4*)hp, h1 = *(const f32x4*)(hp + 4), h2 = *(const f32x4*)(hp + 512), h3 = *(const f32x4*)(hp + 516);
    float y[16] = {h0.x + oacc[0], h0.y + oacc[1], h0.z + oacc[2], h0.w + oacc[3], h1.x + oacc[4], h1.y + oacc[5], h1.z + oacc[6], h1.w + oacc[7],
                   h2.x + oacc[8], h2.y + oacc[9], h2.z + oacc[10], h2.w + oacc[11], h3.x + oacc[12], h3.y + oacc[13], h3.z + oacc[14], h3.w + oacc[15]};
    float ss = 0.f;
#pragma unroll
    for (int e = 0; e < 16; ++e) ss += y[e] * y[e];
    const float rstd = rsqrtf(wave_sum(ss) * (1.f / D) + 1e-6f);
    const float* gp = gfin + lane * 8; float* op = outp + (size_t)tok * 1024 + lane * 8;
    const f32x4 ga = *(const f32x4*)gp, gb = *(const f32x4*)(gp + 4), gc = *(const f32x4*)(gp + 512), gd = *(const f32x4*)(gp + 516);
    *(f32x4*)op = (f32x4){y[0] * rstd * ga.x, y[1] * rstd * ga.y, y[2] * rstd * ga.z, y[3] * rstd * ga.w};
    *(f32x4*)(op + 4) = (f32x4){y[4] * rstd * gb.x, y[5] * rstd * gb.y, y[6] * rstd * gb.z, y[7] * rstd * gb.w};
    *(f32x4*)(op + 512) = (f32x4){y[8] * rstd * gc.x, y[9] * rstd * gc.y, y[10] * rstd * gc.z, y[11] * rstd * gc.w};
    *(f32x4*)(op + 516) = (f32x4){y[12] * rstd * gd.x, y[13] * rstd * gd.y, y[14] * rstd * gd.z, y[15] * rstd * gd.w};
}

typedef unsigned gu32_unused;
#define XB_TMO      128
#define XB_XCNT(j)  (256  + 64 * (j))
#define XB_XSUB(j)  (1280 + 64 * (j))
#define XB_XGEN(j)  (2304 + 64 * (j))
#define XB_TOP      3328
#define XB_TOPGEN   3392
#define XCD_BAR_WORDS 3456
#define XB_SPIN_CAP (1u << 18)

__device__ __forceinline__ unsigned xb_ld(unsigned* p)              { return __hip_atomic_load(p, __ATOMIC_RELAXED, __HIP_MEMORY_SCOPE_AGENT); }
__device__ __forceinline__ unsigned xb_add(unsigned* p, unsigned v) { return __hip_atomic_fetch_add(p, v, __ATOMIC_RELAXED, __HIP_MEMORY_SCOPE_AGENT); }
__device__ __forceinline__ unsigned xb_xcc_id() { return (unsigned)__builtin_amdgcn_s_getreg((3 << 11) | 20) & 0xFu; }
#define XB_SPIN(cond, bar) do { unsigned _sp = 0; while (cond) { __builtin_amdgcn_s_sleep(1); \
    if ((++_sp & 255u) == 0u) { if (xb_ld(&(bar)[XB_TMO])) break; if (_sp > XB_SPIN_CAP) { atomicAdd(&(bar)[XB_TMO], 1u); break; } } } } while (0)

struct XcdBarrier {
    unsigned* bar; unsigned x;
    volatile LAS unsigned* st;
};

__device__ __forceinline__ XcdBarrier xcd_barrier_post(unsigned* bar, volatile LAS unsigned* st) {
    XcdBarrier b; b.bar = bar; b.x = xb_xcc_id(); b.st = st;
    if (threadIdx.x == 0) (void)xb_add(&bar[XB_XCNT(b.x)], 1u);
    return b;
}
__device__ __forceinline__ void xcd_barrier_complete(unsigned* bar, unsigned x, unsigned& nloc, unsigned& nx) {
    const unsigned G = gridDim.x * gridDim.y * gridDim.z;
    unsigned sum, cnt, mine, sp = 0u;
    for (;;) {
        sum = 0u; cnt = 0u; mine = 0u;
#pragma unroll
        for (unsigned j = 0; j < 16; ++j) { const unsigned c = xb_ld(&bar[XB_XCNT(j)]); sum += c; cnt += (c > 0u) ? 1u : 0u; mine = (j == x) ? c : mine; }
        if (sum == G) break;
        __builtin_amdgcn_s_sleep(1);
        if ((++sp & 255u) == 0u) { if (xb_ld(&bar[XB_TMO])) break; if (sp > XB_SPIN_CAP) { atomicAdd(&bar[XB_TMO], 1u); break; } }
    }
    nloc = mine > 0u ? mine : 1u; nx = cnt > 0u ? cnt : 1u;
}

__device__ __forceinline__ void xcd_barrier(const XcdBarrier& b) {
    asm volatile("s_waitcnt vmcnt(0)" ::: "memory");
    __syncthreads();
    if (threadIdx.x == 0) {
        unsigned* bar = b.bar;
        __builtin_amdgcn_s_waitcnt(0);
        unsigned nloc = b.st[0], nx = b.st[1];
        if (nloc == 0u) { xcd_barrier_complete(bar, b.x, nloc, nx); b.st[0] = nloc; b.st[1] = nx; }
        const unsigned old = xb_add(&bar[XB_XSUB(b.x)], 1u);
        const unsigned gen = old / nloc;
        if (old + 1u == (gen + 1u) * nloc) {
            __builtin_amdgcn_fence(__ATOMIC_RELEASE, "agent");
            asm volatile("s_waitcnt vmcnt(0)" ::: "memory");
            const unsigned og = xb_add(&bar[XB_TOP], 1u);
            const unsigned tg = og / nx;
            if (og + 1u == (tg + 1u) * nx) xb_add(&bar[XB_TOPGEN], 1u);
            else XB_SPIN(xb_ld(&bar[XB_TOPGEN]) == tg, bar);
            __builtin_amdgcn_fence(__ATOMIC_ACQUIRE, "agent");
            xb_add(&bar[XB_XGEN(b.x)], 1u);
            asm volatile("s_waitcnt vmcnt(0)" ::: "memory");
        } else {
            XB_SPIN(xb_ld(&bar[XB_XGEN(b.x)]) == gen, bar);
            __builtin_amdgcn_fence(__ATOMIC_ACQUIRE, "agent");
            asm volatile("s_waitcnt vmcnt(0)" ::: "memory");
        }
    }
    __syncthreads();
}

constexpr int NPHASE = 14;
__global__ void __launch_bounds__(NTHR, 2) hybrid_fwd(Args args) {
    extern __shared__ __attribute__((aligned(16))) unsigned char lds_raw[];
    LAS unsigned char* lds = (LAS unsigned char*)lds_raw;
    unsigned char* ws = args.ws;
    const int tid = threadIdx.x, lane = tid & 63, wave = __builtin_amdgcn_readfirstlane(tid >> 6);
    const int G = gridDim.x, bx = blockIdx.x;
    const int gw = bx * NWAVES + wave, NGW = G * NWAVES;
    const int lo = args.ph_lo, hi = args.ph_hi;
    const bool coop = (hi - lo) > 1;
    volatile LAS unsigned* MISC = (volatile LAS unsigned*)(lds + 131072 + 320);
    for (int u = tid; u < (LDS_BYTES - 131072) / 4; u += NTHR) ((LAS unsigned*)(lds + 131072))[u] = 0u;
    __syncthreads();
    XcdBarrier xbar; xbar.bar = (unsigned*)(ws + WS_CTL) + 4096; xbar.x = 0; xbar.st = nullptr;
    if (coop) xbar = xcd_barrier_post((unsigned*)(ws + WS_CTL) + 4096, MISC + 8);
#ifndef PH_MASK
#define PH_MASK 0x3fff
#endif
#define IN(k) (((PH_MASK >> (k)) & 1) && lo <= (k) && (k) < hi)
#ifndef REP_MASK
#define REP_MASK 0
#endif
#ifndef REP_WHICH
#define REP_WHICH 0
#endif
#define NREP(k) (1 + ((REP_MASK >> (k)) & 1))
#define SEAM(k) do { if (coop && IN(k) && IN((k) + 1)) { if ((k) == 0) cg::this_grid().sync(); else xcd_barrier(xbar); } } while (0)
    const float* x = args.in[0];
    EpiAll ea; ea.mode = 0; ea.ws = ws; ea.x = x; ea.cmp_pos = args.in[6]; ea.part = nullptr;

    if (IN(0)) for (int rep = 0; rep < NREP(0); ++rep) {
        LAS float* scr = (LAS float*)(lds + wave * 16384);
        constexpr int I_WIN = 16 * 160, I_C1 = 32 * 8, I_AB = 8 * 32, I_OUT = 16 * 32, I_CQ = 16 * 16, I_CKV = 16 * 32, I_CO = 8 * 32;
        constexpr int NIT = I_WIN + 2 * I_C1 + 2 * I_AB + I_OUT + I_CQ + I_CKV + I_CO;
        for (int it = gw; it < NIT; it += NGW) {
            int r = it;
            if (r < I_WIN) { transpose_item(args.in[3], 1024, NIN, 160, (bf16*)(ws + WS_WIN_T), scr, r, lane); continue; } r -= I_WIN;
            if (r < I_C1) { transpose_item(args.in[7], 2048, 256, 8, (bf16*)(ws + WS_CKW1_T), scr, r, lane); continue; } r -= I_C1;
            if (r < I_C1) { transpose_item(args.in[9], 2048, 256, 8, (bf16*)(ws + WS_CVW1_T), scr, r, lane); continue; } r -= I_C1;
            if (r < I_AB) { transpose_item(args.in[11], 512, 1024, 32, (bf16*)(ws + WS_WA_T), scr, r, lane); continue; } r -= I_AB;
            if (r < I_AB) { transpose_item(args.in[12], 512, 1024, 32, (bf16*)(ws + WS_WB_T), scr, r, lane); continue; } r -= I_AB;
            if (r < I_OUT) { transpose_item(args.in[13], 1024, 1024, 32, (bf16*)(ws + WS_WOUT_T), scr, r, lane); continue; } r -= I_OUT;
            if (r < I_CQ) { transpose_item(args.in[16], 1024, 512, 16, (bf16*)(ws + WS_WCQ_T), scr, r, lane); continue; } r -= I_CQ;
            if (r < I_CKV) { transpose_item(args.in[17], 1024, 1024, 32, (bf16*)(ws + WS_WCKV_T), scr, r, lane); continue; } r -= I_CKV;
            transpose_item(args.in[18], 512, 1024, 32, (bf16*)(ws + WS_WCO_T), scr, r, lane);
        }
        for (int m = gw; m < T; m += NGW) rms_row_to_bf16(x + (size_t)m * D, args.in[2], (bf16*)(ws + WS_U) + (size_t)m * D, lane);
        for (int m = gw; m < 512; m += NGW) rms_row_to_bf16(args.in[1] + (size_t)m * D, args.in[15], (bf16*)(ws + WS_MEMN) + (size_t)m * D, lane);
        __syncthreads();
        {
            LAS float* skl = (LAS float*)lds;
            LAS float* wql = (LAS float*)(lds + 128 * 132 * 4);
            const float* SK = args.in[21]; const float* WQ = args.in[20];
            for (int item = bx; item < 256; item += G) {
                const int hc = item >> 4, k0 = (item & 15) * 64;
                for (int e = tid; e < 128 * 128; e += NTHR) { const int key = e >> 7, d = e & 127; skl[d * 132 + key] = SK[(size_t)(hc * 128 + key) * 128 + d]; }
                for (int e = tid; e < 64 * 128; e += NTHR) { const int k = e >> 7, d = e & 127; wql[d * 68 + k] = WQ[(size_t)(k0 + k) * 2048 + hc * 128 + d]; }
                __syncthreads();
                const int key4 = (tid & 31) * 4, kk4 = (tid >> 5) * 4;
                float acc[4][4];
#pragma unroll
                for (int i = 0; i < 4; ++i)
#pragma unroll
                    for (int j = 0; j < 4; ++j) acc[i][j] = 0.f;
                for (int d = 0; d < 128; ++d) {
                    const f32x4 av = *(const LAS f32x4*)(skl + d * 132 + key4), bv = *(const LAS f32x4*)(wql + d * 68 + kk4);
#pragma unroll
                    for (int i = 0; i < 4; ++i)
#pragma unroll
                        for (int j = 0; j < 4; ++j) acc[i][j] += av[i] * bv[j];
                }
#pragma unroll
                for (int i = 0; i < 4; ++i) { v2u w; w.x = pk2(acc[i][0], acc[i][1]); w.y = pk2(acc[i][2], acc[i][3]);
                    *(v2u*)((bf16*)(ws + WS_WPS_T) + (size_t)(hc * 128 + key4 + i) * 1024 + k0 + kk4) = w; }
                __syncthreads();
            }
        }
    }
    SEAM(0);
    if (IN(1)) for (int rep = 0; rep < NREP(1); ++rep) { ea.mode = EM_G1; run_gemm(lds, (const bf16*)(ws + WS_U), (const bf16*)(ws + WS_WIN_T), T, NIN_PAD, 1024, 1024, G, bx, ea); }
    SEAM(1);
    if (IN(2)) {
        if (bx < 64) {
            const int ci = bx >> 2, kv = ci >> 3, sp = ci & 7;
            ea.mode = EM_PART; ea.part = (float*)(ws + WS_HIDP) + (size_t)ci * 1024 * 256;
            run_gemm(lds, (const bf16*)(ws + (kv ? WS_VCI : WS_KCI)) + sp * 256, (const bf16*)(ws + (kv ? WS_CVW1_T : WS_CKW1_T)) + sp * 256, 1024, 256, 256, 2048, G, bx & 3, ea);
        } else {
            ea.mode = EM_KVMEM;
            run_gemm(lds, (const bf16*)(ws + WS_MEMN), (const bf16*)(ws + WS_WCKV_T), 512, 1024, 1024, 1024, G, (bx >= 128 && bx < 136) ? bx - 128 : 1 << 20, ea);
        }
    }
    SEAM(2);
    if (IN(3)) {
        LAS float* hl = (LAS float*)lds;
        const float* HP = (const float*)(ws + WS_HIDP);
        for (int it = bx; it < 256; it += G) {
            for (int e = tid; e < 2048; e += NTHR) { const int kv = e >> 10, rr = (e >> 8) & 3, c = e & 255, row = it * 4 + rr; float s_ = 0.f;
#pragma unroll
                for (int sp = 0; sp < 8; ++sp) s_ += HP[((size_t)((kv * 8 + sp) * 1024 + row)) * 256 + c];
                hl[e] = gelu_erf(s_); }
            __syncthreads();
            { const int kv = tid >> 8, rr = (tid >> 6) & 3, d = tid & 63, row = it * 4 + rr; const float* w2 = kv ? args.in[10] : args.in[8]; float a_ = 0.f;
              for (int j = 0; j < 256; ++j) a_ += hl[(kv * 4 + rr) * 256 + j] * w2[j * 64 + d];
              if (kv == 0) ((bf16*)(ws + WS_KCMP))[(size_t)row * 64 + d] = f2bf1(a_);
              else ((bf16*)(ws + WS_VCMP_T))[((size_t)((row >> 8) * 64 + d)) * 256 + (row & 255)] = f2bf1(a_); }
            __syncthreads();
        }
    }
    SEAM(3);
    if (IN(4)) for (int rep = 0; rep < NREP(4); ++rep) {
        unsigned* qctr = (unsigned*)(ws + WS_CTL) + 1024 + 64 * (bx & 7) + 512 * rep;
        LAS float* wl = (LAS float*)(lds + wave * 16384);
        const int xq = bx & 7;
        for (;;) {
            int n = 0;
            if (lane == 0) n = (int)atomicAdd(qctr, 1u);
            n = __builtin_amdgcn_readfirstlane(n);
            if (n >= 256 + 1024) break;
            if (n < 256) { if (rep == 0 || REP_WHICH == 0) diff_item(ws, args.in[4], args.in[5], xq, 255 - n, wl, lane); }
            else if (rep == 0 || REP_WHICH == 1) { const int idx = n - 256; nsa_item(ws, xq >> 1, 2047 - (2 * idx + (xq & 1)), wl, lane); }
        }
    }
    SEAM(4);
    if (IN(5)) {
        ea.mode = EM_MA; run_gemm(lds, (const bf16*)(ws + WS_OA), (const bf16*)(ws + WS_WA_T), T, 1024, 512, 512, G, bx, ea);
        ea.mode = EM_MB; run_gemm(lds, (const bf16*)(ws + WS_OB), (const bf16*)(ws + WS_WB_T), T, 1024, 512, 512, G, bx, ea);
    }
    SEAM(5);
    if (IN(6)) { ea.mode = EM_H1; run_gemm(lds, (const bf16*)(ws + WS_U), (const bf16*)(ws + WS_WOUT_T), T, 1024, 1024, 1024, G, bx, ea); }
    SEAM(6);
    if (IN(7)) for (int rep = 0; rep < NREP(7); ++rep) {
        for (int m = gw; m < T; m += NGW) rms_row_to_bf16((const float*)(ws + WS_H) + (size_t)m * D, args.in[14], (bf16*)(ws + WS_U) + (size_t)m * D, lane);
        const size_t NV = (size_t)16384 * 1024 / 8;
        for (size_t e = (size_t)gw * 64 + lane; e < 2 * NV; e += (size_t)NGW * 64) {
            const bool second = e >= NV; const size_t ee = second ? e - NV : e;
            const float* src = (second ? args.in[23] : args.in[22]) + ee * 8; bf16* dst = (bf16*)(ws + (second ? WS_PV : WS_PU)) + ee * 8;
            const f32x4 a0 = *(const f32x4*)src, a1 = *(const f32x4*)(src + 4);
            v4u w; w.x = pk2(a0.x, a0.y); w.y = pk2(a0.z, a0.w); w.z = pk2(a1.x, a1.y); w.w = pk2(a1.z, a1.w); *(v4u*)dst = w;
        }
    }
    SEAM(7);
    if (IN(8)) { ea.mode = EM_QC; run_gemm(lds, (const bf16*)(ws + WS_U), (const bf16*)(ws + WS_WCQ_T), T, 512, 1024, 1024, G, bx, ea); }
    SEAM(8);
    if (IN(9)) for (int rep = 0; rep < NREP(9); ++rep) { for (int it = gw; it < 4096; it += NGW) cross_item(ws, it >> 2, it & 3, lane); }
    SEAM(9);
    if (IN(10)) { ea.mode = EM_H2; run_gemm(lds, (const bf16*)(ws + WS_OC), (const bf16*)(ws + WS_WCO_T), T, 1024, 512, 512, G, bx, ea); }
    SEAM(10);
    if (IN(11)) { for (int m = gw; m < T; m += NGW) rms_row_to_bf16((const float*)(ws + WS_H) + (size_t)m * D, args.in[19], (bf16*)(ws + WS_U) + (size_t)m * D, lane); }
    SEAM(11);
    if (IN(12)) for (int rep = 0; rep < NREP(12); ++rep) { ea.mode = EM_SC; run_gemm(lds, (const bf16*)(ws + WS_U), (const bf16*)(ws + WS_WPS_T), T, 2048, 1024, 1024, G, bx, ea); }
    SEAM(12);
    if (IN(13)) for (int rep = 0; rep < NREP(13); ++rep) { for (int tok = gw; tok < T; tok += NGW) peer_token(ws, args.in[24], args.out, tok, lane); }
#undef IN
#undef SEAM
}

#ifndef N_LAUNCH_MODE
#define N_LAUNCH_MODE 1
#endif
extern "C" void kernel_launch(void* const* d_in, const int* in_sizes, int n_in, void* d_out, int out_size, void* d_ws, size_t ws_size, hipStream_t stream) {
    static int grid = 0;
    if (grid == 0) {
        if (n_in != 25 || out_size != T * D || ws_size < WS_END) { fprintf(stderr, "kernel_launch: unexpected shapes (n_in %d out %d ws %zu)\n", n_in, out_size, ws_size); grid = -1; return; }
        int dev = 0, cus = 0, per_cu = 0;
        hipGetDevice(&dev); hipDeviceGetAttribute(&cus, hipDeviceAttributeMultiprocessorCount, dev);
        if (hipFuncSetAttribute((const void*)hybrid_fwd, hipFuncAttributeMaxDynamicSharedMemorySize, LDS_BYTES) != hipSuccess) { fprintf(stderr, "kernel_launch: hipFuncSetAttribute failed\n"); grid = -1; return; }
        if (hipOccupancyMaxActiveBlocksPerMultiprocessor(&per_cu, (const void*)hybrid_fwd, NTHR, LDS_BYTES) != hipSuccess || per_cu < 1) { fprintf(stderr, "kernel_launch: occupancy query says %d\n", per_cu); per_cu = 1; }
        (void)hipGetLastError();
        grid = cus * 1;
        if (grid > 256) grid = 256;
    }
    if (grid < 0) return;
    hipMemsetAsync((char*)d_ws + WS_CTL, 0, CTL_BYTES, stream);
    Args a{};
    for (int i = 0; i < 25; ++i) a.in[i] = (const float*)d_in[i];
    a.out = (float*)d_out; a.ws = (unsigned char*)d_ws;
#if N_LAUNCH_MODE == 1
    a.ph_lo = 0; a.ph_hi = NPHASE;
    void* kargs[] = {&a};
    hipError_t e = hipLaunchCooperativeKernel((const void*)hybrid_fwd, dim3(grid), dim3(NTHR), kargs, LDS_BYTES, stream);
    if (e != hipSuccess) fprintf(stderr, "cooperative launch failed: %s (grid %d)\n", hipGetErrorString(e), grid);
#else
    for (int p = 0; p < NPHASE; ++p) { a.ph_lo = p; a.ph_hi = p + 1; hipLaunchKernelGGL(hybrid_fwd, dim3(grid), dim3(NTHR), LDS_BYTES, stream, a); }
#endif
}
```

```cpp
#include <hip/hip_runtime.h>
#include <hip/hip_cooperative_groups.h>
#include <cstdio>
#include <cstdint>
namespace cg = cooperative_groups;
namespace pg8 {
#define PG8_LAS __attribute__((address_space(3)))
typedef unsigned short bf16_t;
typedef short bf16x8 __attribute__((ext_vector_type(8)));
typedef float f32x4 __attribute__((ext_vector_type(4)));
typedef unsigned u32x4 __attribute__((ext_vector_type(4)));
constexpr int BM = 256, BK = 64, HALF = 128, HTB = HALF * BK * 2  , STAGE_BYTES = 8 * HTB, NXCD = 8, WGM = 8;

__host__ __device__ __forceinline__ int lds_byte(int r, int c) { const int st = (r >> 4) * 2 + (c >> 5), rr = r & 15, cc = c & 31, ob = rr * 64 + cc * 2; return st * 1024 + (ob ^ (((ob >> 9) & 1) << 5)); }
__host__ __device__ __forceinline__ void stage_rc(int b, int& R, int& C) { const int st = b / 1024, sb = b % 1024, swz = sb ^ (((sb >> 9) & 1) << 5); R = (st >> 1) * 16 + swz / 64; C = (st & 1) * 32 + (swz % 64) / 2; }
__host__ __device__ __forceinline__ int perm32(int rho) { const int n = rho >> 4, i = rho & 15; return 8 * (i >> 2) + 4 * n + (i & 3); }

struct Unit { int pm, pn; };
struct Gemm { const bf16_t* A; const bf16_t* Bt; int M, N, K, ld; };

struct StaticOrder {
    int nM, nN, nwg, G, c;
    __host__ __device__ void init(int M, int N, int G_, int c_) { nM = M / BM; nN = N / BM; nwg = nM * nN; G = G_; c = c_; }
    __host__ __device__ bool next(int i, Unit& u) const {
        const long L = (long)i * G + c; if (L >= nwg) return false;
        int wgid = (int)L; { const int q = nwg / NXCD, r = nwg % NXCD, xcd = wgid % NXCD, off = wgid / NXCD; wgid = (xcd < r ? xcd * (q + 1) : r * (q + 1) + (xcd - r) * q) + off; }
        const int nig = WGM * nN, gid = wgid / nig, fm = gid * WGM, gsz = (nM - fm) < WGM ? (nM - fm) : WGM;
        u.pm = fm + ((wgid % nig) % gsz); u.pn = (wgid % nig) / gsz; return true;
    }
    __device__ __forceinline__ void a_ready(const Unit&) const {}
    __device__ __forceinline__ void done(const Unit&) const {}
};

__device__ __forceinline__ unsigned cvt_pk_bf16(float lo, float hi) { unsigned r; asm volatile("v_cvt_pk_bf16_f32 %0, %1, %2" : "=v"(r) : "v"(lo), "v"(hi)); return r; }
template <class F> struct EpiF {
    static constexpr bool PERM = true, AFTER_DRAIN = false;
    F f;
    __device__ __forceinline__ void operator()(const f32x4 (&acc)[2][2][4][2], const Unit& u, int wr, int wc, int fr, int fq) const {
        const int row0 = u.pm * BM + wr * 64 + fr, col0 = u.pn * BM + wc * 32 + 8 * fq;
#pragma unroll
        for (int ai = 0; ai < 2; ++ai)
#pragma unroll
            for (int m = 0; m < 4; ++m)
#pragma unroll
                for (int bj = 0; bj < 2; ++bj) f(row0 + ai * HALF + m * 16, col0 + bj * HALF, acc[ai][bj][m][0], acc[ai][bj][m][1]);
    }
};
template <class Epi, class Sched, bool ALIGN_EPI = false, bool SP2 = false>
__device__ __forceinline__ void gemm_phase(PG8_LAS unsigned char* lds, const Gemm g, const Sched& S, const Epi& E) {
    const int tid = threadIdx.x, wid = __builtin_amdgcn_readfirstlane(tid >> 6), lane = tid & 63, wr = wid >> 2, wc = wid & 3, fr = lane & 15, fq = lane >> 4;
    const int K = g.K, nt = K / BK;
    unsigned voffA[2], voffB[2];
#pragma unroll
    for (int i = 0; i < 2; ++i) { int R, C; stage_rc(tid * 16 + i * 8192, R, C); const int Rb = Epi::PERM ? ((R & ~31) + perm32(R & 31)) : R;
        voffA[i] = (unsigned)(R * g.ld + C) * 2u; voffB[i] = (unsigned)(Rb * g.ld + C) * 2u; }
    const size_t kstep = (size_t)(BK * 2);
    const size_t hstep = (size_t)HALF * g.ld * 2;
    const size_t tstep = 2 * hstep;
    const unsigned ldsw = (unsigned)wid * 1024u;
    const int aoff = lds_byte(wr * 64 + fr, fq * 8), boff = lds_byte(wc * 32 + fr, fq * 8);
#define PG8_SA(b, h) (((b) * 2 + (h)) * HTB)
#define PG8_SB(b, h) ((4 + (b) * 2 + (h)) * HTB)
#define PG8_STAGE(bufoff, gbase, voff) do { _Pragma("unroll") for (int _i = 0; _i < 2; ++_i) \
        __builtin_amdgcn_global_load_lds((const unsigned*)((const char*)(gbase) + (voff)[_i]), (PG8_LAS unsigned*)(lds + (bufoff) + ldsw + _i * 8192), 16, 0, 0); } while (0)
#define PG8_LDA(dst, b, h) do { _Pragma("unroll") for (int m = 0; m < 4; ++m) _Pragma("unroll") for (int k = 0; k < 2; ++k) dst[m][k] = *(const PG8_LAS bf16x8*)(lds + PG8_SA(b, h) + aoff + m * 2048 + k * 1024); } while (0)
#define PG8_LDB(dst, b, h) do { _Pragma("unroll") for (int n = 0; n < 2; ++n) _Pragma("unroll") for (int k = 0; k < 2; ++k) dst[n][k] = *(const PG8_LAS bf16x8*)(lds + PG8_SB(b, h) + boff + n * 2048 + k * 1024); } while (0)
#define PG8_MMA(ai, bj, At, Bt) do { __builtin_amdgcn_s_setprio(1); _Pragma("unroll") for (int m = 0; m < 4; ++m) _Pragma("unroll") for (int n = 0; n < 2; ++n) _Pragma("unroll") for (int k = 0; k < 2; ++k) \
        acc[ai][bj][m][n] = __builtin_amdgcn_mfma_f32_16x16x32_bf16(Bt[n][k], At[m][k], acc[ai][bj][m][n], 0, 0, 0); __builtin_amdgcn_s_setprio(0); } while (0)
#define PG8_WAIT_V(n) asm volatile("s_waitcnt vmcnt(" #n ")" ::: "memory")
#define PG8_WAIT_L(n) asm volatile("s_waitcnt lgkmcnt(" #n ")" ::: "memory")
#define PG8_BAR __builtin_amdgcn_s_barrier()
#define PG8_SCHED __builtin_amdgcn_sched_barrier(0)
    Unit cur, nxt; int ui = 0;
    if (!S.next(0, cur)) return;
    f32x4 acc[2][2][4][2];
#pragma unroll
    for (int a = 0; a < 2; ++a)
#pragma unroll
        for (int b = 0; b < 2; ++b)
#pragma unroll
            for (int m = 0; m < 4; ++m)
#pragma unroll
                for (int n = 0; n < 2; ++n) acc[a][b][m][n] = (f32x4){0.f, 0.f, 0.f, 0.f};
    bf16x8 At[4][2], B0[2][2], B1[2][2];
    const char* cA = (const char*)g.A + (size_t)cur.pm * tstep; const char* cB = (const char*)g.Bt + (size_t)cur.pn * tstep;
    S.a_ready(cur);
    if constexpr (SP2) {
        PG8_STAGE(PG8_SB(0, 0), cB, voffB); PG8_STAGE(PG8_SB(0, 1), cB + hstep, voffB); PG8_STAGE(PG8_SA(0, 0), cA, voffA); PG8_STAGE(PG8_SA(0, 1), cA + hstep, voffA);
        if (wr == 1) PG8_BAR;
        PG8_WAIT_V(2); PG8_BAR;
        PG8_STAGE(PG8_SB(1, 0), cB + kstep, voffB); PG8_STAGE(PG8_SA(1, 0), cA + kstep, voffA); PG8_STAGE(PG8_SB(1, 1), cB + hstep + kstep, voffB);
        PG8_WAIT_V(6); PG8_BAR;
    } else {
        PG8_STAGE(PG8_SB(0, 0), cB, voffB); PG8_STAGE(PG8_SA(0, 0), cA, voffA); PG8_STAGE(PG8_SB(0, 1), cB + hstep, voffB); PG8_STAGE(PG8_SA(0, 1), cA + hstep, voffA);
        if (wr == 1) PG8_BAR;
        PG8_WAIT_V(4); PG8_BAR;
        PG8_STAGE(PG8_SB(1, 0), cB + kstep, voffB); PG8_STAGE(PG8_SA(1, 0), cA + kstep, voffA); PG8_STAGE(PG8_SB(1, 1), cB + hstep + kstep, voffB);
        PG8_WAIT_V(6); PG8_BAR;
    }
    for (;;) {
        const bool has_next = S.next(ui + 1, nxt);
        const char* nA = has_next ? (const char*)g.A + (size_t)nxt.pm * tstep : cA; const char* nB = has_next ? (const char*)g.Bt + (size_t)nxt.pn * tstep : cB;
        for (int t = 0; t < nt; t += 2) {
            const bool last = (t == nt - 2);
            const char* a1 = cA + (size_t)(t + 1) * kstep;
            const char* a2 = last ? nA : cA + (size_t)(t + 2) * kstep; const char* b2 = last ? nB : cB + (size_t)(t + 2) * kstep;
            const char* a3 = a2 + kstep; const char* b3 = b2 + kstep;
            if (last && has_next) S.a_ready(nxt);
            if constexpr (SP2) {
            PG8_LDB(B0, 0, 0); PG8_LDB(B1, 0, 1); PG8_SCHED; PG8_LDA(At, 0, 0); PG8_STAGE(PG8_SA(1, 1), a1 + hstep, voffA);
            PG8_WAIT_V(8); PG8_WAIT_L(0); PG8_BAR; PG8_MMA(0, 0, At, B0); PG8_MMA(0, 1, At, B1); PG8_BAR; PG8_SCHED;
            PG8_LDA(At, 0, 1); PG8_STAGE(PG8_SB(0, 0), b2, voffB); PG8_STAGE(PG8_SB(0, 1), b2 + hstep, voffB); PG8_STAGE(PG8_SA(0, 0), a2, voffA);
            PG8_WAIT_V(8); PG8_WAIT_L(0); PG8_BAR; PG8_MMA(1, 0, At, B0); PG8_MMA(1, 1, At, B1); PG8_BAR; PG8_SCHED;
            PG8_LDB(B0, 1, 0); PG8_LDB(B1, 1, 1); PG8_SCHED; PG8_LDA(At, 1, 0); PG8_STAGE(PG8_SA(0, 1), a2 + hstep, voffA);
            PG8_WAIT_V(8); PG8_WAIT_L(0); PG8_BAR; PG8_MMA(0, 0, At, B0); PG8_MMA(0, 1, At, B1); PG8_BAR; PG8_SCHED;
            PG8_LDA(At, 1, 1); PG8_STAGE(PG8_SB(1, 0), b3, voffB); PG8_STAGE(PG8_SB(1, 1), b3 + hstep, voffB); PG8_STAGE(PG8_SA(1, 0), a3, voffA);
            PG8_WAIT_V(8); PG8_WAIT_L(0); PG8_BAR; PG8_MMA(1, 0, At, B0); PG8_MMA(1, 1, At, B1); PG8_BAR; PG8_SCHED;
            } else {
            PG8_LDB(B0, 0, 0); PG8_SCHED; PG8_LDA(At, 0, 0); PG8_STAGE(PG8_SA(1, 1), a1 + hstep, voffA);
            PG8_WAIT_L(8); PG8_BAR; PG8_WAIT_L(0); PG8_MMA(0, 0, At, B0); PG8_BAR; PG8_SCHED;
            PG8_LDB(B1, 0, 1); PG8_STAGE(PG8_SB(0, 0), b2, voffB);
            PG8_BAR; PG8_WAIT_L(0); PG8_MMA(0, 1, At, B1); PG8_BAR;
            PG8_LDA(At, 0, 1); PG8_STAGE(PG8_SA(0, 0), a2, voffA);
            PG8_BAR; PG8_WAIT_L(0); PG8_MMA(1, 0, At, B0); PG8_BAR; PG8_SCHED;
            PG8_STAGE(PG8_SB(0, 1), b2 + hstep, voffB);
            PG8_WAIT_V(6); PG8_BAR; PG8_MMA(1, 1, At, B1); PG8_BAR;
            PG8_LDB(B0, 1, 0); PG8_SCHED; PG8_LDA(At, 1, 0); PG8_STAGE(PG8_SA(0, 1), a2 + hstep, voffA);
            PG8_WAIT_L(8); PG8_BAR; PG8_WAIT_L(0); PG8_MMA(0, 0, At, B0); PG8_BAR; PG8_SCHED;
            PG8_LDB(B1, 1, 1); PG8_STAGE(PG8_SB(1, 0), b3, voffB);
            PG8_BAR; PG8_WAIT_L(0); PG8_MMA(0, 1, At, B1); PG8_BAR;
            PG8_LDA(At, 1, 1); PG8_STAGE(PG8_SA(1, 0), a3, voffA);
            PG8_BAR; PG8_WAIT_L(0); PG8_MMA(1, 0, At, B0); PG8_BAR; PG8_SCHED;
            PG8_STAGE(PG8_SB(1, 1), b3 + hstep, voffB);
            PG8_WAIT_V(6); PG8_BAR; PG8_MMA(1, 1, At, B1); PG8_BAR;
            }
        }
        if constexpr (ALIGN_EPI) { if (wr == 0) PG8_BAR; }
        if constexpr (!Epi::AFTER_DRAIN) { E(acc, cur, wr, wc, fr, fq); S.done(cur); }
        if (!has_next) break;
#pragma unroll
        for (int a = 0; a < 2; ++a)
#pragma unroll
            for (int b = 0; b < 2; ++b)
#pragma unroll
                for (int m = 0; m < 4; ++m)
#pragma unroll
                    for (int n = 0; n < 2; ++n) acc[a][b][m][n] = (f32x4){0.f, 0.f, 0.f, 0.f};
        cur = nxt; cA = nA; cB = nB; ++ui;
        if constexpr (ALIGN_EPI) { if (wr == 1) PG8_BAR; }
    }
    PG8_WAIT_V(0);
    if constexpr (!ALIGN_EPI) { if (wr == 0) PG8_BAR; }
    PG8_BAR;
    if constexpr (Epi::AFTER_DRAIN) { E.fused(acc, cur, wr, wc, fr, fq, lds, wid, lane); S.done(cur); }
#undef PG8_SA
#undef PG8_SB
#undef PG8_STAGE
#undef PG8_LDA
#undef PG8_LDB
#undef PG8_MMA
#undef PG8_WAIT_V
#undef PG8_WAIT_L
#undef PG8_BAR
#undef PG8_SCHED
}
}

#define LAS __attribute__((address_space(3)))
typedef unsigned short bf16;
typedef unsigned v4u __attribute__((ext_vector_type(4)));
typedef unsigned v2u __attribute__((ext_vector_type(2)));
typedef float f32x4 __attribute__((ext_vector_type(4)));
typedef short bf16x8 __attribute__((ext_vector_type(8)));
#define LDS_WAIT() asm volatile("s_waitcnt lgkmcnt(0)" ::: "memory")
#define MFMA16(a, b, c) __builtin_amdgcn_mfma_f32_16x16x32_bf16((a), (b), (c), 0, 0, 0)

constexpr int NWAVES = 8, NTHR = 512;
constexpr int NB = 2, S = 8192, T = NB * S, D = 1024;
constexpr int LDS_BYTES = 147456;
constexpr float LOG2E = 1.4426950408889634f;
constexpr int NIN = 4888, NIN_PAD = 5120;

constexpr size_t MiB = 1u << 20;
constexpr size_t WS_CTL = 0, CTL_BYTES = 1 * MiB;
constexpr size_t WS_MEMN = 1 * MiB, WS_WIN_T = 2 * MiB, WS_CKW1_T = 12 * MiB, WS_CVW1_T = 13 * MiB, WS_WA_T = 14 * MiB, WS_WB_T = 15 * MiB, WS_WOUT_T = 16 * MiB,
                 WS_WCQ_T = 18 * MiB, WS_WCKV_T = 19 * MiB, WS_WCO_T = 21 * MiB, WS_WPS_T = 22 * MiB;
constexpr size_t WS_KCMP = 26 * MiB, WS_VCMP_T = 26 * MiB + 256 * 1024, WS_KMEM = 27 * MiB, WS_VMEM_T = 27 * MiB + 512 * 1024, WS_GB = 28 * MiB;
constexpr size_t WS_U = 32 * MiB;
constexpr size_t WS_QA = 64 * MiB, WS_KA = 80 * MiB, WS_VAT = 96 * MiB, WS_QB = 112 * MiB;
constexpr size_t WS_PU = 64 * MiB, WS_PV = 96 * MiB;
constexpr size_t WS_KCI = 128 * MiB, WS_VCI = 132 * MiB, WS_KS = 136 * MiB, WS_VST = 140 * MiB, WS_KW = 144 * MiB, WS_VWT = 148 * MiB;
constexpr size_t WS_OA = 152 * MiB, WS_OB = 168 * MiB, WS_HIDP = 152 * MiB;
constexpr size_t WS_GA = 184 * MiB, WS_GBT = 216 * MiB;
constexpr size_t WS_H = 192 * MiB;
constexpr size_t WS_QC = 128 * MiB, WS_OC = 144 * MiB, WS_SCORES = 128 * MiB;
constexpr size_t WS_END = 256 * MiB;

__device__ __forceinline__ unsigned pk2(float lo, float hi) { return pg8::cvt_pk_bf16(lo, hi); }
__device__ __forceinline__ unsigned short f2bf1(float f) { return (unsigned short)(pk2(f, 0.f) & 0xffffu); }
__device__ __forceinline__ float bflo(unsigned u) { return __builtin_bit_cast(float, u << 16); }
__device__ __forceinline__ float bfhi(unsigned u) { return __builtin_bit_cast(float, u & 0xffff0000u); }
__device__ __forceinline__ float wave_sum(float v) {
#pragma unroll
    for (int o = 1; o < 64; o <<= 1) v += __shfl_xor(v, o);
    return v;
}
__device__ __forceinline__ float sigm(float x) { return 1.f / (1.f + __expf(-x)); }
__device__ __forceinline__ float gelu_erf(float x) { return 0.5f * x * (1.f + erff(x * 0.70710678118654752f)); }
__device__ __forceinline__ float ex2(float x) { return __builtin_amdgcn_exp2f(x); }
__device__ __forceinline__ void store8bf(bf16* dst, const float* v) { v4u w; w.x = pk2(v[0], v[1]); w.y = pk2(v[2], v[3]); w.z = pk2(v[4], v[5]); w.w = pk2(v[6], v[7]); *(v4u*)dst = w; }
__device__ __forceinline__ bf16x8 ldg8(const bf16* p) { return *(const bf16x8*)p; }
__device__ __forceinline__ bf16x8 pack8(float a0, float a1, float a2, float a3, float a4, float a5, float a6, float a7) {
    v4u w; w.x = pk2(a0, a1); w.y = pk2(a2, a3); w.z = pk2(a4, a5); w.w = pk2(a6, a7); return __builtin_bit_cast(bf16x8, w);
}

struct Args { const float* in[25]; float* out; unsigned char* ws; int ph_lo, ph_hi; };

enum { EM_G1 = 0, EM_PART, EM_KVMEM, EM_MA, EM_MB, EM_H1, EM_QC, EM_H2, EM_SC };
struct EpiAll {
    int mode; unsigned char* ws; const float* x; const float* cmp_pos; float* part;
    __device__ __forceinline__ void operator()(int row, int col, const f32x4& v0, const f32x4& v1) const {
        float v[8] = {v0[0], v0[1], v0[2], v0[3], v1[0], v1[1], v1[2], v1[3]};
        switch (mode) {
        case EM_G1: {
            if (col >= NIN) return;
            const int b = row >> 13, s = row & (S - 1);
            if (col < 1024) {
                const bool isq = col < 512; bf16* dst = (bf16*)(ws + (isq ? WS_QA : WS_KA)) + (size_t)row * 512 + (col & 511);
                const float sc = isq ? 0.125f : 1.f;
#pragma unroll
                for (int i = 0; i < 8; ++i) v[i] *= sc;
                store8bf(dst, v);
            } else if (col < 1536) {
                bf16* dst = (bf16*)(ws + WS_VAT) + (size_t)(b * 512 + (col - 1024)) * S + s;
#pragma unroll
                for (int i = 0; i < 8; ++i) dst[(size_t)i * S] = f2bf1(v[i]);
            } else if (col < 2048) {
#pragma unroll
                for (int i = 0; i < 8; ++i) v[i] *= 0.125f;
                store8bf((bf16*)(ws + WS_QB) + (size_t)row * 512 + (col - 1536), v);
            } else if (col < 2816) {
                const int c2 = col - 2048, j = c2 >> 7, gg = (c2 >> 6) & 1, d = c2 & 63; const size_t bg = (size_t)(b * 2 + gg);
                if (j == 0 || j == 1) {
                    const float* cp = cmp_pos + (s & 31) * 64 + d;
#pragma unroll
                    for (int i = 0; i < 8; ++i) v[i] += cp[i];
                    store8bf((bf16*)(ws + (j == 0 ? WS_KCI : WS_VCI)) + (bg * S + s) * 64 + d, v);
                } else if (j == 2 || j == 4) {
                    store8bf((bf16*)(ws + (j == 2 ? WS_KS : WS_KW)) + (bg * S + s) * 64 + d, v);
                } else {
                    bf16* dst = (bf16*)(ws + (j == 3 ? WS_VST : WS_VWT)) + (bg * 64 + d) * S + s;
#pragma unroll
                    for (int i = 0; i < 8; ++i) dst[(size_t)i * S] = f2bf1(v[i]);
                }
            } else if (col < 2840) {
                float* dst = (float*)(ws + WS_GB) + (size_t)row * 24 + (col - 2816);
                *(f32x4*)dst = (f32x4){sigm(v[0]), sigm(v[1]), sigm(v[2]), sigm(v[3])}; *(f32x4*)(dst + 4) = (f32x4){sigm(v[4]), sigm(v[5]), sigm(v[6]), sigm(v[7])};
            } else {
                const bool ia = col < 3864; bf16* dst = (bf16*)(ws + (ia ? WS_GA : WS_GBT)) + (size_t)row * 1024 + (col - (ia ? 2840 : 3864));
#pragma unroll
                for (int i = 0; i < 8; ++i) v[i] = sigm(v[i]);
                store8bf(dst, v);
            }
        } break;
        case EM_PART: { float* dst = part + (size_t)row * 256 + col; *(f32x4*)dst = v0; *(f32x4*)(dst + 4) = v1; } break;
        case EM_KVMEM: {
            const int b = row >> 8, m = row & 255, c2 = col & 511, h = c2 >> 7, d = c2 & 127;
            if (col < 512) store8bf((bf16*)(ws + WS_KMEM) + ((size_t)((b * 4 + h) * 256 + m)) * 128 + d, v);
            else { bf16* dst = (bf16*)(ws + WS_VMEM_T) + ((size_t)((b * 4 + h) * 128 + d)) * 256 + m;
#pragma unroll
                for (int i = 0; i < 8; ++i) dst[i * 256] = f2bf1(v[i]); }
        } break;
        case EM_MA: {
            const v4u gq = *(const v4u*)((const bf16*)(ws + WS_GA) + (size_t)row * 1024 + col);
            const float g[8] = {bflo(gq.x), bfhi(gq.x), bflo(gq.y), bfhi(gq.y), bflo(gq.z), bfhi(gq.z), bflo(gq.w), bfhi(gq.w)};
#pragma unroll
            for (int i = 0; i < 8; ++i) v[i] *= g[i];
            store8bf((bf16*)(ws + WS_U) + (size_t)row * 1024 + col, v);
        } break;
        case EM_MB: {
            const v4u gq = *(const v4u*)((const bf16*)(ws + WS_GBT) + (size_t)row * 1024 + col);
            bf16* mp = (bf16*)(ws + WS_U) + (size_t)row * 1024 + col; const v4u mq = *(const v4u*)mp;
            const float g[8] = {bflo(gq.x), bfhi(gq.x), bflo(gq.y), bfhi(gq.y), bflo(gq.z), bfhi(gq.z), bflo(gq.w), bfhi(gq.w)};
            const float mm[8] = {bflo(mq.x), bfhi(mq.x), bflo(mq.y), bfhi(mq.y), bflo(mq.z), bfhi(mq.z), bflo(mq.w), bfhi(mq.w)};
#pragma unroll
            for (int i = 0; i < 8; ++i) v[i] = mm[i] + g[i] * v[i];
            store8bf(mp, v);
        } break;
        case EM_H1: {
            const float* xp = x + (size_t)row * 1024 + col; float* hp = (float*)(ws + WS_H) + (size_t)row * 1024 + col;
            const f32x4 x0 = *(const f32x4*)xp, x1 = *(const f32x4*)(xp + 4);
            *(f32x4*)hp = x0 + v0; *(f32x4*)(hp + 4) = x1 + v1;
        } break;
        case EM_QC: {
#pragma unroll
            for (int i = 0; i < 8; ++i) v[i] *= 0.08838834764831845f;
            store8bf((bf16*)(ws + WS_QC) + (size_t)row * 512 + col, v);
        } break;
        case EM_H2: {
            float* hp = (float*)(ws + WS_H) + (size_t)row * 1024 + col;
            const f32x4 x0 = *(const f32x4*)hp, x1 = *(const f32x4*)(hp + 4);
            *(f32x4*)hp = x0 + v0; *(f32x4*)(hp + 4) = x1 + v1;
        } break;
        default: {
            store8bf((bf16*)(ws + WS_SCORES) + (size_t)row * 2048 + col, v);
        } break;
        }
    }
};
typedef pg8::EpiF<EpiAll> EpiT;

__device__ __forceinline__ void run_gemm(LAS unsigned char* lds, const bf16* A, const bf16* Bt, int M, int N, int K, int ld, int G, int c, const EpiAll& ea) {
    pg8::Gemm g{A, Bt, M, N, K, ld}; pg8::StaticOrder So; So.init(M, N, G, c);
    EpiT E{ea};
    pg8::gemm_phase<EpiT, pg8::StaticOrder, true, true>(lds, g, So, E);
}

__device__ __forceinline__ void transpose_item(const float* W, int K, int Nsrc, int nblk, bf16* WT, LAS float* scr, int item, int lane) {
    const int kb = item / nblk, nb = item % nblk, k0 = 64 * kb, n0 = 32 * nb; const int n = n0 + (lane & 31);
#pragma unroll 8
    for (int i = 0; i < 32; ++i) { const int kk = 2 * i + (lane >> 5); scr[kk * 33 + (lane & 31)] = (n < Nsrc) ? W[(size_t)(k0 + kk) * Nsrc + n] : 0.f; }
    LDS_WAIT();
    const int c = lane & 7;
#pragma unroll
    for (int j = 0; j < 4; ++j) { const int nn = (lane >> 3) + 8 * j; const LAS float* s = scr + (8 * c) * 33 + nn;
        v4u o; o.x = pk2(s[0 * 33], s[1 * 33]); o.y = pk2(s[2 * 33], s[3 * 33]); o.z = pk2(s[4 * 33], s[5 * 33]); o.w = pk2(s[6 * 33], s[7 * 33]);
        *(v4u*)(WT + (size_t)(n0 + nn) * K + k0 + 8 * c) = o; }
    LDS_WAIT();
}
__device__ __forceinline__ void rms_row_to_bf16(const float* xrow, const float* g, bf16* orow, int lane) {
    const f32x4* xr = (const f32x4*)xrow + lane; const f32x4* gr = (const f32x4*)g + lane;
    f32x4 v[4]; float s = 0.f;
#pragma unroll
    for (int j = 0; j < 4; ++j) { v[j] = xr[64 * j]; s += (v[j].x * v[j].x + v[j].y * v[j].y) + (v[j].z * v[j].z + v[j].w * v[j].w); }
    const float rstd = rsqrtf(wave_sum(s) * (1.f / D) + 1e-6f);
    v2u* o8 = (v2u*)orow + lane;
#pragma unroll
    for (int j = 0; j < 4; ++j) { const f32x4 gg = gr[64 * j]; v2u w; w.x = pk2(v[j].x * rstd * gg.x, v[j].y * rstd * gg.y); w.y = pk2(v[j].z * rstd * gg.z, v[j].w * rstd * gg.w); o8[64 * j] = w; }
}


__device__ __forceinline__ void diff_item(unsigned char* ws, const float* lamp, const float* subln, int bh, int qt, LAS float* park, int lane) {
    const int b = bh >> 2, h = bh & 3, fr = lane & 15, fq = lane >> 4, q0 = qt * 32;
    float lam;
    { const float a = lamp[lane] * lamp[64 + lane], c = lamp[128 + lane] * lamp[192 + lane]; lam = __expf(wave_sum(a)) - __expf(wave_sum(c)) + 0.2f; }
    const float slope2 = ex2(-2.f * (float)(h + 1)) * LOG2E;
    const bf16* Qb = (const bf16*)(ws + WS_QA) + (size_t)(b * S) * 512 + h * 128;
    const bf16* Kb = (const bf16*)(ws + WS_KA) + (size_t)(b * S) * 512 + h * 128;
    const bf16* Vb = (const bf16*)(ws + WS_VAT) + (size_t)((b * 4 + h) * 128) * S;
    const int kr0 = 8 * (fr >> 2) + (fr & 3);
    const int nsteps = qt + 1;
    for (int c = 0; c < 2; ++c) {
        bf16x8 Qf[2][2];
#pragma unroll
        for (int nt = 0; nt < 2; ++nt)
#pragma unroll
            for (int ks = 0; ks < 2; ++ks) Qf[nt][ks] = ldg8(Qb + (size_t)(q0 + nt * 16 + fr) * 512 + c * 64 + ks * 32 + fq * 8);
        f32x4 O[8][2];
#pragma unroll
        for (int mt = 0; mt < 8; ++mt) { O[mt][0] = (f32x4){0.f, 0.f, 0.f, 0.f}; O[mt][1] = (f32x4){0.f, 0.f, 0.f, 0.f}; }
        float mrun[2] = {-1e30f, -1e30f}, lrun[2] = {0.f, 0.f};
        const bf16* kp = Kb + (size_t)kr0 * 512 + c * 64 + fq * 8;
        bf16x8 Kc[2][2];
#pragma unroll
        for (int t = 0; t < 2; ++t)
#pragma unroll
            for (int ks = 0; ks < 2; ++ks) Kc[t][ks] = ldg8(kp + (size_t)(4 * t) * 512 + ks * 32);
        for (int kb = 0; kb < nsteps; ++kb) {
            bf16x8 Vf[8];
#pragma unroll
            for (int mt = 0; mt < 8; ++mt) Vf[mt] = ldg8(Vb + (size_t)(mt * 16 + fr) * S + kb * 32 + fq * 8);
            const int kbn = (kb + 1 < nsteps) ? kb + 1 : kb;
            bf16x8 Kn[2][2];
#pragma unroll
            for (int t = 0; t < 2; ++t)
#pragma unroll
                for (int ks = 0; ks < 2; ++ks) Kn[t][ks] = ldg8(kp + (size_t)(kbn * 32 + 4 * t) * 512 + ks * 32);
            f32x4 Sx[2][2];
#pragma unroll
            for (int t = 0; t < 2; ++t)
#pragma unroll
                for (int nt = 0; nt < 2; ++nt) { f32x4 z = {0.f, 0.f, 0.f, 0.f}; z = MFMA16(Kc[t][0], Qf[nt][0], z); Sx[t][nt] = MFMA16(Kc[t][1], Qf[nt][1], z); }
            bf16x8 Pf[2];
#pragma unroll
            for (int nt = 0; nt < 2; ++nt) {
                const int qpos = q0 + nt * 16 + fr;
                const float base = (float)(kb * 32 + fq * 8 - qpos);
                float sv[8]; float mx = -1e30f;
#pragma unroll
                for (int t = 0; t < 2; ++t)
#pragma unroll
                    for (int r = 0; r < 4; ++r) { const float kd = base + (float)(4 * t + r); const float val = Sx[t][nt][r] * LOG2E + slope2 * kd; const float s_ = (kd <= 0.f) ? val : -1e30f; sv[t * 4 + r] = s_; mx = fmaxf(mx, s_); }
                mx = fmaxf(mx, __shfl_xor(mx, 16)); mx = fmaxf(mx, __shfl_xor(mx, 32));
                const float mnew = fmaxf(mrun[nt], mx), alpha = ex2(mrun[nt] - mnew); mrun[nt] = mnew;
                float ps = 0.f;
#pragma unroll
                for (int i = 0; i < 8; ++i) { sv[i] = (sv[i] > -1e29f) ? ex2(sv[i] - mnew) : 0.f; ps += sv[i]; }
                lrun[nt] = lrun[nt] * alpha + ps;
#pragma unroll
                for (int mt = 0; mt < 8; ++mt) O[mt][nt] *= alpha;
                Pf[nt] = pack8(sv[0], sv[1], sv[2], sv[3], sv[4], sv[5], sv[6], sv[7]);
            }
#pragma unroll
            for (int mt = 0; mt < 8; ++mt) { O[mt][0] = MFMA16(Vf[mt], Pf[0], O[mt][0]); O[mt][1] = MFMA16(Vf[mt], Pf[1], O[mt][1]); }
#pragma unroll
            for (int t = 0; t < 2; ++t) { Kc[t][0] = Kn[t][0]; Kc[t][1] = Kn[t][1]; }
        }
        float inv[2];
#pragma unroll
        for (int nt = 0; nt < 2; ++nt) { float l = lrun[nt]; l += __shfl_xor(l, 16); l += __shfl_xor(l, 32); inv[nt] = 1.f / l; }
        if (c == 0) {
#pragma unroll
            for (int mt = 0; mt < 8; ++mt)
#pragma unroll
                for (int nt = 0; nt < 2; ++nt)
#pragma unroll
                    for (int r = 0; r < 4; ++r) park[((mt * 2 + nt) * 4 + r) * 64 + lane] = O[mt][nt][r] * inv[nt];
        } else {
            LDS_WAIT();
            float ss[2] = {0.f, 0.f};
#pragma unroll
            for (int mt = 0; mt < 8; ++mt)
#pragma unroll
                for (int nt = 0; nt < 2; ++nt)
#pragma unroll
                    for (int r = 0; r < 4; ++r) { const float v_ = park[((mt * 2 + nt) * 4 + r) * 64 + lane] - lam * (O[mt][nt][r] * inv[nt]); O[mt][nt][r] = v_; ss[nt] += v_ * v_; }
#pragma unroll
            for (int nt = 0; nt < 2; ++nt) {
                float s_ = ss[nt]; s_ += __shfl_xor(s_, 16); s_ += __shfl_xor(s_, 32);
                const float rstd = rsqrtf(s_ * (1.f / 128.f) + 1e-6f) * 0.8f;
                bf16* op = (bf16*)(ws + WS_OA) + (size_t)(b * S + q0 + nt * 16 + fr) * 512 + h * 128 + fq * 4;
#pragma unroll
                for (int mt = 0; mt < 8; ++mt) { const f32x4 gg = *(const f32x4*)(subln + mt * 16 + fq * 4);
                    v2u w; w.x = pk2(O[mt][nt][0] * rstd * gg.x, O[mt][nt][1] * rstd * gg.y); w.y = pk2(O[mt][nt][2] * rstd * gg.z, O[mt][nt][3] * rstd * gg.w);
                    *(v2u*)(op + mt * 16) = w; }
            }
            LDS_WAIT();
        }
    }
}


__device__ __forceinline__ int kswz(int row, int c) { const int F = (0x1320 >> (((row >> 3) & 3) * 4)) & 3; return row * 128 + ((c ^ (F | (((row >> 1) & 1) << 2))) << 4); }
__device__ __forceinline__ int vswz(int row, int c) { const int F = (0x1320 >> (((row >> 2) & 3) * 4)) & 3; return row * 64 + ((c ^ F) << 4); }
__device__ __forceinline__ void diff_wg_item(unsigned char* ws, const float* lamp, const float* subln, int bh, int qb, LAS unsigned char* lds, int tid, int wave, int lane) {
    const int b = bh >> 2, h = bh & 3, fr = lane & 15, fq = lane >> 4, wv = wave & 3, cm = wave >> 2;
    const int q0 = qb * 128 + wv * 32, lastkb = qb * 4 + wv, nsteps = qb * 4 + 4;
    float lam;
    { const float a = lamp[lane] * lamp[64 + lane], c = lamp[128 + lane] * lamp[192 + lane]; lam = __expf(wave_sum(a)) - __expf(wave_sum(c)) + 0.2f; }
    const float slope2 = ex2(-2.f * (float)(h + 1)) * LOG2E;
    const bf16* Qb = (const bf16*)(ws + WS_QA) + (size_t)(b * S) * 512 + h * 128;
    const bf16* Kb = (const bf16*)(ws + WS_KA) + (size_t)(b * S) * 512 + h * 128;
    const bf16* Vb = (const bf16*)(ws + WS_VAT) + (size_t)((b * 4 + h) * 128) * S;
    const int kr0 = 8 * (fr >> 2) + (fr & 3);
    const bf16* gA = Kb + (size_t)((tid & 255) >> 3) * 512 + (tid >> 8) * 64 + (tid & 7) * 8;
    const int lA = (tid >> 8) * 4096 + kswz((tid & 255) >> 3, tid & 7);
    const bf16* gB = Vb + (size_t)(tid >> 2) * S + (tid & 3) * 8;
    const int lB = 8192 + vswz(tid >> 2, tid & 3);
    bf16x8 Qf[2][2];
#pragma unroll
    for (int nt = 0; nt < 2; ++nt)
#pragma unroll
        for (int ks = 0; ks < 2; ++ks) Qf[nt][ks] = ldg8(Qb + (size_t)(q0 + nt * 16 + fr) * 512 + cm * 64 + ks * 32 + fq * 8);
    f32x4 O[8][2];
#pragma unroll
    for (int mt = 0; mt < 8; ++mt) { O[mt][0] = (f32x4){0.f, 0.f, 0.f, 0.f}; O[mt][1] = (f32x4){0.f, 0.f, 0.f, 0.f}; }
    float mrun[2] = {-1e30f, -1e30f}, lrun[2] = {0.f, 0.f};
    int koff[2][2];
#pragma unroll
    for (int t = 0; t < 2; ++t)
#pragma unroll
        for (int ks = 0; ks < 2; ++ks) koff[t][ks] = cm * 4096 + kswz(kr0 + 4 * t, ks * 4 + fq);
    const int voff = 8192 + vswz(fr, fq);
    float cst[8];
#pragma unroll
    for (int i = 0; i < 8; ++i) cst[i] = slope2 * (float)i;
    v4u ra = *(const v4u*)gA, rb = *(const v4u*)gB;
    *(LAS v4u*)(lds + lA) = ra; *(LAS v4u*)(lds + lB) = rb;
    __syncthreads();
    for (int kb = 0; kb < nsteps; ++kb) {
        const int cur = (kb & 1) * 16384, nxt = 16384 - cur;
        const bool more = kb + 1 < nsteps;
        if (more) { ra = *(const v4u*)(gA + (size_t)(kb + 1) * 32 * 512); rb = *(const v4u*)(gB + (kb + 1) * 32); }
        if (kb <= lastkb) {
            bf16x8 Kc[2][2];
#pragma unroll
            for (int t = 0; t < 2; ++t)
#pragma unroll
                for (int ks = 0; ks < 2; ++ks) Kc[t][ks] = *(const LAS bf16x8*)(lds + cur + koff[t][ks]);
            f32x4 Sx[2][2];
#pragma unroll
            for (int t = 0; t < 2; ++t)
#pragma unroll
                for (int nt = 0; nt < 2; ++nt) { f32x4 z = {0.f, 0.f, 0.f, 0.f}; z = MFMA16(Kc[t][0], Qf[nt][0], z); Sx[t][nt] = MFMA16(Kc[t][1], Qf[nt][1], z); }
            bf16x8 Vf[8];
#pragma unroll
            for (int mt = 0; mt < 8; ++mt) Vf[mt] = *(const LAS bf16x8*)(lds + cur + voff + mt * 1024);
            const bool diag = (kb == lastkb);
            bf16x8 Pf[2];
#pragma unroll
            for (int nt = 0; nt < 2; ++nt) {
                const int dq = q0 + nt * 16 + fr - (kb * 32 + fq * 8);
                const float sb = -slope2 * (float)dq;
                float sv[8];
#pragma unroll
                for (int t = 0; t < 2; ++t)
#pragma unroll
                    for (int r = 0; r < 4; ++r) sv[t * 4 + r] = fmaf(Sx[t][nt][r], LOG2E, sb + cst[t * 4 + r]);
                if (diag) {
#pragma unroll
                    for (int i = 0; i < 8; ++i) sv[i] = (i <= dq) ? sv[i] : -1e30f;
                }
                float mx = fmaxf(fmaxf(fmaxf(sv[0], sv[1]), fmaxf(sv[2], sv[3])), fmaxf(fmaxf(sv[4], sv[5]), fmaxf(sv[6], sv[7])));
                mx = fmaxf(mx, __shfl_xor(mx, 16)); mx = fmaxf(mx, __shfl_xor(mx, 32));
                const float mold = mrun[nt], mnew = fmaxf(mold, mx);
                float ps = 0.f;
#pragma unroll
                for (int i = 0; i < 8; ++i) { sv[i] = ex2(sv[i] - mnew); ps += sv[i]; }
                if (__ballot(mnew > mold) != 0ull) {
                    const float alpha = ex2(mold - mnew); mrun[nt] = mnew; lrun[nt] *= alpha;
#pragma unroll
                    for (int mt = 0; mt < 8; ++mt) O[mt][nt] *= alpha;
                }
                lrun[nt] += ps;
                Pf[nt] = pack8(sv[0], sv[1], sv[2], sv[3], sv[4], sv[5], sv[6], sv[7]);
            }
#pragma unroll
            for (int mt = 0; mt < 8; ++mt) { O[mt][0] = MFMA16(Vf[mt], Pf[0], O[mt][0]); O[mt][1] = MFMA16(Vf[mt], Pf[1], O[mt][1]); }
        }
        if (more) { *(LAS v4u*)(lds + nxt + lA) = ra; *(LAS v4u*)(lds + nxt + lB) = rb; }
        __syncthreads();
    }
    float inv[2];
#pragma unroll
    for (int nt = 0; nt < 2; ++nt) { float l = lrun[nt]; l += __shfl_xor(l, 16); l += __shfl_xor(l, 32); inv[nt] = 1.f / l; }
    LAS float* park = (LAS float*)(lds + 32768 + wv * 16384);
    if (cm == 1) {
#pragma unroll
        for (int mt = 0; mt < 8; ++mt)
#pragma unroll
            for (int nt = 0; nt < 2; ++nt)
#pragma unroll
                for (int r = 0; r < 4; ++r) park[((mt * 2 + nt) * 4 + r) * 64 + lane] = O[mt][nt][r] * inv[nt];
    }
    __syncthreads();
    if (cm == 0) {
        float ss[2] = {0.f, 0.f};
#pragma unroll
        for (int mt = 0; mt < 8; ++mt)
#pragma unroll
            for (int nt = 0; nt < 2; ++nt)
#pragma unroll
                for (int r = 0; r < 4; ++r) { const float v_ = O[mt][nt][r] * inv[nt] - lam * park[((mt * 2 + nt) * 4 + r) * 64 + lane]; O[mt][nt][r] = v_; ss[nt] += v_ * v_; }
#pragma unroll
        for (int nt = 0; nt < 2; ++nt) {
            float s_ = ss[nt]; s_ += __shfl_xor(s_, 16); s_ += __shfl_xor(s_, 32);
            const float rstd = rsqrtf(s_ * (1.f / 128.f) + 1e-6f) * 0.8f;
            bf16* op = (bf16*)(ws + WS_OA) + (size_t)(b * S + q0 + nt * 16 + fr) * 512 + h * 128 + fq * 4;
#pragma unroll
            for (int mt = 0; mt < 8; ++mt) { const f32x4 gg = *(const f32x4*)(subln + mt * 16 + fq * 4);
                v2u w; w.x = pk2(O[mt][nt][0] * rstd * gg.x, O[mt][nt][1] * rstd * gg.y); w.y = pk2(O[mt][nt][2] * rstd * gg.z, O[mt][nt][3] * rstd * gg.w);
                *(v2u*)(op + mt * 16) = w; }
        }
    }
    __syncthreads();
}

template <int MODE>
__device__ __forceinline__ void nsa_step(const bf16* Kp, const bf16* Vp, int kbase, const bf16x8 (&Qf)[2], int qpos, float slope2, bool blkok, int fr, int fq, int kr0,
                                         float& mrun, float& lrun, f32x4 (&O)[4]) {
    bf16x8 Ka[2][2];
#pragma unroll
    for (int t = 0; t < 2; ++t)
#pragma unroll
        for (int ks = 0; ks < 2; ++ks) Ka[t][ks] = ldg8(Kp + (size_t)(kbase + kr0 + 4 * t) * 64 + ks * 32 + fq * 8);
    bf16x8 Vf[4];
#pragma unroll
    for (int mt = 0; mt < 4; ++mt) Vf[mt] = ldg8(Vp + (size_t)(mt * 16 + fr) * S + kbase + fq * 8);
    f32x4 Sx[2];
#pragma unroll
    for (int t = 0; t < 2; ++t) { f32x4 z = {0.f, 0.f, 0.f, 0.f}; z = MFMA16(Ka[t][0], Qf[0], z); Sx[t] = MFMA16(Ka[t][1], Qf[1], z); }
    const int kd0 = kbase + fq * 8 - qpos;
    float sv[8]; float mx = -1e30f;
#pragma unroll
    for (int t = 0; t < 2; ++t)
#pragma unroll
        for (int r = 0; r < 4; ++r) { const int kd = kd0 + 4 * t + r; const bool ok = (MODE == 0) ? (blkok && kd <= 0) : (kd <= 0 && kd > -512);
            const float val = Sx[t][r] * LOG2E + slope2 * (float)kd; const float s_ = ok ? val : -1e30f; sv[t * 4 + r] = s_; mx = fmaxf(mx, s_); }
    mx = fmaxf(mx, __shfl_xor(mx, 16)); mx = fmaxf(mx, __shfl_xor(mx, 32));
    const float mnew = fmaxf(mrun, mx), alpha = ex2(mrun - mnew); mrun = mnew;
    float ps = 0.f;
#pragma unroll
    for (int i = 0; i < 8; ++i) { sv[i] = (sv[i] > -1e29f) ? ex2(sv[i] - mnew) : 0.f; ps += sv[i]; }
    lrun = lrun * alpha + ps;
    const bf16x8 Pf = pack8(sv[0], sv[1], sv[2], sv[3], sv[4], sv[5], sv[6], sv[7]);
#pragma unroll
    for (int mt = 0; mt < 4; ++mt) { O[mt] *= alpha; O[mt] = MFMA16(Vf[mt], Pf, O[mt]); }
}

__device__ __forceinline__ void cmp_scores(const bf16* Kc, int u, const bf16x8 (&Qf)[2], int qpos, int nv, float slope2, int fq, int kr0, float (&sv)[8]) {
#pragma unroll
    for (int t = 0; t < 2; ++t) {
        const bf16* kp = Kc + (size_t)(32 * u + kr0 + 4 * t) * 64 + fq * 8;
        f32x4 z = {0.f, 0.f, 0.f, 0.f}; z = MFMA16(ldg8(kp), Qf[0], z); z = MFMA16(ldg8(kp + 32), Qf[1], z);
#pragma unroll
        for (int rr = 0; rr < 4; ++rr) { const int cidx = 32 * u + 8 * fq + 4 * t + rr; const float dist = (float)(qpos - (cidx * 32 + 31));
            sv[t * 4 + rr] = (cidx < nv) ? (z[rr] * LOG2E - slope2 * dist) : -1e30f; }
    }
}

__device__ __forceinline__ void nsa_item(unsigned char* ws, int bg, int it, LAS float* wl, int lane) {
    const int b = bg >> 1, g = bg & 1, fr = lane & 15, fq = lane >> 4, i = fr >> 2, r = fr & 3, s0 = it * 4, qpos = s0 + i;
    const int kr0 = 8 * (fr >> 2) + (fr & 3);
    const float slope2 = ex2(-(float)(g * 4 + r + 1)) * LOG2E;
    bf16x8 Qf[2];
    { const bf16* qp = (const bf16*)(ws + WS_QB) + (size_t)(b * S + qpos) * 512 + (g * 4 + r) * 64 + fq * 8; Qf[0] = ldg8(qp); Qf[1] = ldg8(qp + 32); }
    const float* gp = (const float*)(ws + WS_GB) + (size_t)(b * S + qpos) * 24 + g * 12 + r * 3;
    const float g0 = gp[0], g1 = gp[1], g2 = gp[2];
    f32x4 Oacc[4];
#pragma unroll
    for (int mt = 0; mt < 4; ++mt) Oacc[mt] = (f32x4){0.f, 0.f, 0.f, 0.f};
#pragma unroll
    for (int e = 0; e < 8; ++e) wl[e * 64 + lane] = 0.f;
    const int nv = (qpos + 1) >> 5, nvmax = (s0 + 4) >> 5;
    if (nvmax > 0) {
        const bf16* Kc = (const bf16*)(ws + WS_KCMP) + (size_t)(bg * 256) * 64;
        const bf16* Vc = (const bf16*)(ws + WS_VCMP_T) + (size_t)(bg * 64) * 256;
        const int nu = (nvmax + 31) >> 5;
        float mloc = -1e30f, lloc = 0.f;
#pragma unroll 1
        for (int u = 0; u < nu; ++u) {
            float sv[8]; cmp_scores(Kc, u, Qf, qpos, nv, slope2, fq, kr0, sv);
            float mx = mloc;
#pragma unroll
            for (int e = 0; e < 8; ++e) mx = fmaxf(mx, sv[e]);
            float ps = 0.f;
#pragma unroll
            for (int e = 0; e < 8; ++e) ps += (sv[e] > -1e29f) ? ex2(sv[e] - mx) : 0.f;
            lloc = lloc * ex2(mloc - mx) + ps; mloc = mx;
        }
        float mx = fmaxf(mloc, __shfl_xor(mloc, 16)); mx = fmaxf(mx, __shfl_xor(mx, 32));
        float ls = lloc * ex2(mloc - mx); ls += __shfl_xor(ls, 16); ls += __shfl_xor(ls, 32);
        const float inv = (ls > 0.f) ? 1.f / ls : 0.f;
        f32x4 Oc[4];
#pragma unroll
        for (int mt = 0; mt < 4; ++mt) Oc[mt] = (f32x4){0.f, 0.f, 0.f, 0.f};
#pragma unroll 1
        for (int u = 0; u < nu; ++u) {
            float sv[8]; cmp_scores(Kc, u, Qf, qpos, nv, slope2, fq, kr0, sv);
#pragma unroll
            for (int e = 0; e < 8; ++e) sv[e] = (sv[e] > -1e29f) ? ex2(sv[e] - mx) * inv : 0.f;
#pragma unroll
            for (int t = 0; t < 2; ++t) {
                float e0 = sv[t * 4 + 0] + sv[t * 4 + 1], e1 = sv[t * 4 + 2] + sv[t * 4 + 3];
                e0 += __shfl_xor(e0, 1); e0 += __shfl_xor(e0, 2); e1 += __shfl_xor(e1, 1); e1 += __shfl_xor(e1, 2);
                if (r == 0) { const int j = 16 * u + 4 * fq + 2 * t; wl[i * 128 + j] = e0; wl[i * 128 + j + 1] = e1; }
            }
            const bf16x8 Pf = pack8(sv[0], sv[1], sv[2], sv[3], sv[4], sv[5], sv[6], sv[7]);
#pragma unroll
            for (int mt = 0; mt < 4; ++mt) Oc[mt] = MFMA16(ldg8(Vc + (size_t)(mt * 16 + fr) * 256 + 32 * u + fq * 8), Pf, Oc[mt]);
        }
#pragma unroll
        for (int mt = 0; mt < 4; ++mt) Oacc[mt] = Oc[mt] * g0;
    }
    LDS_WAIT();
    unsigned msk[4] = {0u, 0u, 0u, 0u};
    {
        const int q16 = r + 4 * fq, cur = qpos >> 6;
        float cv[8];
#pragma unroll
        for (int e = 0; e < 8; ++e) { const int j = q16 + 16 * e; const bool forced = (j == 0) || (j == cur) || (j == cur - 1);
            cv[e] = forced ? 1e4f : ((j <= cur) ? wl[i * 128 + j] : -1e9f); }
        for (int round = 0; round < 16; ++round) {
            float best = cv[0]; int be = 0;
#pragma unroll
            for (int e = 1; e < 8; ++e) if (cv[e] > best) { best = cv[e]; be = e; }
            int bj = q16 + 16 * be;
#pragma unroll
            for (int oi = 0; oi < 4; ++oi) { const int off = (oi == 0) ? 1 : (oi == 1) ? 2 : (oi == 2) ? 16 : 32;
                const float ov = __shfl_xor(best, off); const int oj = __shfl_xor(bj, off);
                const bool take = (ov > best) || (ov == best && oj < bj); best = take ? ov : best; bj = take ? oj : bj; }
            const unsigned bit = 1u << (bj & 31); const int w = bj >> 5;
            msk[0] |= (w == 0) ? bit : 0u; msk[1] |= (w == 1) ? bit : 0u; msk[2] |= (w == 2) ? bit : 0u; msk[3] |= (w == 3) ? bit : 0u;
#pragma unroll
            for (int e = 0; e < 8; ++e) if (bj == q16 + 16 * e) cv[e] = -3e38f;
        }
    }
    {
        const bf16* Kp = (const bf16*)(ws + WS_KS) + (size_t)(bg * S) * 64;
        const bf16* Vp = (const bf16*)(ws + WS_VST) + (size_t)(bg * 64) * S;
        float mrun = -1e30f, lrun = 0.f; f32x4 O[4];
#pragma unroll
        for (int mt = 0; mt < 4; ++mt) O[mt] = (f32x4){0.f, 0.f, 0.f, 0.f};
        const int curmax = (s0 + 3) >> 6;
#pragma unroll
        for (int w = 0; w < 4; ++w) {
            unsigned u_ = msk[w]; u_ |= __shfl_xor(u_, 4); u_ |= __shfl_xor(u_, 8);
            unsigned uu = (unsigned)__builtin_amdgcn_readfirstlane((int)u_);
            const int hi = curmax - 32 * w;
            const unsigned vm = (hi < 0) ? 0u : (hi >= 31 ? 0xffffffffu : ((2u << hi) - 1u));
            uu &= vm;
            while (uu) {
                const int jb = __builtin_ctz(uu); uu &= uu - 1u;
                const bool blkok = (msk[w] >> jb) & 1u;
                const int kbase = (32 * w + jb) * 64;
                nsa_step<0>(Kp, Vp, kbase, Qf, qpos, slope2, blkok, fr, fq, kr0, mrun, lrun, O);
                nsa_step<0>(Kp, Vp, kbase + 32, Qf, qpos, slope2, blkok, fr, fq, kr0, mrun, lrun, O);
            }
        }
        float l = lrun; l += __shfl_xor(l, 16); l += __shfl_xor(l, 32);
        const float sc_ = g1 / l;
#pragma unroll
        for (int mt = 0; mt < 4; ++mt) Oacc[mt] += O[mt] * sc_;
    }
    {
        const bf16* Kp = (const bf16*)(ws + WS_KW) + (size_t)(bg * S) * 64;
        const bf16* Vp = (const bf16*)(ws + WS_VWT) + (size_t)(bg * 64) * S;
        float mrun = -1e30f, lrun = 0.f; f32x4 O[4];
#pragma unroll
        for (int mt = 0; mt < 4; ++mt) O[mt] = (f32x4){0.f, 0.f, 0.f, 0.f};
        const int kstart = (s0 - 511 > 0) ? (s0 - 511) : 0;
        for (int k32 = kstart >> 5; k32 <= ((s0 + 3) >> 5); ++k32)
            nsa_step<1>(Kp, Vp, k32 * 32, Qf, qpos, slope2, true, fr, fq, kr0, mrun, lrun, O);
        float l = lrun; l += __shfl_xor(l, 16); l += __shfl_xor(l, 32);
        const float sc_ = g2 / l;
#pragma unroll
        for (int mt = 0; mt < 4; ++mt) Oacc[mt] += O[mt] * sc_;
    }
    bf16* op = (bf16*)(ws + WS_OB) + (size_t)(b * S + qpos) * 512 + (g * 4 + r) * 64 + fq * 4;
#pragma unroll
    for (int mt = 0; mt < 4; ++mt) { v2u w; w.x = pk2(Oacc[mt][0], Oacc[mt][1]); w.y = pk2(Oacc[mt][2], Oacc[mt][3]); *(v2u*)(op + mt * 16) = w; }
    LDS_WAIT();
}

__device__ __forceinline__ void cross_item(unsigned char* ws, int rt, int h, int lane) {
    const int fr = lane & 15, fq = lane >> 4, row = rt * 16 + fr, b = (rt * 16) >> 13;
    const int kr0 = 8 * (fr >> 2) + (fr & 3);
    bf16x8 Qf[4];
    { const bf16* qp = (const bf16*)(ws + WS_QC) + (size_t)row * 512 + h * 128 + fq * 8;
#pragma unroll
      for (int ks = 0; ks < 4; ++ks) Qf[ks] = ldg8(qp + ks * 32); }
    const bf16* Kc = (const bf16*)(ws + WS_KMEM) + (size_t)((b * 4 + h) * 256) * 128;
    const bf16* Vc = (const bf16*)(ws + WS_VMEM_T) + (size_t)((b * 4 + h) * 128) * 256;
    f32x4 sc[16]; float mx = -1e30f;
#pragma unroll
    for (int kt = 0; kt < 16; ++kt) {
        const int u = kt >> 1, t = kt & 1;
        const bf16* kp = Kc + (size_t)(32 * u + kr0 + 4 * t) * 128 + fq * 8;
        f32x4 z = {0.f, 0.f, 0.f, 0.f};
#pragma unroll
        for (int ks = 0; ks < 4; ++ks) z = MFMA16(ldg8(kp + ks * 32), Qf[ks], z);
        z *= LOG2E; sc[kt] = z;
        mx = fmaxf(mx, fmaxf(fmaxf(z[0], z[1]), fmaxf(z[2], z[3])));
    }
    mx = fmaxf(mx, __shfl_xor(mx, 16)); mx = fmaxf(mx, __shfl_xor(mx, 32));
    float ls = 0.f;
#pragma unroll
    for (int kt = 0; kt < 16; ++kt)
#pragma unroll
        for (int rr = 0; rr < 4; ++rr) { const float p = ex2(sc[kt][rr] - mx); sc[kt][rr] = p; ls += p; }
    ls += __shfl_xor(ls, 16); ls += __shfl_xor(ls, 32);
    const float inv = 1.f / ls;
    f32x4 O[8];
#pragma unroll
    for (int mt = 0; mt < 8; ++mt) O[mt] = (f32x4){0.f, 0.f, 0.f, 0.f};
#pragma unroll
    for (int u = 0; u < 8; ++u) {
        const bf16x8 Pf = pack8(sc[2 * u][0], sc[2 * u][1], sc[2 * u][2], sc[2 * u][3], sc[2 * u + 1][0], sc[2 * u + 1][1], sc[2 * u + 1][2], sc[2 * u + 1][3]);
#pragma unroll
        for (int mt = 0; mt < 8; ++mt) O[mt] = MFMA16(ldg8(Vc + (size_t)(mt * 16 + fr) * 256 + 32 * u + fq * 8), Pf, O[mt]);
    }
    bf16* op = (bf16*)(ws + WS_OC) + (size_t)row * 512 + h * 128 + fq * 4;
#pragma unroll
    for (int mt = 0; mt < 8; ++mt) { v2u w; w.x = pk2(O[mt][0] * inv, O[mt][1] * inv); w.y = pk2(O[mt][2] * inv, O[mt][3] * inv); *(v2u*)(op + mt * 16) = w; }
}

__device__ __forceinline__ void peer_token(unsigned char* ws, const float* gfin, float* outp, int tok, int lane) {
    const bf16* scp = (const bf16*)(ws + WS_SCORES) + (size_t)tok * 2048;
    const int l16 = lane & 15, grp = lane >> 4;
    float tsv[4]; int tsi[4];
#pragma unroll
    for (int gi = 0; gi < 4; ++gi) {
        const int hc = gi * 4 + grp;
        const v4u raw = *(const v4u*)(scp + hc * 128 + l16 * 8);
        float cv[8] = {bflo(raw.x), bfhi(raw.x), bflo(raw.y), bfhi(raw.y), bflo(raw.z), bfhi(raw.z), bflo(raw.w), bfhi(raw.w)};
        float myv = 0.f; int myi = 0;
        for (int round = 0; round < 16; ++round) {
            float best = cv[0]; int be = 0;
#pragma unroll
            for (int e = 1; e < 8; ++e) if (cv[e] > best) { best = cv[e]; be = e; }
            int bk = l16 * 8 + be;
#pragma unroll
            for (int off = 1; off < 16; off <<= 1) { const float ov = __shfl_xor(best, off); const int ok = __shfl_xor(bk, off);
                const bool take = (ov > best) || (ov == best && ok < bk); best = take ? ov : best; bk = take ? ok : bk; }
            if (l16 == round) { myv = best; myi = bk; }
#pragma unroll
            for (int e = 0; e < 8; ++e) if (bk == l16 * 8 + e) cv[e] = -3e38f;
        }
        tsv[gi] = myv; tsi[gi] = myi;
    }
    float gsel[4]; int esel[4];
    const int half = lane >> 5, L = lane & 31, hb = half * 32, a = L & 15, bb = (L >> 4) * 8;
#pragma unroll
    for (int gi = 0; gi < 4; ++gi) {
        const float s0a = __shfl(tsv[gi], hb + a);
        float cand[8];
#pragma unroll
        for (int e = 0; e < 8; ++e) cand[e] = s0a + __shfl(tsv[gi], hb + 16 + bb + e);
        float selv = 0.f; int self_ = 0;
        for (int round = 0; round < 16; ++round) {
            float best = cand[0]; int be = 0;
#pragma unroll
            for (int e = 1; e < 8; ++e) if (cand[e] > best) { best = cand[e]; be = e; }
            int bfi = a * 16 + bb + be;
#pragma unroll
            for (int off = 1; off < 32; off <<= 1) { const float ov = __shfl_xor(best, off); const int oi = __shfl_xor(bfi, off);
                const bool take = (ov > best) || (ov == best && oi < bfi); best = take ? ov : best; bfi = take ? oi : bfi; }
            if (L == round) { selv = best; self_ = bfi; }
#pragma unroll
            for (int e = 0; e < 8; ++e) if (bfi == a * 16 + bb + e) cand[e] = -3e38f;
        }
        const int i0 = __shfl(tsi[gi], hb + (self_ >> 4)), i1 = __shfl(tsi[gi], hb + 16 + (self_ & 15));
        const float mxv = __shfl(selv, hb);
        float ev = (L < 16) ? __expf(selv - mxv) : 0.f;
        float sm = ev;
#pragma unroll
        for (int off = 1; off < 16; off <<= 1) sm += __shfl_xor(sm, off);
        gsel[gi] = (L < 16) ? ev / sm : 0.f; esel[gi] = i0 * 128 + i1;
    }
    float xf[16];
    { const bf16* up = (const bf16*)(ws + WS_U) + (size_t)tok * 1024 + lane * 8; const v4u a0 = *(const v4u*)up, a1 = *(const v4u*)(up + 512);
      xf[0] = bflo(a0.x); xf[1] = bfhi(a0.x); xf[2] = bflo(a0.y); xf[3] = bfhi(a0.y); xf[4] = bflo(a0.z); xf[5] = bfhi(a0.z); xf[6] = bflo(a0.w); xf[7] = bfhi(a0.w);
      xf[8] = bflo(a1.x); xf[9] = bfhi(a1.x); xf[10] = bflo(a1.y); xf[11] = bfhi(a1.y); xf[12] = bflo(a1.z); xf[13] = bfhi(a1.z); xf[14] = bflo(a1.w); xf[15] = bfhi(a1.w); }
    float oacc[16];
#pragma unroll
    for (int e = 0; e < 16; ++e) oacc[e] = 0.f;
    const bf16* PU = (const bf16*)(ws + WS_PU); const bf16* PV = (const bf16*)(ws + WS_PV);
#pragma unroll
    for (int gi = 0; gi < 4; ++gi) {
        for (int hk = 0; hk < 4; ++hk) {
            const int lbase = (hk >> 1) * 32 + (hk & 1) * 8;
            v4u ua[8], ub[8]; int eid[8]; float gt[8];
#pragma unroll
            for (int kk = 0; kk < 8; ++kk) {
                eid[kk] = __builtin_amdgcn_readfirstlane(__shfl(esel[gi], lbase + kk));
                gt[kk] = __builtin_bit_cast(float, __builtin_amdgcn_readfirstlane(__builtin_bit_cast(int, __shfl(gsel[gi], lbase + kk))));
                const bf16* up = PU + (size_t)eid[kk] * 1024 + lane * 8; ua[kk] = *(const v4u*)up; ub[kk] = *(const v4u*)(up + 512);
            }
            float wgt[8];
#pragma unroll
            for (int kk = 0; kk < 8; ++kk) {
                float d = xf[0] * bflo(ua[kk].x) + xf[1] * bfhi(ua[kk].x) + xf[2] * bflo(ua[kk].y) + xf[3] * bfhi(ua[kk].y)
                        + xf[4] * bflo(ua[kk].z) + xf[5] * bfhi(ua[kk].z) + xf[6] * bflo(ua[kk].w) + xf[7] * bfhi(ua[kk].w)
                        + xf[8] * bflo(ub[kk].x) + xf[9] * bfhi(ub[kk].x) + xf[10] * bflo(ub[kk].y) + xf[11] * bfhi(ub[kk].y)
                        + xf[12] * bflo(ub[kk].z) + xf[13] * bfhi(ub[kk].z) + xf[14] * bflo(ub[kk].w) + xf[15] * bfhi(ub[kk].w);
                d = wave_sum(d);
                wgt[kk] = gt[kk] * gelu_erf(d);
            }
#pragma unroll
            for (int kk = 0; kk < 8; ++kk) { const bf16* vp = PV + (size_t)eid[kk] * 1024 + lane * 8; ua[kk] = *(const v4u*)vp; ub[kk] = *(const v4u*)(vp + 512); }
#pragma unroll
            for (int kk = 0; kk < 8; ++kk) { const float w_ = wgt[kk];
                oacc[0] += w_ * bflo(ua[kk].x); oacc[1] += w_ * bfhi(ua[kk].x); oacc[2] += w_ * bflo(ua[kk].y); oacc[3] += w_ * bfhi(ua[kk].y);
                oacc[4] += w_ * bflo(ua[kk].z); oacc[5] += w_ * bfhi(ua[kk].z); oacc[6] += w_ * bflo(ua[kk].w); oacc[7] += w_ * bfhi(ua[kk].w);
                oacc[8] += w_ * bflo(ub[kk].x); oacc[9] += w_ * bfhi(ub[kk].x); oacc[10] += w_ * bflo(ub[kk].y); oacc[11] += w_ * bfhi(ub[kk].y);
                oacc[12] += w_ * bflo(ub[kk].z); oacc[13] += w_ * bfhi(ub[kk].z); oacc[14] += w_ * bflo(ub[kk].w); oacc[15] += w_ * bfhi(ub[kk].w); }
        }
    }
    const float* hp = (const float*)(ws + WS_H) + (size_t)tok * 1024 + lane * 8;
    const f32x4 h0 = *(const f32x4*)hp, h1 = *(const f32x4*)(hp + 4), h2 = *(const f32x4*)(hp + 512), h3 = *(const f32x4*)(hp + 516);
    float y[16] = {h0.x + oacc[0], h0.y + oacc[1], h0.z + oacc[2], h0.w + oacc[3], h1.x + oacc[4], h1.y + oacc[5], h1.z + oacc[6], h1.w + oacc[7],
                   h2.x + oacc[8], h2.y + oacc[9], h2.z + oacc[10], h2.w + oacc[11], h3.x + oacc[12], h3.y + oacc[13], h3.z + oacc[14], h3.w + oacc[15]};
    float ss = 0.f;
#pragma unroll
    for (int e = 0; e < 16; ++e) ss += y[e] * y[e];
    const float rstd = rsqrtf(wave_sum(ss) * (1.f / D) + 1e-6f);
    const float* gp = gfin + lane * 8; float* op = outp + (size_t)tok * 1024 + lane * 8;
    const f32x4 ga = *(const f32x4*)gp, gb = *(const f32x4*)(gp + 4), gc = *(const f32x4*)(gp + 512), gd = *(const f32x4*)(gp + 516);
    *(f32x4*)op = (f32x4){y[0] * rstd * ga.x, y[1] * rstd * ga.y, y[2] * rstd * ga.z, y[3] * rstd * ga.w};
    *(f32x4*)(op + 4) = (f32x4){y[4] * rstd * gb.x, y[5] * rstd * gb.y, y[6] * rstd * gb.z, y[7] * rstd * gb.w};
    *(f32x4*)(op + 512) = (f32x4){y[8] * rstd * gc.x, y[9] * rstd * gc.y, y[10] * rstd * gc.z, y[11] * rstd * gc.w};
    *(f32x4*)(op + 516) = (f32x4){y[12] * rstd * gd.x, y[13] * rstd * gd.y, y[14] * rstd * gd.z, y[15] * rstd * gd.w};
}

typedef unsigned gu32_unused;
#define XB_TMO      128
#define XB_XCNT(j)  (256  + 64 * (j))
#define XB_XSUB(j)  (1280 + 64 * (j))
#define XB_XGEN(j)  (2304 + 64 * (j))
#define XB_TOP      3328
#define XB_TOPGEN   3392
#define XCD_BAR_WORDS 3456
#define XB_SPIN_CAP (1u << 18)

__device__ __forceinline__ unsigned xb_ld(unsigned* p)              { return __hip_atomic_load(p, __ATOMIC_RELAXED, __HIP_MEMORY_SCOPE_AGENT); }
__device__ __forceinline__ unsigned xb_add(unsigned* p, unsigned v) { return __hip_atomic_fetch_add(p, v, __ATOMIC_RELAXED, __HIP_MEMORY_SCOPE_AGENT); }
__device__ __forceinline__ unsigned xb_xcc_id() { return (unsigned)__builtin_amdgcn_s_getreg((3 << 11) | 20) & 0xFu; }
#define XB_SPIN(cond, bar) do { unsigned _sp = 0; while (cond) { __builtin_amdgcn_s_sleep(1); \
    if ((++_sp & 255u) == 0u) { if (xb_ld(&(bar)[XB_TMO])) break; if (_sp > XB_SPIN_CAP) { atomicAdd(&(bar)[XB_TMO], 1u); break; } } } } while (0)

struct XcdBarrier {
    unsigned* bar; unsigned x;
    volatile LAS unsigned* st;
};

__device__ __forceinline__ XcdBarrier xcd_barrier_post(unsigned* bar, volatile LAS unsigned* st) {
    XcdBarrier b; b.bar = bar; b.x = xb_xcc_id(); b.st = st;
    if (threadIdx.x == 0) (void)xb_add(&bar[XB_XCNT(b.x)], 1u);
    return b;
}
__device__ __forceinline__ void xcd_barrier_complete(unsigned* bar, unsigned x, unsigned& nloc, unsigned& nx) {
    const unsigned G = gridDim.x * gridDim.y * gridDim.z;
    unsigned sum, cnt, mine, sp = 0u;
    for (;;) {
        sum = 0u; cnt = 0u; mine = 0u;
#pragma unroll
        for (unsigned j = 0; j < 16; ++j) { const unsigned c = xb_ld(&bar[XB_XCNT(j)]); sum += c; cnt += (c > 0u) ? 1u : 0u; mine = (j == x) ? c : mine; }
        if (sum == G) break;
        __builtin_amdgcn_s_sleep(1);
        if ((++sp & 255u) == 0u) { if (xb_ld(&bar[XB_TMO])) break; if (sp > XB_SPIN_CAP) { atomicAdd(&bar[XB_TMO], 1u); break; } }
    }
    nloc = mine > 0u ? mine : 1u; nx = cnt > 0u ? cnt : 1u;
}

__device__ __forceinline__ void xcd_barrier(const XcdBarrier& b) {
    asm volatile("s_waitcnt vmcnt(0)" ::: "memory");
    __syncthreads();
    if (threadIdx.x == 0) {
        unsigned* bar = b.bar;
        __builtin_amdgcn_s_waitcnt(0);
        unsigned nloc = b.st[0], nx = b.st[1];
        if (nloc == 0u) { xcd_barrier_complete(bar, b.x, nloc, nx); b.st[0] = nloc; b.st[1] = nx; }
        const unsigned old = xb_add(&bar[XB_XSUB(b.x)], 1u);
        const unsigned gen = old / nloc;
        if (old + 1u == (gen + 1u) * nloc) {
            __builtin_amdgcn_fence(__ATOMIC_RELEASE, "agent");
            asm volatile("s_waitcnt vmcnt(0)" ::: "memory");
            const unsigned og = xb_add(&bar[XB_TOP], 1u);
            const unsigned tg = og / nx;
            if (og + 1u == (tg + 1u) * nx) xb_add(&bar[XB_TOPGEN], 1u);
            else XB_SPIN(xb_ld(&bar[XB_TOPGEN]) == tg, bar);
            __builtin_amdgcn_fence(__ATOMIC_ACQUIRE, "agent");
            xb_add(&bar[XB_XGEN(b.x)], 1u);
            asm volatile("s_waitcnt vmcnt(0)" ::: "memory");
        } else {
            XB_SPIN(xb_ld(&bar[XB_XGEN(b.x)]) == gen, bar);
            __builtin_amdgcn_fence(__ATOMIC_ACQUIRE, "agent");
            asm volatile("s_waitcnt vmcnt(0)" ::: "memory");
        }
    }
    __syncthreads();
}

constexpr int NPHASE = 14;
__global__ void __launch_bounds__(NTHR, 2) hybrid_fwd(Args args) {
    extern __shared__ __attribute__((aligned(16))) unsigned char lds_raw[];
    LAS unsigned char* lds = (LAS unsigned char*)lds_raw;
    unsigned char* ws = args.ws;
    const int tid = threadIdx.x, lane = tid & 63, wave = __builtin_amdgcn_readfirstlane(tid >> 6);
    const int G = gridDim.x, bx = blockIdx.x;
    const int gw = bx * NWAVES + wave, NGW = G * NWAVES;
    const int lo = args.ph_lo, hi = args.ph_hi;
    const bool coop = (hi - lo) > 1;
    volatile LAS unsigned* MISC = (volatile LAS unsigned*)(lds + 131072 + 320);
    for (int u = tid; u < (LDS_BYTES - 131072) / 4; u += NTHR) ((LAS unsigned*)(lds + 131072))[u] = 0u;
    __syncthreads();
    XcdBarrier xbar; xbar.bar = (unsigned*)(ws + WS_CTL) + 4096; xbar.x = 0; xbar.st = nullptr;
    if (coop) xbar = xcd_barrier_post((unsigned*)(ws + WS_CTL) + 4096, MISC + 8);
#ifndef PH_MASK
#define PH_MASK 0x3fff
#endif
#define IN(k) (((PH_MASK >> (k)) & 1) && lo <= (k) && (k) < hi)
#ifndef REP_MASK
#define REP_MASK 0
#endif
#ifndef REP_WHICH
#define REP_WHICH 0
#endif
#define NREP(k) (1 + ((REP_MASK >> (k)) & 1))
#define SEAM(k) do { if (coop && IN(k) && IN((k) + 1)) { if ((k) == 0) cg::this_grid().sync(); else xcd_barrier(xbar); } } while (0)
    const float* x = args.in[0];
    EpiAll ea; ea.mode = 0; ea.ws = ws; ea.x = x; ea.cmp_pos = args.in[6]; ea.part = nullptr;

    if (IN(0)) for (int rep = 0; rep < NREP(0); ++rep) {
        LAS float* scr = (LAS float*)(lds + wave * 16384);
        constexpr int I_WIN = 16 * 160, I_C1 = 32 * 8, I_AB = 8 * 32, I_OUT = 16 * 32, I_CQ = 16 * 16, I_CKV = 16 * 32, I_CO = 8 * 32;
        constexpr int NIT = I_WIN + 2 * I_C1 + 2 * I_AB + I_OUT + I_CQ + I_CKV + I_CO;
        for (int it = gw; it < NIT; it += NGW) {
            int r = it;
            if (r < I_WIN) { transpose_item(args.in[3], 1024, NIN, 160, (bf16*)(ws + WS_WIN_T), scr, r, lane); continue; } r -= I_WIN;
            if (r < I_C1) { transpose_item(args.in[7], 2048, 256, 8, (bf16*)(ws + WS_CKW1_T), scr, r, lane); continue; } r -= I_C1;
            if (r < I_C1) { transpose_item(args.in[9], 2048, 256, 8, (bf16*)(ws + WS_CVW1_T), scr, r, lane); continue; } r -= I_C1;
            if (r < I_AB) { transpose_item(args.in[11], 512, 1024, 32, (bf16*)(ws + WS_WA_T), scr, r, lane); continue; } r -= I_AB;
            if (r < I_AB) { transpose_item(args.in[12], 512, 1024, 32, (bf16*)(ws + WS_WB_T), scr, r, lane); continue; } r -= I_AB;
            if (r < I_OUT) { transpose_item(args.in[13], 1024, 1024, 32, (bf16*)(ws + WS_WOUT_T), scr, r, lane); continue; } r -= I_OUT;
            if (r < I_CQ) { transpose_item(args.in[16], 1024, 512, 16, (bf16*)(ws + WS_WCQ_T), scr, r, lane); continue; } r -= I_CQ;
            if (r < I_CKV) { transpose_item(args.in[17], 1024, 1024, 32, (bf16*)(ws + WS_WCKV_T), scr, r, lane); continue; } r -= I_CKV;
            transpose_item(args.in[18], 512, 1024, 32, (bf16*)(ws + WS_WCO_T), scr, r, lane);
        }
        for (int m = gw; m < T; m += NGW) rms_row_to_bf16(x + (size_t)m * D, args.in[2], (bf16*)(ws + WS_U) + (size_t)m * D, lane);
        for (int m = gw; m < 512; m += NGW) rms_row_to_bf16(args.in[1] + (size_t)m * D, args.in[15], (bf16*)(ws + WS_MEMN) + (size_t)m * D, lane);
        __syncthreads();
        {
            LAS float* skl = (LAS float*)lds;
            LAS float* wql = (LAS float*)(lds + 128 * 132 * 4);
            const float* SK = args.in[21]; const float* WQ = args.in[20];
            for (int item = bx; item < 256; item += G) {
                const int hc = item >> 4, k0 = (item & 15) * 64;
                for (int e = tid; e < 128 * 128; e += NTHR) { const int key = e >> 7, d = e & 127; skl[d * 132 + key] = SK[(size_t)(hc * 128 + key) * 128 + d]; }
                for (int e = tid; e < 64 * 128; e += NTHR) { const int k = e >> 7, d = e & 127; wql[d * 68 + k] = WQ[(size_t)(k0 + k) * 2048 + hc * 128 + d]; }
                __syncthreads();
                const int key4 = (tid & 31) * 4, kk4 = (tid >> 5) * 4;
                float acc[4][4];
#pragma unroll
                for (int i = 0; i < 4; ++i)
#pragma unroll
                    for (int j = 0; j < 4; ++j) acc[i][j] = 0.f;
                for (int d = 0; d < 128; ++d) {
                    const f32x4 av = *(const LAS f32x4*)(skl + d * 132 + key4), bv = *(const LAS f32x4*)(wql + d * 68 + kk4);
#pragma unroll
                    for (int i = 0; i < 4; ++i)
#pragma unroll
                        for (int j = 0; j < 4; ++j) acc[i][j] += av[i] * bv[j];
                }
#pragma unroll
                for (int i = 0; i < 4; ++i) { v2u w; w.x = pk2(acc[i][0], acc[i][1]); w.y = pk2(acc[i][2], acc[i][3]);
                    *(v2u*)((bf16*)(ws + WS_WPS_T) + (size_t)(hc * 128 + key4 + i) * 1024 + k0 + kk4) = w; }
                __syncthreads();
            }
        }
    }
    SEAM(0);
    if (IN(1)) for (int rep = 0; rep < NREP(1); ++rep) { ea.mode = EM_G1; run_gemm(lds, (const bf16*)(ws + WS_U), (const bf16*)(ws + WS_WIN_T), T, NIN_PAD, 1024, 1024, G, bx, ea); }
    SEAM(1);
    if (IN(2)) {
        if (bx < 64) {
            const int ci = bx >> 2, kv = ci >> 3, sp = ci & 7;
            ea.mode = EM_PART; ea.part = (float*)(ws + WS_HIDP) + (size_t)ci * 1024 * 256;
            run_gemm(lds, (const bf16*)(ws + (kv ? WS_VCI : WS_KCI)) + sp * 256, (const bf16*)(ws + (kv ? WS_CVW1_T : WS_CKW1_T)) + sp * 256, 1024, 256, 256, 2048, G, bx & 3, ea);
        } else {
            ea.mode = EM_KVMEM;
            run_gemm(lds, (const bf16*)(ws + WS_MEMN), (const bf16*)(ws + WS_WCKV_T), 512, 1024, 1024, 1024, G, (bx >= 128 && bx < 136) ? bx - 128 : 1 << 20, ea);
        }
    }
    SEAM(2);
    if (IN(3)) {
        LAS float* hl = (LAS float*)lds;
        const float* HP = (const float*)(ws + WS_HIDP);
        for (int it = bx; it < 256; it += G) {
            for (int e = tid; e < 2048; e += NTHR) { const int kv = e >> 10, rr = (e >> 8) & 3, c = e & 255, row = it * 4 + rr; float s_ = 0.f;
#pragma unroll
                for (int sp = 0; sp < 8; ++sp) s_ += HP[((size_t)((kv * 8 + sp) * 1024 + row)) * 256 + c];
                hl[e] = gelu_erf(s_); }
            __syncthreads();
            { const int kv = tid >> 8, rr = (tid >> 6) & 3, d = tid & 63, row = it * 4 + rr; const float* w2 = kv ? args.in[10] : args.in[8]; float a_ = 0.f;
              for (int j = 0; j < 256; ++j) a_ += hl[(kv * 4 + rr) * 256 + j] * w2[j * 64 + d];
              if (kv == 0) ((bf16*)(ws + WS_KCMP))[(size_t)row * 64 + d] = f2bf1(a_);
              else ((bf16*)(ws + WS_VCMP_T))[((size_t)((row >> 8) * 64 + d)) * 256 + (row & 255)] = f2bf1(a_); }
            __syncthreads();
        }
    }
    SEAM(3);
    if (IN(4)) for (int rep = 0; rep < NREP(4); ++rep) {
        const int xq = bx & 7;
        unsigned* qctrD = (unsigned*)(ws + WS_CTL) + 1024 + 64 * xq + 512 * rep;
        unsigned* qctrN = (unsigned*)(ws + WS_CTL) + 2048 + 64 * xq + 512 * rep;
        volatile LAS int* qslot = (volatile LAS int*)(lds + 131072 + 64);
        if (rep == 0 || REP_WHICH == 0) {
            for (;;) {
                if (tid == 0) *qslot = (int)atomicAdd(qctrD, 1u);
                __syncthreads();
                const int n = __builtin_amdgcn_readfirstlane(*qslot);
                __syncthreads();
                if (n >= 64) break;
                diff_wg_item(ws, args.in[4], args.in[5], xq, 63 - n, lds, tid, wave, lane);
            }
        }
        if (rep == 0 || REP_WHICH == 1) {
            LAS float* wl = (LAS float*)(lds + wave * 16384);
            for (;;) {
                int n = 0;
                if (lane == 0) n = (int)atomicAdd(qctrN, 1u);
                n = __builtin_amdgcn_readfirstlane(n);
                if (n >= 1024) break;
                nsa_item(ws, xq >> 1, 2047 - (2 * n + (xq & 1)), wl, lane);
            }
        }
    }
    SEAM(4);
    if (IN(5)) {
        ea.mode = EM_MA; run_gemm(lds, (const bf16*)(ws + WS_OA), (const bf16*)(ws + WS_WA_T), T, 1024, 512, 512, G, bx, ea);
        ea.mode = EM_MB; run_gemm(lds, (const bf16*)(ws + WS_OB), (const bf16*)(ws + WS_WB_T), T, 1024, 512, 512, G, bx, ea);
    }
    SEAM(5);
    if (IN(6)) { ea.mode = EM_H1; run_gemm(lds, (const bf16*)(ws + WS_U), (const bf16*)(ws + WS_WOUT_T), T, 1024, 1024, 1024, G, bx, ea); }
    SEAM(6);
    if (IN(7)) for (int rep = 0; rep < NREP(7); ++rep) {
        for (int m = gw; m < T; m += NGW) rms_row_to_bf16((const float*)(ws + WS_H) + (size_t)m * D, args.in[14], (bf16*)(ws + WS_U) + (size_t)m * D, lane);
        const size_t NV = (size_t)16384 * 1024 / 8;
        for (size_t e = (size_t)gw * 64 + lane; e < 2 * NV; e += (size_t)NGW * 64) {
            const bool second = e >= NV; const size_t ee = second ? e - NV : e;
            const float* src = (second ? args.in[23] : args.in[22]) + ee * 8; bf16* dst = (bf16*)(ws + (second ? WS_PV : WS_PU)) + ee * 8;
            const f32x4 a0 = *(const f32x4*)src, a1 = *(const f32x4*)(src + 4);
            v4u w; w.x = pk2(a0.x, a0.y); w.y = pk2(a0.z, a0.w); w.z = pk2(a1.x, a1.y); w.w = pk2(a1.z, a1.w); *(v4u*)dst = w;
        }
    }
    SEAM(7);
    if (IN(8)) { ea.mode = EM_QC; run_gemm(lds, (const bf16*)(ws + WS_U), (const bf16*)(ws + WS_WCQ_T), T, 512, 1024, 1024, G, bx, ea); }
    SEAM(8);
    if (IN(9)) for (int rep = 0; rep < NREP(9); ++rep) { for (int it = gw; it < 4096; it += NGW) cross_item(ws, it >> 2, it & 3, lane); }
    SEAM(9);
    if (IN(10)) { ea.mode = EM_H2; run_gemm(lds, (const bf16*)(ws + WS_OC), (const bf16*)(ws + WS_WCO_T), T, 1024, 512, 512, G, bx, ea); }
    SEAM(10);
    if (IN(11)) { for (int m = gw; m < T; m += NGW) rms_row_to_bf16((const float*)(ws + WS_H) + (size_t)m * D, args.in[19], (bf16*)(ws + WS_U) + (size_t)m * D, lane); }
    SEAM(11);
    if (IN(12)) for (int rep = 0; rep < NREP(12); ++rep) { ea.mode = EM_SC; run_gemm(lds, (const bf16*)(ws + WS_U), (const bf16*)(ws + WS_WPS_T), T, 2048, 1024, 1024, G, bx, ea); }
    SEAM(12);
    if (IN(13)) for (int rep = 0; rep < NREP(13); ++rep) { for (int tok = gw; tok < T; tok += NGW) peer_token(ws, args.in[24], args.out, tok, lane); }
#undef IN
#undef SEAM
}

#ifndef N_LAUNCH_MODE
#define N_LAUNCH_MODE 1
#endif
extern "C" void kernel_launch(void* const* d_in, const int* in_sizes, int n_in, void* d_out, int out_size, void* d_ws, size_t ws_size, hipStream_t stream) {
    static int grid = 0;
    if (grid == 0) {
        if (n_in != 25 || out_size != T * D || ws_size < WS_END) { fprintf(stderr, "kernel_launch: unexpected shapes (n_in %d out %d ws %zu)\n", n_in, out_size, ws_size); grid = -1; return; }
        int dev = 0, cus = 0, per_cu = 0;
        hipGetDevice(&dev); hipDeviceGetAttribute(&cus, hipDeviceAttributeMultiprocessorCount, dev);
        if (hipFuncSetAttribute((const void*)hybrid_fwd, hipFuncAttributeMaxDynamicSharedMemorySize, LDS_BYTES) != hipSuccess) { fprintf(stderr, "kernel_launch: hipFuncSetAttribute failed\n"); grid = -1; return; }
        if (hipOccupancyMaxActiveBlocksPerMultiprocessor(&per_cu, (const void*)hybrid_fwd, NTHR, LDS_BYTES) != hipSuccess || per_cu < 1) { fprintf(stderr, "kernel_launch: occupancy query says %d\n", per_cu); per_cu = 1; }
        (void)hipGetLastError();
        grid = cus * 1;
        if (grid > 256) grid = 256;
    }
    if (grid < 0) return;
    hipMemsetAsync((char*)d_ws + WS_CTL, 0, CTL_BYTES, stream);
    Args a{};
    for (int i = 0; i < 25; ++i) a.in[i] = (const float*)d_in[i];
    a.out = (float*)d_out; a.ws = (unsigned char*)d_ws;
#if N_LAUNCH_MODE == 1
    a.ph_lo = 0; a.ph_hi = NPHASE;
    void* kargs[] = {&a};
    hipError_t e = hipLaunchCooperativeKernel((const void*)hybrid_fwd, dim3(grid), dim3(NTHR), kargs, LDS_BYTES, stream);
    if (e != hipSuccess) fprintf(stderr, "cooperative launch failed: %s (grid %d)\n", hipGetErrorString(e), grid);
#else
    for (int p = 0; p < NPHASE; ++p) { a.ph_lo = p; a.ph_hi = p + 1; hipLaunchKernelGGL(hybrid_fwd, dim3(grid), dim3(NTHR), LDS_BYTES, stream, a); }
#endif
}
```

```cpp
#include <hip/hip_runtime.h>
#include <hip/hip_cooperative_groups.h>
#include <cstdio>
#include <cstdint>
namespace cg = cooperative_groups;
namespace pg8 {
#define PG8_LAS __attribute__((address_space(3)))
typedef unsigned short bf16_t;
typedef short bf16x8 __attribute__((ext_vector_type(8)));
typedef float f32x4 __attribute__((ext_vector_type(4)));
typedef unsigned u32x4 __attribute__((ext_vector_type(4)));
constexpr int BM = 256, BK = 64, HALF = 128, HTB = HALF * BK * 2  , STAGE_BYTES = 8 * HTB, NXCD = 8, WGM = 8;

__host__ __device__ __forceinline__ int lds_byte(int r, int c) { const int st = (r >> 4) * 2 + (c >> 5), rr = r & 15, cc = c & 31, ob = rr * 64 + cc * 2; return st * 1024 + (ob ^ (((ob >> 9) & 1) << 5)); }
__host__ __device__ __forceinline__ void stage_rc(int b, int& R, int& C) { const int st = b / 1024, sb = b % 1024, swz = sb ^ (((sb >> 9) & 1) << 5); R = (st >> 1) * 16 + swz / 64; C = (st & 1) * 32 + (swz % 64) / 2; }
__host__ __device__ __forceinline__ int perm32(int rho) { const int n = rho >> 4, i = rho & 15; return 8 * (i >> 2) + 4 * n + (i & 3); }

struct Unit { int pm, pn; };
struct Gemm { const bf16_t* A; const bf16_t* Bt; int M, N, K, ld; };

struct StaticOrder {
    int nM, nN, nwg, G, c;
    __host__ __device__ void init(int M, int N, int G_, int c_) { nM = M / BM; nN = N / BM; nwg = nM * nN; G = G_; c = c_; }
    __host__ __device__ bool next(int i, Unit& u) const {
        const long L = (long)i * G + c; if (L >= nwg) return false;
        int wgid = (int)L; { const int q = nwg / NXCD, r = nwg % NXCD, xcd = wgid % NXCD, off = wgid / NXCD; wgid = (xcd < r ? xcd * (q + 1) : r * (q + 1) + (xcd - r) * q) + off; }
        const int nig = WGM * nN, gid = wgid / nig, fm = gid * WGM, gsz = (nM - fm) < WGM ? (nM - fm) : WGM;
        u.pm = fm + ((wgid % nig) % gsz); u.pn = (wgid % nig) / gsz; return true;
    }
    __device__ __forceinline__ void a_ready(const Unit&) const {}
    __device__ __forceinline__ void done(const Unit&) const {}
};

__device__ __forceinline__ unsigned cvt_pk_bf16(float lo, float hi) { unsigned r; asm volatile("v_cvt_pk_bf16_f32 %0, %1, %2" : "=v"(r) : "v"(lo), "v"(hi)); return r; }
template <class F> struct EpiF {
    static constexpr bool PERM = true, AFTER_DRAIN = false;
    F f;
    __device__ __forceinline__ void operator()(const f32x4 (&acc)[2][2][4][2], const Unit& u, int wr, int wc, int fr, int fq) const {
        const int row0 = u.pm * BM + wr * 64 + fr, col0 = u.pn * BM + wc * 32 + 8 * fq;
#pragma unroll
        for (int ai = 0; ai < 2; ++ai)
#pragma unroll
            for (int m = 0; m < 4; ++m)
#pragma unroll
                for (int bj = 0; bj < 2; ++bj) f(row0 + ai * HALF + m * 16, col0 + bj * HALF, acc[ai][bj][m][0], acc[ai][bj][m][1]);
    }
};
template <class Epi, class Sched, bool ALIGN_EPI = false, bool SP2 = false>
__device__ __forceinline__ void gemm_phase(PG8_LAS unsigned char* lds, const Gemm g, const Sched& S, const Epi& E) {
    const int tid = threadIdx.x, wid = __builtin_amdgcn_readfirstlane(tid >> 6), lane = tid & 63, wr = wid >> 2, wc = wid & 3, fr = lane & 15, fq = lane >> 4;
    const int K = g.K, nt = K / BK;
    unsigned voffA[2], voffB[2];
#pragma unroll
    for (int i = 0; i < 2; ++i) { int R, C; stage_rc(tid * 16 + i * 8192, R, C); const int Rb = Epi::PERM ? ((R & ~31) + perm32(R & 31)) : R;
        voffA[i] = (unsigned)(R * g.ld + C) * 2u; voffB[i] = (unsigned)(Rb * g.ld + C) * 2u; }
    const size_t kstep = (size_t)(BK * 2);
    const size_t hstep = (size_t)HALF * g.ld * 2;
    const size_t tstep = 2 * hstep;
    const unsigned ldsw = (unsigned)wid * 1024u;
    const int aoff = lds_byte(wr * 64 + fr, fq * 8), boff = lds_byte(wc * 32 + fr, fq * 8);
#define PG8_SA(b, h) (((b) * 2 + (h)) * HTB)
#define PG8_SB(b, h) ((4 + (b) * 2 + (h)) * HTB)
#define PG8_STAGE(bufoff, gbase, voff) do { _Pragma("unroll") for (int _i = 0; _i < 2; ++_i) \
        __builtin_amdgcn_global_load_lds((const unsigned*)((const char*)(gbase) + (voff)[_i]), (PG8_LAS unsigned*)(lds + (bufoff) + ldsw + _i * 8192), 16, 0, 0); } while (0)
#define PG8_LDA(dst, b, h) do { _Pragma("unroll") for (int m = 0; m < 4; ++m) _Pragma("unroll") for (int k = 0; k < 2; ++k) dst[m][k] = *(const PG8_LAS bf16x8*)(lds + PG8_SA(b, h) + aoff + m * 2048 + k * 1024); } while (0)
#define PG8_LDB(dst, b, h) do { _Pragma("unroll") for (int n = 0; n < 2; ++n) _Pragma("unroll") for (int k = 0; k < 2; ++k) dst[n][k] = *(const PG8_LAS bf16x8*)(lds + PG8_SB(b, h) + boff + n * 2048 + k * 1024); } while (0)
#define PG8_MMA(ai, bj, At, Bt) do { __builtin_amdgcn_s_setprio(1); _Pragma("unroll") for (int m = 0; m < 4; ++m) _Pragma("unroll") for (int n = 0; n < 2; ++n) _Pragma("unroll") for (int k = 0; k < 2; ++k) \
        acc[ai][bj][m][n] = __builtin_amdgcn_mfma_f32_16x16x32_bf16(Bt[n][k], At[m][k], acc[ai][bj][m][n], 0, 0, 0); __builtin_amdgcn_s_setprio(0); } while (0)
#define PG8_WAIT_V(n) asm volatile("s_waitcnt vmcnt(" #n ")" ::: "memory")
#define PG8_WAIT_L(n) asm volatile("s_waitcnt lgkmcnt(" #n ")" ::: "memory")
#define PG8_BAR __builtin_amdgcn_s_barrier()
#define PG8_SCHED __builtin_amdgcn_sched_barrier(0)
    Unit cur, nxt; int ui = 0;
    if (!S.next(0, cur)) return;
    f32x4 acc[2][2][4][2];
#pragma unroll
    for (int a = 0; a < 2; ++a)
#pragma unroll
        for (int b = 0; b < 2; ++b)
#pragma unroll
            for (int m = 0; m < 4; ++m)
#pragma unroll
                for (int n = 0; n < 2; ++n) acc[a][b][m][n] = (f32x4){0.f, 0.f, 0.f, 0.f};
    bf16x8 At[4][2], B0[2][2], B1[2][2];
    const char* cA = (const char*)g.A + (size_t)cur.pm * tstep; const char* cB = (const char*)g.Bt + (size_t)cur.pn * tstep;
    S.a_ready(cur);
    if constexpr (SP2) {
        PG8_STAGE(PG8_SB(0, 0), cB, voffB); PG8_STAGE(PG8_SB(0, 1), cB + hstep, voffB); PG8_STAGE(PG8_SA(0, 0), cA, voffA); PG8_STAGE(PG8_SA(0, 1), cA + hstep, voffA);
        if (wr == 1) PG8_BAR;
        PG8_WAIT_V(2); PG8_BAR;
        PG8_STAGE(PG8_SB(1, 0), cB + kstep, voffB); PG8_STAGE(PG8_SA(1, 0), cA + kstep, voffA); PG8_STAGE(PG8_SB(1, 1), cB + hstep + kstep, voffB);
        PG8_WAIT_V(6); PG8_BAR;
    } else {
        PG8_STAGE(PG8_SB(0, 0), cB, voffB); PG8_STAGE(PG8_SA(0, 0), cA, voffA); PG8_STAGE(PG8_SB(0, 1), cB + hstep, voffB); PG8_STAGE(PG8_SA(0, 1), cA + hstep, voffA);
        if (wr == 1) PG8_BAR;
        PG8_WAIT_V(4); PG8_BAR;
        PG8_STAGE(PG8_SB(1, 0), cB + kstep, voffB); PG8_STAGE(PG8_SA(1, 0), cA + kstep, voffA); PG8_STAGE(PG8_SB(1, 1), cB + hstep + kstep, voffB);
        PG8_WAIT_V(6); PG8_BAR;
    }
    for (;;) {
        const bool has_next = S.next(ui + 1, nxt);
        const char* nA = has_next ? (const char*)g.A + (size_t)nxt.pm * tstep : cA; const char* nB = has_next ? (const char*)g.Bt + (size_t)nxt.pn * tstep : cB;
        for (int t = 0; t < nt; t += 2) {
            const bool last = (t == nt - 2);
            const char* a1 = cA + (size_t)(t + 1) * kstep;
            const char* a2 = last ? nA : cA + (size_t)(t + 2) * kstep; const char* b2 = last ? nB : cB + (size_t)(t + 2) * kstep;
            const char* a3 = a2 + kstep; const char* b3 = b2 + kstep;
            if (last && has_next) S.a_ready(nxt);
            if constexpr (SP2) {
            PG8_LDB(B0, 0, 0); PG8_LDB(B1, 0, 1); PG8_SCHED; PG8_LDA(At, 0, 0); PG8_STAGE(PG8_SA(1, 1), a1 + hstep, voffA);
            PG8_WAIT_V(8); PG8_WAIT_L(0); PG8_BAR; PG8_MMA(0, 0, At, B0); PG8_MMA(0, 1, At, B1); PG8_BAR; PG8_SCHED;
            PG8_LDA(At, 0, 1); PG8_STAGE(PG8_SB(0, 0), b2, voffB); PG8_STAGE(PG8_SB(0, 1), b2 + hstep, voffB); PG8_STAGE(PG8_SA(0, 0), a2, voffA);
            PG8_WAIT_V(8); PG8_WAIT_L(0); PG8_BAR; PG8_MMA(1, 0, At, B0); PG8_MMA(1, 1, At, B1); PG8_BAR; PG8_SCHED;
            PG8_LDB(B0, 1, 0); PG8_LDB(B1, 1, 1); PG8_SCHED; PG8_LDA(At, 1, 0); PG8_STAGE(PG8_SA(0, 1), a2 + hstep, voffA);
            PG8_WAIT_V(8); PG8_WAIT_L(0); PG8_BAR; PG8_MMA(0, 0, At, B0); PG8_MMA(0, 1, At, B1); PG8_BAR; PG8_SCHED;
            PG8_LDA(At, 1, 1); PG8_STAGE(PG8_SB(1, 0), b3, voffB); PG8_STAGE(PG8_SB(1, 1), b3 + hstep, voffB); PG8_STAGE(PG8_SA(1, 0), a3, voffA);
            PG8_WAIT_V(8); PG8_WAIT_L(0); PG8_BAR; PG8_MMA(1, 0, At, B0); PG8_MMA(1, 1, At, B1); PG8_BAR; PG8_SCHED;
            } else {
            PG8_LDB(B0, 0, 0); PG8_SCHED; PG8_LDA(At, 0, 0); PG8_STAGE(PG8_SA(1, 1), a1 + hstep, voffA);
            PG8_WAIT_L(8); PG8_BAR; PG8_WAIT_L(0); PG8_MMA(0, 0, At, B0); PG8_BAR; PG8_SCHED;
            PG8_LDB(B1, 0, 1); PG8_STAGE(PG8_SB(0, 0), b2, voffB);
            PG8_BAR; PG8_WAIT_L(0); PG8_MMA(0, 1, At, B1); PG8_BAR;
            PG8_LDA(At, 0, 1); PG8_STAGE(PG8_SA(0, 0), a2, voffA);
            PG8_BAR; PG8_WAIT_L(0); PG8_MMA(1, 0, At, B0); PG8_BAR; PG8_SCHED;
            PG8_STAGE(PG8_SB(0, 1), b2 + hstep, voffB);
            PG8_WAIT_V(6); PG8_BAR; PG8_MMA(1, 1, At, B1); PG8_BAR;
            PG8_LDB(B0, 1, 0); PG8_SCHED; PG8_LDA(At, 1, 0); PG8_STAGE(PG8_SA(0, 1), a2 + hstep, voffA);
            PG8_WAIT_L(8); PG8_BAR; PG8_WAIT_L(0); PG8_MMA(0, 0, At, B0); PG8_BAR; PG8_SCHED;
            PG8_LDB(B1, 1, 1); PG8_STAGE(PG8_SB(1, 0), b3, voffB);
            PG8_BAR; PG8_WAIT_L(0); PG8_MMA(0, 1, At, B1); PG8_BAR;
            PG8_LDA(At, 1, 1); PG8_STAGE(PG8_SA(1, 0), a3, voffA);
            PG8_BAR; PG8_WAIT_L(0); PG8_MMA(1, 0, At, B0); PG8_BAR; PG8_SCHED;
            PG8_STAGE(PG8_SB(1, 1), b3 + hstep, voffB);
            PG8_WAIT_V(6); PG8_BAR; PG8_MMA(1, 1, At, B1); PG8_BAR;
            }
        }
        if constexpr (ALIGN_EPI) { if (wr == 0) PG8_BAR; }
        if constexpr (!Epi::AFTER_DRAIN) { E(acc, cur, wr, wc, fr, fq); S.done(cur); }
        if (!has_next) break;
#pragma unroll
        for (int a = 0; a < 2; ++a)
#pragma unroll
            for (int b = 0; b < 2; ++b)
#pragma unroll
                for (int m = 0; m < 4; ++m)
#pragma unroll
                    for (int n = 0; n < 2; ++n) acc[a][b][m][n] = (f32x4){0.f, 0.f, 0.f, 0.f};
        cur = nxt; cA = nA; cB = nB; ++ui;
        if constexpr (ALIGN_EPI) { if (wr == 1) PG8_BAR; }
    }
    PG8_WAIT_V(0);
    if constexpr (!ALIGN_EPI) { if (wr == 0) PG8_BAR; }
    PG8_BAR;
    if constexpr (Epi::AFTER_DRAIN) { E.fused(acc, cur, wr, wc, fr, fq, lds, wid, lane); S.done(cur); }
#undef PG8_SA
#undef PG8_SB
#undef PG8_STAGE
#undef PG8_LDA
#undef PG8_LDB
#undef PG8_MMA
#undef PG8_WAIT_V
#undef PG8_WAIT_L
#undef PG8_BAR
#undef PG8_SCHED
}
}

#define LAS __attribute__((address_space(3)))
typedef unsigned short bf16;
typedef unsigned v4u __attribute__((ext_vector_type(4)));
typedef unsigned v2u __attribute__((ext_vector_type(2)));
typedef float f32x4 __attribute__((ext_vector_type(4)));
typedef float f32x2 __attribute__((ext_vector_type(2)));
typedef short bf16x8 __attribute__((ext_vector_type(8)));
#define LDS_WAIT() asm volatile("s_waitcnt lgkmcnt(0)" ::: "memory")
#define MFMA16(a, b, c) __builtin_amdgcn_mfma_f32_16x16x32_bf16((a), (b), (c), 0, 0, 0)

constexpr int NWAVES = 8, NTHR = 512;
constexpr int NB = 2, S = 8192, T = NB * S, D = 1024;
constexpr int LDS_BYTES = 147456;
constexpr float LOG2E = 1.4426950408889634f;
constexpr int NIN = 4888, NIN_PAD = 5120;

constexpr size_t MiB = 1u << 20;
constexpr size_t WS_CTL = 0, CTL_BYTES = 1 * MiB;
constexpr size_t WS_MEMN = 1 * MiB, WS_WIN_T = 2 * MiB, WS_CKW1_T = 12 * MiB, WS_CVW1_T = 13 * MiB, WS_WA_T = 14 * MiB, WS_WB_T = 15 * MiB, WS_WOUT_T = 16 * MiB,
                 WS_WCQ_T = 18 * MiB, WS_WCKV_T = 19 * MiB, WS_WCO_T = 21 * MiB, WS_WPS_T = 22 * MiB;
constexpr size_t WS_KCMP = 26 * MiB, WS_VCMP_T = 26 * MiB + 256 * 1024, WS_KMEM = 27 * MiB, WS_VMEM_T = 27 * MiB + 512 * 1024, WS_GB = 28 * MiB;
constexpr size_t WS_U = 32 * MiB;
constexpr size_t WS_QA = 64 * MiB, WS_KA = 80 * MiB, WS_VAT = 96 * MiB, WS_QB = 112 * MiB;
constexpr size_t WS_PU = 64 * MiB, WS_PV = 96 * MiB;
constexpr size_t WS_KCI = 128 * MiB, WS_VCI = 132 * MiB, WS_KS = 136 * MiB, WS_VST = 140 * MiB, WS_KW = 144 * MiB, WS_VWT = 148 * MiB;
constexpr size_t WS_OA = 152 * MiB, WS_OB = 168 * MiB, WS_HIDP = 152 * MiB;
constexpr size_t WS_GA = 184 * MiB, WS_GBT = 216 * MiB;
constexpr size_t WS_H = 192 * MiB;
constexpr size_t WS_QC = 128 * MiB, WS_OC = 144 * MiB, WS_SCORES = 128 * MiB;
constexpr size_t WS_END = 256 * MiB;

__device__ __forceinline__ unsigned pk2(float lo, float hi) { return pg8::cvt_pk_bf16(lo, hi); }
__device__ __forceinline__ unsigned short f2bf1(float f) { return (unsigned short)(pk2(f, 0.f) & 0xffffu); }
__device__ __forceinline__ float bflo(unsigned u) { return __builtin_bit_cast(float, u << 16); }
__device__ __forceinline__ float bfhi(unsigned u) { return __builtin_bit_cast(float, u & 0xffff0000u); }
__device__ __forceinline__ float wave_sum(float v) {
#pragma unroll
    for (int o = 1; o < 64; o <<= 1) v += __shfl_xor(v, o);
    return v;
}
__device__ __forceinline__ float sigm(float x) { return 1.f / (1.f + __expf(-x)); }
__device__ __forceinline__ float gelu_erf(float x) { return 0.5f * x * (1.f + erff(x * 0.70710678118654752f)); }
__device__ __forceinline__ float ex2(float x) { return __builtin_amdgcn_exp2f(x); }
__device__ __forceinline__ void store8bf(bf16* dst, const float* v) { v4u w; w.x = pk2(v[0], v[1]); w.y = pk2(v[2], v[3]); w.z = pk2(v[4], v[5]); w.w = pk2(v[6], v[7]); *(v4u*)dst = w; }
__device__ __forceinline__ bf16x8 ldg8(const bf16* p) { return *(const bf16x8*)p; }
__device__ __forceinline__ bf16x8 pack8(float a0, float a1, float a2, float a3, float a4, float a5, float a6, float a7) {
    v4u w; w.x = pk2(a0, a1); w.y = pk2(a2, a3); w.z = pk2(a4, a5); w.w = pk2(a6, a7); return __builtin_bit_cast(bf16x8, w);
}

struct Args { const float* in[25]; float* out; unsigned char* ws; int ph_lo, ph_hi; };

enum { EM_G1 = 0, EM_PART, EM_KVMEM, EM_MA, EM_MB, EM_H1, EM_QC, EM_H2, EM_SC };
struct EpiAll {
    int mode; unsigned char* ws; const float* x; const float* cmp_pos; float* part;
    __device__ __forceinline__ void operator()(int row, int col, const f32x4& v0, const f32x4& v1) const {
        float v[8] = {v0[0], v0[1], v0[2], v0[3], v1[0], v1[1], v1[2], v1[3]};
        switch (mode) {
        case EM_G1: {
            if (col >= NIN) return;
            const int b = row >> 13, s = row & (S - 1);
            if (col < 1024) {
                const bool isq = col < 512; bf16* dst = (bf16*)(ws + (isq ? WS_QA : WS_KA)) + (size_t)row * 512 + (col & 511);
                const float sc = isq ? 0.125f : 1.f;
#pragma unroll
                for (int i = 0; i < 8; ++i) v[i] *= sc;
                store8bf(dst, v);
            } else if (col < 1536) {
                bf16* dst = (bf16*)(ws + WS_VAT) + (size_t)(b * 512 + (col - 1024)) * S + s;
#pragma unroll
                for (int i = 0; i < 8; ++i) dst[(size_t)i * S] = f2bf1(v[i]);
            } else if (col < 2048) {
#pragma unroll
                for (int i = 0; i < 8; ++i) v[i] *= 0.125f;
                store8bf((bf16*)(ws + WS_QB) + (size_t)row * 512 + (col - 1536), v);
            } else if (col < 2816) {
                const int c2 = col - 2048, j = c2 >> 7, gg = (c2 >> 6) & 1, d = c2 & 63; const size_t bg = (size_t)(b * 2 + gg);
                if (j == 0 || j == 1) {
                    const float* cp = cmp_pos + (s & 31) * 64 + d;
#pragma unroll
                    for (int i = 0; i < 8; ++i) v[i] += cp[i];
                    store8bf((bf16*)(ws + (j == 0 ? WS_KCI : WS_VCI)) + (bg * S + s) * 64 + d, v);
                } else if (j == 2 || j == 4) {
                    store8bf((bf16*)(ws + (j == 2 ? WS_KS : WS_KW)) + (bg * S + s) * 64 + d, v);
                } else {
                    bf16* dst = (bf16*)(ws + (j == 3 ? WS_VST : WS_VWT)) + (bg * 64 + d) * S + s;
#pragma unroll
                    for (int i = 0; i < 8; ++i) dst[(size_t)i * S] = f2bf1(v[i]);
                }
            } else if (col < 2840) {
                float* dst = (float*)(ws + WS_GB) + (size_t)row * 24 + (col - 2816);
                *(f32x4*)dst = (f32x4){sigm(v[0]), sigm(v[1]), sigm(v[2]), sigm(v[3])}; *(f32x4*)(dst + 4) = (f32x4){sigm(v[4]), sigm(v[5]), sigm(v[6]), sigm(v[7])};
            } else {
                const bool ia = col < 3864; bf16* dst = (bf16*)(ws + (ia ? WS_GA : WS_GBT)) + (size_t)row * 1024 + (col - (ia ? 2840 : 3864));
#pragma unroll
                for (int i = 0; i < 8; ++i) v[i] = sigm(v[i]);
                store8bf(dst, v);
            }
        } break;
        case EM_PART: { float* dst = part + (size_t)row * 256 + col; *(f32x4*)dst = v0; *(f32x4*)(dst + 4) = v1; } break;
        case EM_KVMEM: {
            const int b = row >> 8, m = row & 255, c2 = col & 511, h = c2 >> 7, d = c2 & 127;
            if (col < 512) store8bf((bf16*)(ws + WS_KMEM) + ((size_t)((b * 4 + h) * 256 + m)) * 128 + d, v);
            else { bf16* dst = (bf16*)(ws + WS_VMEM_T) + ((size_t)((b * 4 + h) * 128 + d)) * 256 + m;
#pragma unroll
                for (int i = 0; i < 8; ++i) dst[i * 256] = f2bf1(v[i]); }
        } break;
        case EM_MA: {
            const v4u gq = *(const v4u*)((const bf16*)(ws + WS_GA) + (size_t)row * 1024 + col);
            const float g[8] = {bflo(gq.x), bfhi(gq.x), bflo(gq.y), bfhi(gq.y), bflo(gq.z), bfhi(gq.z), bflo(gq.w), bfhi(gq.w)};
#pragma unroll
            for (int i = 0; i < 8; ++i) v[i] *= g[i];
            store8bf((bf16*)(ws + WS_U) + (size_t)row * 1024 + col, v);
        } break;
        case EM_MB: {
            const v4u gq = *(const v4u*)((const bf16*)(ws + WS_GBT) + (size_t)row * 1024 + col);
            bf16* mp = (bf16*)(ws + WS_U) + (size_t)row * 1024 + col; const v4u mq = *(const v4u*)mp;
            const float g[8] = {bflo(gq.x), bfhi(gq.x), bflo(gq.y), bfhi(gq.y), bflo(gq.z), bfhi(gq.z), bflo(gq.w), bfhi(gq.w)};
            const float mm[8] = {bflo(mq.x), bfhi(mq.x), bflo(mq.y), bfhi(mq.y), bflo(mq.z), bfhi(mq.z), bflo(mq.w), bfhi(mq.w)};
#pragma unroll
            for (int i = 0; i < 8; ++i) v[i] = mm[i] + g[i] * v[i];
            store8bf(mp, v);
        } break;
        case EM_H1: {
            const float* xp = x + (size_t)row * 1024 + col; float* hp = (float*)(ws + WS_H) + (size_t)row * 1024 + col;
            const f32x4 x0 = *(const f32x4*)xp, x1 = *(const f32x4*)(xp + 4);
            *(f32x4*)hp = x0 + v0; *(f32x4*)(hp + 4) = x1 + v1;
        } break;
        case EM_QC: {
#pragma unroll
            for (int i = 0; i < 8; ++i) v[i] *= 0.08838834764831845f;
            store8bf((bf16*)(ws + WS_QC) + (size_t)row * 512 + col, v);
        } break;
        case EM_H2: {
            float* hp = (float*)(ws + WS_H) + (size_t)row * 1024 + col;
            const f32x4 x0 = *(const f32x4*)hp, x1 = *(const f32x4*)(hp + 4);
            *(f32x4*)hp = x0 + v0; *(f32x4*)(hp + 4) = x1 + v1;
        } break;
        default: {
            store8bf((bf16*)(ws + WS_SCORES) + (size_t)row * 2048 + col, v);
        } break;
        }
    }
};
typedef pg8::EpiF<EpiAll> EpiT;

__device__ __forceinline__ void run_gemm(LAS unsigned char* lds, const bf16* A, const bf16* Bt, int M, int N, int K, int ld, int G, int c, const EpiAll& ea) {
    pg8::Gemm g{A, Bt, M, N, K, ld}; pg8::StaticOrder So; So.init(M, N, G, c);
    EpiT E{ea};
    pg8::gemm_phase<EpiT, pg8::StaticOrder, true, true>(lds, g, So, E);
}

__device__ __forceinline__ void transpose_item(const float* W, int K, int Nsrc, int nblk, bf16* WT, LAS float* scr, int item, int lane) {
    const int kb = item / nblk, nb = item % nblk, k0 = 64 * kb, n0 = 32 * nb; const int n = n0 + (lane & 31);
#pragma unroll 8
    for (int i = 0; i < 32; ++i) { const int kk = 2 * i + (lane >> 5); scr[kk * 33 + (lane & 31)] = (n < Nsrc) ? W[(size_t)(k0 + kk) * Nsrc + n] : 0.f; }
    LDS_WAIT();
    const int c = lane & 7;
#pragma unroll
    for (int j = 0; j < 4; ++j) { const int nn = (lane >> 3) + 8 * j; const LAS float* s = scr + (8 * c) * 33 + nn;
        v4u o; o.x = pk2(s[0 * 33], s[1 * 33]); o.y = pk2(s[2 * 33], s[3 * 33]); o.z = pk2(s[4 * 33], s[5 * 33]); o.w = pk2(s[6 * 33], s[7 * 33]);
        *(v4u*)(WT + (size_t)(n0 + nn) * K + k0 + 8 * c) = o; }
    LDS_WAIT();
}
__device__ __forceinline__ void rms_row_to_bf16(const float* xrow, const float* g, bf16* orow, int lane) {
    const f32x4* xr = (const f32x4*)xrow + lane; const f32x4* gr = (const f32x4*)g + lane;
    f32x4 v[4]; float s = 0.f;
#pragma unroll
    for (int j = 0; j < 4; ++j) { v[j] = xr[64 * j]; s += (v[j].x * v[j].x + v[j].y * v[j].y) + (v[j].z * v[j].z + v[j].w * v[j].w); }
    const float rstd = rsqrtf(wave_sum(s) * (1.f / D) + 1e-6f);
    v2u* o8 = (v2u*)orow + lane;
#pragma unroll
    for (int j = 0; j < 4; ++j) { const f32x4 gg = gr[64 * j]; v2u w; w.x = pk2(v[j].x * rstd * gg.x, v[j].y * rstd * gg.y); w.y = pk2(v[j].z * rstd * gg.z, v[j].w * rstd * gg.w); o8[64 * j] = w; }
}


__device__ __forceinline__ void diff_item(unsigned char* ws, const float* lamp, const float* subln, int bh, int qt, LAS float* park, int lane) {
    const int b = bh >> 2, h = bh & 3, fr = lane & 15, fq = lane >> 4, q0 = qt * 32;
    float lam;
    { const float a = lamp[lane] * lamp[64 + lane], c = lamp[128 + lane] * lamp[192 + lane]; lam = __expf(wave_sum(a)) - __expf(wave_sum(c)) + 0.2f; }
    const float slope2 = ex2(-2.f * (float)(h + 1)) * LOG2E;
    const bf16* Qb = (const bf16*)(ws + WS_QA) + (size_t)(b * S) * 512 + h * 128;
    const bf16* Kb = (const bf16*)(ws + WS_KA) + (size_t)(b * S) * 512 + h * 128;
    const bf16* Vb = (const bf16*)(ws + WS_VAT) + (size_t)((b * 4 + h) * 128) * S;
    const int kr0 = 8 * (fr >> 2) + (fr & 3);
    const int nsteps = qt + 1;
    for (int c = 0; c < 2; ++c) {
        bf16x8 Qf[2][2];
#pragma unroll
        for (int nt = 0; nt < 2; ++nt)
#pragma unroll
            for (int ks = 0; ks < 2; ++ks) Qf[nt][ks] = ldg8(Qb + (size_t)(q0 + nt * 16 + fr) * 512 + c * 64 + ks * 32 + fq * 8);
        f32x4 O[8][2];
#pragma unroll
        for (int mt = 0; mt < 8; ++mt) { O[mt][0] = (f32x4){0.f, 0.f, 0.f, 0.f}; O[mt][1] = (f32x4){0.f, 0.f, 0.f, 0.f}; }
        float mrun[2] = {-1e30f, -1e30f}, lrun[2] = {0.f, 0.f};
        const bf16* kp = Kb + (size_t)kr0 * 512 + c * 64 + fq * 8;
        bf16x8 Kc[2][2];
#pragma unroll
        for (int t = 0; t < 2; ++t)
#pragma unroll
            for (int ks = 0; ks < 2; ++ks) Kc[t][ks] = ldg8(kp + (size_t)(4 * t) * 512 + ks * 32);
        for (int kb = 0; kb < nsteps; ++kb) {
            bf16x8 Vf[8];
#pragma unroll
            for (int mt = 0; mt < 8; ++mt) Vf[mt] = ldg8(Vb + (size_t)(mt * 16 + fr) * S + kb * 32 + fq * 8);
            const int kbn = (kb + 1 < nsteps) ? kb + 1 : kb;
            bf16x8 Kn[2][2];
#pragma unroll
            for (int t = 0; t < 2; ++t)
#pragma unroll
                for (int ks = 0; ks < 2; ++ks) Kn[t][ks] = ldg8(kp + (size_t)(kbn * 32 + 4 * t) * 512 + ks * 32);
            f32x4 Sx[2][2];
#pragma unroll
            for (int t = 0; t < 2; ++t)
#pragma unroll
                for (int nt = 0; nt < 2; ++nt) { f32x4 z = {0.f, 0.f, 0.f, 0.f}; z = MFMA16(Kc[t][0], Qf[nt][0], z); Sx[t][nt] = MFMA16(Kc[t][1], Qf[nt][1], z); }
            bf16x8 Pf[2];
#pragma unroll
            for (int nt = 0; nt < 2; ++nt) {
                const int qpos = q0 + nt * 16 + fr;
                const float base = (float)(kb * 32 + fq * 8 - qpos);
                float sv[8]; float mx = -1e30f;
#pragma unroll
                for (int t = 0; t < 2; ++t)
#pragma unroll
                    for (int r = 0; r < 4; ++r) { const float kd = base + (float)(4 * t + r); const float val = Sx[t][nt][r] * LOG2E + slope2 * kd; const float s_ = (kd <= 0.f) ? val : -1e30f; sv[t * 4 + r] = s_; mx = fmaxf(mx, s_); }
                mx = fmaxf(mx, __shfl_xor(mx, 16)); mx = fmaxf(mx, __shfl_xor(mx, 32));
                const float mnew = fmaxf(mrun[nt], mx), alpha = ex2(mrun[nt] - mnew); mrun[nt] = mnew;
                float ps = 0.f;
#pragma unroll
                for (int i = 0; i < 8; ++i) { sv[i] = (sv[i] > -1e29f) ? ex2(sv[i] - mnew) : 0.f; ps += sv[i]; }
                lrun[nt] = lrun[nt] * alpha + ps;
#pragma unroll
                for (int mt = 0; mt < 8; ++mt) O[mt][nt] *= alpha;
                Pf[nt] = pack8(sv[0], sv[1], sv[2], sv[3], sv[4], sv[5], sv[6], sv[7]);
            }
#pragma unroll
            for (int mt = 0; mt < 8; ++mt) { O[mt][0] = MFMA16(Vf[mt], Pf[0], O[mt][0]); O[mt][1] = MFMA16(Vf[mt], Pf[1], O[mt][1]); }
#pragma unroll
            for (int t = 0; t < 2; ++t) { Kc[t][0] = Kn[t][0]; Kc[t][1] = Kn[t][1]; }
        }
        float inv[2];
#pragma unroll
        for (int nt = 0; nt < 2; ++nt) { float l = lrun[nt]; l += __shfl_xor(l, 16); l += __shfl_xor(l, 32); inv[nt] = 1.f / l; }
        if (c == 0) {
#pragma unroll
            for (int mt = 0; mt < 8; ++mt)
#pragma unroll
                for (int nt = 0; nt < 2; ++nt)
#pragma unroll
                    for (int r = 0; r < 4; ++r) park[((mt * 2 + nt) * 4 + r) * 64 + lane] = O[mt][nt][r] * inv[nt];
        } else {
            LDS_WAIT();
            float ss[2] = {0.f, 0.f};
#pragma unroll
            for (int mt = 0; mt < 8; ++mt)
#pragma unroll
                for (int nt = 0; nt < 2; ++nt)
#pragma unroll
                    for (int r = 0; r < 4; ++r) { const float v_ = park[((mt * 2 + nt) * 4 + r) * 64 + lane] - lam * (O[mt][nt][r] * inv[nt]); O[mt][nt][r] = v_; ss[nt] += v_ * v_; }
#pragma unroll
            for (int nt = 0; nt < 2; ++nt) {
                float s_ = ss[nt]; s_ += __shfl_xor(s_, 16); s_ += __shfl_xor(s_, 32);
                const float rstd = rsqrtf(s_ * (1.f / 128.f) + 1e-6f) * 0.8f;
                bf16* op = (bf16*)(ws + WS_OA) + (size_t)(b * S + q0 + nt * 16 + fr) * 512 + h * 128 + fq * 4;
#pragma unroll
                for (int mt = 0; mt < 8; ++mt) { const f32x4 gg = *(const f32x4*)(subln + mt * 16 + fq * 4);
                    v2u w; w.x = pk2(O[mt][nt][0] * rstd * gg.x, O[mt][nt][1] * rstd * gg.y); w.y = pk2(O[mt][nt][2] * rstd * gg.z, O[mt][nt][3] * rstd * gg.w);
                    *(v2u*)(op + mt * 16) = w; }
            }
            LDS_WAIT();
        }
    }
}


__device__ __forceinline__ int kswz(int row, int c) { const int F = (0x1320 >> (((row >> 3) & 3) * 4)) & 3; return row * 128 + ((c ^ (F | (((row >> 1) & 1) << 2))) << 4); }
__device__ __forceinline__ int vswz(int row, int c) { const int F = (0x1320 >> (((row >> 2) & 3) * 4)) & 3; return row * 64 + ((c ^ F) << 4); }
__device__ __forceinline__ void diff_wg_item(unsigned char* ws, const float* lamp, const float* subln, int bh, int qb, LAS unsigned char* lds, int tid, int wave, int lane) {
    const int b = bh >> 2, h = bh & 3, fr = lane & 15, fq = lane >> 4, wv = wave & 3, cm = wave >> 2;
    const int q0 = qb * 128 + wv * 32, lastkb = qb * 4 + wv, nsteps = qb * 4 + 4;
    float lam;
    { const float a = lamp[lane] * lamp[64 + lane], c = lamp[128 + lane] * lamp[192 + lane]; lam = __expf(wave_sum(a)) - __expf(wave_sum(c)) + 0.2f; }
    const float slope2 = ex2(-2.f * (float)(h + 1)) * LOG2E;
    const bf16* Qb = (const bf16*)(ws + WS_QA) + (size_t)(b * S) * 512 + h * 128;
    const bf16* Kb = (const bf16*)(ws + WS_KA) + (size_t)(b * S) * 512 + h * 128;
    const bf16* Vb = (const bf16*)(ws + WS_VAT) + (size_t)((b * 4 + h) * 128) * S;
    const int kr0 = 8 * (fr >> 2) + (fr & 3);
    const bf16* gA = Kb + (size_t)((tid & 255) >> 3) * 512 + (tid >> 8) * 64 + (tid & 7) * 8;
    const int lA = (tid >> 8) * 4096 + kswz((tid & 255) >> 3, tid & 7);
    const bf16* gB = Vb + (size_t)(tid >> 2) * S + (tid & 3) * 8;
    const int lB = 8192 + vswz(tid >> 2, tid & 3);
    bf16x8 Qf[2][2];
#pragma unroll
    for (int nt = 0; nt < 2; ++nt)
#pragma unroll
        for (int ks = 0; ks < 2; ++ks) Qf[nt][ks] = ldg8(Qb + (size_t)(q0 + nt * 16 + fr) * 512 + cm * 64 + ks * 32 + fq * 8);
    f32x4 O[8][2];
#pragma unroll
    for (int mt = 0; mt < 8; ++mt) { O[mt][0] = (f32x4){0.f, 0.f, 0.f, 0.f}; O[mt][1] = (f32x4){0.f, 0.f, 0.f, 0.f}; }
    float mrun[2] = {-1e30f, -1e30f}, lrun[2] = {0.f, 0.f};
    int koff[2][2];
#pragma unroll
    for (int t = 0; t < 2; ++t)
#pragma unroll
        for (int ks = 0; ks < 2; ++ks) koff[t][ks] = cm * 4096 + kswz(kr0 + 4 * t, ks * 4 + fq);
    const int voff = 8192 + vswz(fr, fq);
    float cst[8];
#pragma unroll
    for (int i = 0; i < 8; ++i) cst[i] = slope2 * (float)i;
    v4u ra = *(const v4u*)gA, rb = *(const v4u*)gB;
    *(LAS v4u*)(lds + lA) = ra; *(LAS v4u*)(lds + lB) = rb;
    __syncthreads();
    for (int kb = 0; kb < nsteps; ++kb) {
        const int cur = (kb & 1) * 16384, nxt = 16384 - cur;
        const bool more = kb + 1 < nsteps;
        if (more) { ra = *(const v4u*)(gA + (size_t)(kb + 1) * 32 * 512); rb = *(const v4u*)(gB + (kb + 1) * 32); }
        if (kb <= lastkb) {
            bf16x8 Kc[2][2];
#pragma unroll
            for (int t = 0; t < 2; ++t)
#pragma unroll
                for (int ks = 0; ks < 2; ++ks) Kc[t][ks] = *(const LAS bf16x8*)(lds + cur + koff[t][ks]);
            f32x4 Sx[2][2];
#pragma unroll
            for (int t = 0; t < 2; ++t)
#pragma unroll
                for (int nt = 0; nt < 2; ++nt) { f32x4 z = {0.f, 0.f, 0.f, 0.f}; z = MFMA16(Kc[t][0], Qf[nt][0], z); Sx[t][nt] = MFMA16(Kc[t][1], Qf[nt][1], z); }
            bf16x8 Vf[8];
#pragma unroll
            for (int mt = 0; mt < 8; ++mt) Vf[mt] = *(const LAS bf16x8*)(lds + cur + voff + mt * 1024);
            const bool diag = (kb == lastkb);
            bf16x8 Pf[2];
#pragma unroll
            for (int nt = 0; nt < 2; ++nt) {
                const int dq = q0 + nt * 16 + fr - (kb * 32 + fq * 8);
                const float sb = -slope2 * (float)dq;
                float sv[8];
#pragma unroll
                for (int t = 0; t < 2; ++t)
#pragma unroll
                    for (int r = 0; r < 4; ++r) sv[t * 4 + r] = fmaf(Sx[t][nt][r], LOG2E, sb + cst[t * 4 + r]);
                if (diag) {
#pragma unroll
                    for (int i = 0; i < 8; ++i) sv[i] = (i <= dq) ? sv[i] : -1e30f;
                }
                float mx = fmaxf(fmaxf(fmaxf(sv[0], sv[1]), fmaxf(sv[2], sv[3])), fmaxf(fmaxf(sv[4], sv[5]), fmaxf(sv[6], sv[7])));
                mx = fmaxf(mx, __shfl_xor(mx, 16)); mx = fmaxf(mx, __shfl_xor(mx, 32));
                const float mold = mrun[nt], mnew = fmaxf(mold, mx);
                float ps = 0.f;
#pragma unroll
                for (int i = 0; i < 8; ++i) { sv[i] = ex2(sv[i] - mnew); ps += sv[i]; }
                if (__ballot(mnew > mold) != 0ull) {
                    const float alpha = ex2(mold - mnew); mrun[nt] = mnew; lrun[nt] *= alpha;
#pragma unroll
                    for (int mt = 0; mt < 8; ++mt) O[mt][nt] *= alpha;
                }
                lrun[nt] += ps;
                Pf[nt] = pack8(sv[0], sv[1], sv[2], sv[3], sv[4], sv[5], sv[6], sv[7]);
            }
#pragma unroll
            for (int mt = 0; mt < 8; ++mt) { O[mt][0] = MFMA16(Vf[mt], Pf[0], O[mt][0]); O[mt][1] = MFMA16(Vf[mt], Pf[1], O[mt][1]); }
        }
        if (more) { *(LAS v4u*)(lds + nxt + lA) = ra; *(LAS v4u*)(lds + nxt + lB) = rb; }
        __syncthreads();
    }
    float inv[2];
#pragma unroll
    for (int nt = 0; nt < 2; ++nt) { float l = lrun[nt]; l += __shfl_xor(l, 16); l += __shfl_xor(l, 32); inv[nt] = 1.f / l; }
    LAS float* park = (LAS float*)(lds + 32768 + wv * 16384);
    if (cm == 1) {
#pragma unroll
        for (int mt = 0; mt < 8; ++mt)
#pragma unroll
            for (int nt = 0; nt < 2; ++nt)
#pragma unroll
                for (int r = 0; r < 4; ++r) park[((mt * 2 + nt) * 4 + r) * 64 + lane] = O[mt][nt][r] * inv[nt];
    }
    __syncthreads();
    if (cm == 0) {
        float ss[2] = {0.f, 0.f};
#pragma unroll
        for (int mt = 0; mt < 8; ++mt)
#pragma unroll
            for (int nt = 0; nt < 2; ++nt)
#pragma unroll
                for (int r = 0; r < 4; ++r) { const float v_ = O[mt][nt][r] * inv[nt] - lam * park[((mt * 2 + nt) * 4 + r) * 64 + lane]; O[mt][nt][r] = v_; ss[nt] += v_ * v_; }
#pragma unroll
        for (int nt = 0; nt < 2; ++nt) {
            float s_ = ss[nt]; s_ += __shfl_xor(s_, 16); s_ += __shfl_xor(s_, 32);
            const float rstd = rsqrtf(s_ * (1.f / 128.f) + 1e-6f) * 0.8f;
            bf16* op = (bf16*)(ws + WS_OA) + (size_t)(b * S + q0 + nt * 16 + fr) * 512 + h * 128 + fq * 4;
#pragma unroll
            for (int mt = 0; mt < 8; ++mt) { const f32x4 gg = *(const f32x4*)(subln + mt * 16 + fq * 4);
                v2u w; w.x = pk2(O[mt][nt][0] * rstd * gg.x, O[mt][nt][1] * rstd * gg.y); w.y = pk2(O[mt][nt][2] * rstd * gg.z, O[mt][nt][3] * rstd * gg.w);
                *(v2u*)(op + mt * 16) = w; }
        }
    }
    __syncthreads();
}

template <int MODE>
__device__ __forceinline__ void nsa_step(const bf16* Kp, const bf16* Vp, int kbase, const bf16x8 (&Qf)[2], int qpos, float slope2, bool blkok, int fr, int fq, int kr0,
                                         float& mrun, float& lrun, f32x4 (&O)[4]) {
    bf16x8 Ka[2][2];
#pragma unroll
    for (int t = 0; t < 2; ++t)
#pragma unroll
        for (int ks = 0; ks < 2; ++ks) Ka[t][ks] = ldg8(Kp + (size_t)(kbase + kr0 + 4 * t) * 64 + ks * 32 + fq * 8);
    bf16x8 Vf[4];
#pragma unroll
    for (int mt = 0; mt < 4; ++mt) Vf[mt] = ldg8(Vp + (size_t)(mt * 16 + fr) * S + kbase + fq * 8);
    f32x4 Sx[2];
#pragma unroll
    for (int t = 0; t < 2; ++t) { f32x4 z = {0.f, 0.f, 0.f, 0.f}; z = MFMA16(Ka[t][0], Qf[0], z); Sx[t] = MFMA16(Ka[t][1], Qf[1], z); }
    const int kd0 = kbase + fq * 8 - qpos;
    float sv[8]; float mx = -1e30f;
#pragma unroll
    for (int t = 0; t < 2; ++t)
#pragma unroll
        for (int r = 0; r < 4; ++r) { const int kd = kd0 + 4 * t + r; const bool ok = (MODE == 0) ? (blkok && kd <= 0) : (kd <= 0 && kd > -512);
            const float val = Sx[t][r] * LOG2E + slope2 * (float)kd; const float s_ = ok ? val : -1e30f; sv[t * 4 + r] = s_; mx = fmaxf(mx, s_); }
    mx = fmaxf(mx, __shfl_xor(mx, 16)); mx = fmaxf(mx, __shfl_xor(mx, 32));
    const float mnew = fmaxf(mrun, mx), alpha = ex2(mrun - mnew); mrun = mnew;
    float ps = 0.f;
#pragma unroll
    for (int i = 0; i < 8; ++i) { sv[i] = (sv[i] > -1e29f) ? ex2(sv[i] - mnew) : 0.f; ps += sv[i]; }
    lrun = lrun * alpha + ps;
    const bf16x8 Pf = pack8(sv[0], sv[1], sv[2], sv[3], sv[4], sv[5], sv[6], sv[7]);
#pragma unroll
    for (int mt = 0; mt < 4; ++mt) { O[mt] *= alpha; O[mt] = MFMA16(Vf[mt], Pf, O[mt]); }
}

__device__ __forceinline__ void cmp_scores(const bf16* Kc, int u, const bf16x8 (&Qf)[2], int qpos, int nv, float slope2, int fq, int kr0, float (&sv)[8]) {
#pragma unroll
    for (int t = 0; t < 2; ++t) {
        const bf16* kp = Kc + (size_t)(32 * u + kr0 + 4 * t) * 64 + fq * 8;
        f32x4 z = {0.f, 0.f, 0.f, 0.f}; z = MFMA16(ldg8(kp), Qf[0], z); z = MFMA16(ldg8(kp + 32), Qf[1], z);
#pragma unroll
        for (int rr = 0; rr < 4; ++rr) { const int cidx = 32 * u + 8 * fq + 4 * t + rr; const float dist = (float)(qpos - (cidx * 32 + 31));
            sv[t * 4 + rr] = (cidx < nv) ? (z[rr] * LOG2E - slope2 * dist) : -1e30f; }
    }
}

__device__ __forceinline__ void nsa_item(unsigned char* ws, int bg, int it, LAS float* wl, int lane) {
    const int b = bg >> 1, g = bg & 1, fr = lane & 15, fq = lane >> 4, i = fr >> 2, r = fr & 3, s0 = it * 4, qpos = s0 + i;
    const int kr0 = 8 * (fr >> 2) + (fr & 3);
    const float slope2 = ex2(-(float)(g * 4 + r + 1)) * LOG2E;
    bf16x8 Qf[2];
    { const bf16* qp = (const bf16*)(ws + WS_QB) + (size_t)(b * S + qpos) * 512 + (g * 4 + r) * 64 + fq * 8; Qf[0] = ldg8(qp); Qf[1] = ldg8(qp + 32); }
    const float* gp = (const float*)(ws + WS_GB) + (size_t)(b * S + qpos) * 24 + g * 12 + r * 3;
    const float g0 = gp[0], g1 = gp[1], g2 = gp[2];
    f32x4 Oacc[4];
#pragma unroll
    for (int mt = 0; mt < 4; ++mt) Oacc[mt] = (f32x4){0.f, 0.f, 0.f, 0.f};
#pragma unroll
    for (int e = 0; e < 8; ++e) wl[e * 64 + lane] = 0.f;
    const int nv = (qpos + 1) >> 5, nvmax = (s0 + 4) >> 5;
    if (nvmax > 0) {
        const bf16* Kc = (const bf16*)(ws + WS_KCMP) + (size_t)(bg * 256) * 64;
        const bf16* Vc = (const bf16*)(ws + WS_VCMP_T) + (size_t)(bg * 64) * 256;
        const int nu = (nvmax + 31) >> 5;
        float mloc = -1e30f, lloc = 0.f;
#pragma unroll 1
        for (int u = 0; u < nu; ++u) {
            float sv[8]; cmp_scores(Kc, u, Qf, qpos, nv, slope2, fq, kr0, sv);
            float mx = mloc;
#pragma unroll
            for (int e = 0; e < 8; ++e) mx = fmaxf(mx, sv[e]);
            float ps = 0.f;
#pragma unroll
            for (int e = 0; e < 8; ++e) ps += (sv[e] > -1e29f) ? ex2(sv[e] - mx) : 0.f;
            lloc = lloc * ex2(mloc - mx) + ps; mloc = mx;
        }
        float mx = fmaxf(mloc, __shfl_xor(mloc, 16)); mx = fmaxf(mx, __shfl_xor(mx, 32));
        float ls = lloc * ex2(mloc - mx); ls += __shfl_xor(ls, 16); ls += __shfl_xor(ls, 32);
        const float inv = (ls > 0.f) ? 1.f / ls : 0.f;
        f32x4 Oc[4];
#pragma unroll
        for (int mt = 0; mt < 4; ++mt) Oc[mt] = (f32x4){0.f, 0.f, 0.f, 0.f};
#pragma unroll 1
        for (int u = 0; u < nu; ++u) {
            float sv[8]; cmp_scores(Kc, u, Qf, qpos, nv, slope2, fq, kr0, sv);
#pragma unroll
            for (int e = 0; e < 8; ++e) sv[e] = (sv[e] > -1e29f) ? ex2(sv[e] - mx) * inv : 0.f;
#pragma unroll
            for (int t = 0; t < 2; ++t) {
                float e0 = sv[t * 4 + 0] + sv[t * 4 + 1], e1 = sv[t * 4 + 2] + sv[t * 4 + 3];
                e0 += __shfl_xor(e0, 1); e0 += __shfl_xor(e0, 2); e1 += __shfl_xor(e1, 1); e1 += __shfl_xor(e1, 2);
                if (r == 0) { const int j = 16 * u + 4 * fq + 2 * t; wl[i * 128 + j] = e0; wl[i * 128 + j + 1] = e1; }
            }
            const bf16x8 Pf = pack8(sv[0], sv[1], sv[2], sv[3], sv[4], sv[5], sv[6], sv[7]);
#pragma unroll
            for (int mt = 0; mt < 4; ++mt) Oc[mt] = MFMA16(ldg8(Vc + (size_t)(mt * 16 + fr) * 256 + 32 * u + fq * 8), Pf, Oc[mt]);
        }
#pragma unroll
        for (int mt = 0; mt < 4; ++mt) Oacc[mt] = Oc[mt] * g0;
    }
    LDS_WAIT();
    unsigned msk[4] = {0u, 0u, 0u, 0u};
    {
        const int q16 = r + 4 * fq, cur = qpos >> 6;
        float cv[8];
#pragma unroll
        for (int e = 0; e < 8; ++e) { const int j = q16 + 16 * e; const bool forced = (j == 0) || (j == cur) || (j == cur - 1);
            cv[e] = forced ? 1e4f : ((j <= cur) ? wl[i * 128 + j] : -1e9f); }
        for (int round = 0; round < 16; ++round) {
            float best = cv[0]; int be = 0;
#pragma unroll
            for (int e = 1; e < 8; ++e) if (cv[e] > best) { best = cv[e]; be = e; }
            int bj = q16 + 16 * be;
#pragma unroll
            for (int oi = 0; oi < 4; ++oi) { const int off = (oi == 0) ? 1 : (oi == 1) ? 2 : (oi == 2) ? 16 : 32;
                const float ov = __shfl_xor(best, off); const int oj = __shfl_xor(bj, off);
                const bool take = (ov > best) || (ov == best && oj < bj); best = take ? ov : best; bj = take ? oj : bj; }
            const unsigned bit = 1u << (bj & 31); const int w = bj >> 5;
            msk[0] |= (w == 0) ? bit : 0u; msk[1] |= (w == 1) ? bit : 0u; msk[2] |= (w == 2) ? bit : 0u; msk[3] |= (w == 3) ? bit : 0u;
#pragma unroll
            for (int e = 0; e < 8; ++e) if (bj == q16 + 16 * e) cv[e] = -3e38f;
        }
    }
    {
        const bf16* Kp = (const bf16*)(ws + WS_KS) + (size_t)(bg * S) * 64;
        const bf16* Vp = (const bf16*)(ws + WS_VST) + (size_t)(bg * 64) * S;
        float mrun = -1e30f, lrun = 0.f; f32x4 O[4];
#pragma unroll
        for (int mt = 0; mt < 4; ++mt) O[mt] = (f32x4){0.f, 0.f, 0.f, 0.f};
        const int curmax = (s0 + 3) >> 6;
#pragma unroll
        for (int w = 0; w < 4; ++w) {
            unsigned u_ = msk[w]; u_ |= __shfl_xor(u_, 4); u_ |= __shfl_xor(u_, 8);
            unsigned uu = (unsigned)__builtin_amdgcn_readfirstlane((int)u_);
            const int hi = curmax - 32 * w;
            const unsigned vm = (hi < 0) ? 0u : (hi >= 31 ? 0xffffffffu : ((2u << hi) - 1u));
            uu &= vm;
            while (uu) {
                const int jb = __builtin_ctz(uu); uu &= uu - 1u;
                const bool blkok = (msk[w] >> jb) & 1u;
                const int kbase = (32 * w + jb) * 64;
                nsa_step<0>(Kp, Vp, kbase, Qf, qpos, slope2, blkok, fr, fq, kr0, mrun, lrun, O);
                nsa_step<0>(Kp, Vp, kbase + 32, Qf, qpos, slope2, blkok, fr, fq, kr0, mrun, lrun, O);
            }
        }
        float l = lrun; l += __shfl_xor(l, 16); l += __shfl_xor(l, 32);
        const float sc_ = g1 / l;
#pragma unroll
        for (int mt = 0; mt < 4; ++mt) Oacc[mt] += O[mt] * sc_;
    }
    {
        const bf16* Kp = (const bf16*)(ws + WS_KW) + (size_t)(bg * S) * 64;
        const bf16* Vp = (const bf16*)(ws + WS_VWT) + (size_t)(bg * 64) * S;
        float mrun = -1e30f, lrun = 0.f; f32x4 O[4];
#pragma unroll
        for (int mt = 0; mt < 4; ++mt) O[mt] = (f32x4){0.f, 0.f, 0.f, 0.f};
        const int kstart = (s0 - 511 > 0) ? (s0 - 511) : 0;
        for (int k32 = kstart >> 5; k32 <= ((s0 + 3) >> 5); ++k32)
            nsa_step<1>(Kp, Vp, k32 * 32, Qf, qpos, slope2, true, fr, fq, kr0, mrun, lrun, O);
        float l = lrun; l += __shfl_xor(l, 16); l += __shfl_xor(l, 32);
        const float sc_ = g2 / l;
#pragma unroll
        for (int mt = 0; mt < 4; ++mt) Oacc[mt] += O[mt] * sc_;
    }
    bf16* op = (bf16*)(ws + WS_OB) + (size_t)(b * S + qpos) * 512 + (g * 4 + r) * 64 + fq * 4;
#pragma unroll
    for (int mt = 0; mt < 4; ++mt) { v2u w; w.x = pk2(Oacc[mt][0], Oacc[mt][1]); w.y = pk2(Oacc[mt][2], Oacc[mt][3]); *(v2u*)(op + mt * 16) = w; }
    LDS_WAIT();
}

__device__ __forceinline__ void cross_item(unsigned char* ws, int rt, int h, int lane) {
    const int fr = lane & 15, fq = lane >> 4, row = rt * 16 + fr, b = (rt * 16) >> 13;
    const int kr0 = 8 * (fr >> 2) + (fr & 3);
    bf16x8 Qf[4];
    { const bf16* qp = (const bf16*)(ws + WS_QC) + (size_t)row * 512 + h * 128 + fq * 8;
#pragma unroll
      for (int ks = 0; ks < 4; ++ks) Qf[ks] = ldg8(qp + ks * 32); }
    const bf16* Kc = (const bf16*)(ws + WS_KMEM) + (size_t)((b * 4 + h) * 256) * 128;
    const bf16* Vc = (const bf16*)(ws + WS_VMEM_T) + (size_t)((b * 4 + h) * 128) * 256;
    f32x4 sc[16]; float mx = -1e30f;
#pragma unroll
    for (int kt = 0; kt < 16; ++kt) {
        const int u = kt >> 1, t = kt & 1;
        const bf16* kp = Kc + (size_t)(32 * u + kr0 + 4 * t) * 128 + fq * 8;
        f32x4 z = {0.f, 0.f, 0.f, 0.f};
#pragma unroll
        for (int ks = 0; ks < 4; ++ks) z = MFMA16(ldg8(kp + ks * 32), Qf[ks], z);
        z *= LOG2E; sc[kt] = z;
        mx = fmaxf(mx, fmaxf(fmaxf(z[0], z[1]), fmaxf(z[2], z[3])));
    }
    mx = fmaxf(mx, __shfl_xor(mx, 16)); mx = fmaxf(mx, __shfl_xor(mx, 32));
    float ls = 0.f;
#pragma unroll
    for (int kt = 0; kt < 16; ++kt)
#pragma unroll
        for (int rr = 0; rr < 4; ++rr) { const float p = ex2(sc[kt][rr] - mx); sc[kt][rr] = p; ls += p; }
    ls += __shfl_xor(ls, 16); ls += __shfl_xor(ls, 32);
    const float inv = 1.f / ls;
    f32x4 O[8];
#pragma unroll
    for (int mt = 0; mt < 8; ++mt) O[mt] = (f32x4){0.f, 0.f, 0.f, 0.f};
#pragma unroll
    for (int u = 0; u < 8; ++u) {
        const bf16x8 Pf = pack8(sc[2 * u][0], sc[2 * u][1], sc[2 * u][2], sc[2 * u][3], sc[2 * u + 1][0], sc[2 * u + 1][1], sc[2 * u + 1][2], sc[2 * u + 1][3]);
#pragma unroll
        for (int mt = 0; mt < 8; ++mt) O[mt] = MFMA16(ldg8(Vc + (size_t)(mt * 16 + fr) * 256 + 32 * u + fq * 8), Pf, O[mt]);
    }
    bf16* op = (bf16*)(ws + WS_OC) + (size_t)row * 512 + h * 128 + fq * 4;
#pragma unroll
    for (int mt = 0; mt < 8; ++mt) { v2u w; w.x = pk2(O[mt][0] * inv, O[mt][1] * inv); w.y = pk2(O[mt][2] * inv, O[mt][3] * inv); *(v2u*)(op + mt * 16) = w; }
}

__device__ __forceinline__ void peer_token(unsigned char* ws, const float* gfin, float* outp, int tok, int lane) {
    const bf16* scp = (const bf16*)(ws + WS_SCORES) + (size_t)tok * 2048;
    const int l16 = lane & 15, grp = lane >> 4;
    float tsv[4]; int tsi[4];
#pragma unroll
    for (int gi = 0; gi < 4; ++gi) {
        const int hc = gi * 4 + grp;
        const v4u raw = *(const v4u*)(scp + hc * 128 + l16 * 8);
        float cv[8] = {bflo(raw.x), bfhi(raw.x), bflo(raw.y), bfhi(raw.y), bflo(raw.z), bfhi(raw.z), bflo(raw.w), bfhi(raw.w)};
        float myv = 0.f; int myi = 0;
        for (int round = 0; round < 16; ++round) {
            float best = cv[0]; int be = 0;
#pragma unroll
            for (int e = 1; e < 8; ++e) if (cv[e] > best) { best = cv[e]; be = e; }
            int bk = l16 * 8 + be;
#pragma unroll
            for (int off = 1; off < 16; off <<= 1) { const float ov = __shfl_xor(best, off); const int ok = __shfl_xor(bk, off);
                const bool take = (ov > best) || (ov == best && ok < bk); best = take ? ov : best; bk = take ? ok : bk; }
            if (l16 == round) { myv = best; myi = bk; }
#pragma unroll
            for (int e = 0; e < 8; ++e) if (bk == l16 * 8 + e) cv[e] = -3e38f;
        }
        tsv[gi] = myv; tsi[gi] = myi;
    }
    float gsel[4]; int esel[4];
    const int half = lane >> 5, L = lane & 31, hb = half * 32, a = L & 15, bb = (L >> 4) * 8;
#pragma unroll
    for (int gi = 0; gi < 4; ++gi) {
        const float s0a = __shfl(tsv[gi], hb + a);
        float cand[8];
#pragma unroll
        for (int e = 0; e < 8; ++e) cand[e] = s0a + __shfl(tsv[gi], hb + 16 + bb + e);
        float selv = 0.f; int self_ = 0;
        for (int round = 0; round < 16; ++round) {
            float best = cand[0]; int be = 0;
#pragma unroll
            for (int e = 1; e < 8; ++e) if (cand[e] > best) { best = cand[e]; be = e; }
            int bfi = a * 16 + bb + be;
#pragma unroll
            for (int off = 1; off < 32; off <<= 1) { const float ov = __shfl_xor(best, off); const int oi = __shfl_xor(bfi, off);
                const bool take = (ov > best) || (ov == best && oi < bfi); best = take ? ov : best; bfi = take ? oi : bfi; }
            if (L == round) { selv = best; self_ = bfi; }
#pragma unroll
            for (int e = 0; e < 8; ++e) if (bfi == a * 16 + bb + e) cand[e] = -3e38f;
        }
        const int i0 = __shfl(tsi[gi], hb + (self_ >> 4)), i1 = __shfl(tsi[gi], hb + 16 + (self_ & 15));
        const float mxv = __shfl(selv, hb);
        float ev = (L < 16) ? __expf(selv - mxv) : 0.f;
        float sm = ev;
#pragma unroll
        for (int off = 1; off < 16; off <<= 1) sm += __shfl_xor(sm, off);
        gsel[gi] = (L < 16) ? ev / sm : 0.f; esel[gi] = i0 * 128 + i1;
    }
    int eR[2]; float gR[2];
#pragma unroll
    for (int rr = 0; rr < 2; ++rr) {
        const int e1 = __shfl(esel[2 * rr + 1], lane - 16); const float g1_ = __shfl(gsel[2 * rr + 1], lane - 16);
        const bool odd = (lane & 16) != 0;
        eR[rr] = odd ? e1 : esel[2 * rr]; gR[rr] = odd ? g1_ : gsel[2 * rr];
    }
    float xf[16];
    { const bf16* up = (const bf16*)(ws + WS_U) + (size_t)tok * 1024 + lane * 16; const v4u a0 = *(const v4u*)up, a1 = *(const v4u*)(up + 8);
      xf[0] = bflo(a0.x); xf[1] = bfhi(a0.x); xf[2] = bflo(a0.y); xf[3] = bfhi(a0.y); xf[4] = bflo(a0.z); xf[5] = bfhi(a0.z); xf[6] = bflo(a0.w); xf[7] = bfhi(a0.w);
      xf[8] = bflo(a1.x); xf[9] = bfhi(a1.x); xf[10] = bflo(a1.y); xf[11] = bfhi(a1.y); xf[12] = bflo(a1.z); xf[13] = bfhi(a1.z); xf[14] = bflo(a1.w); xf[15] = bfhi(a1.w); }
    float oacc[16];
#pragma unroll
    for (int e = 0; e < 16; ++e) oacc[e] = 0.f;
    const unsigned char* PU = ws + WS_PU; const unsigned char* PV = ws + WS_PV;
    const int kkL = ((lane >> 5) & 1) * 8 + ((lane >> 4) & 1) * 4 + ((lane >> 3) & 1) * 2 + ((lane >> 2) & 1);
#pragma unroll
    for (int rr = 0; rr < 2; ++rr) {
        float wreg = 0.f;
#pragma unroll 1
        for (int sub = 0; sub < 4; ++sub) {
            const int lbase = (sub >> 1) * 16 + (sub & 1) * 32;
            float pv[16];
#pragma unroll
            for (int hh = 0; hh < 2; ++hh) {
            v4u u8[8];
#pragma unroll
            for (int kk = 0; kk < 8; ++kk) { const int eid = __builtin_amdgcn_readlane(eR[rr], lbase + hh * 8 + kk); u8[kk] = *(const v4u*)(PU + (size_t)eid * 1024 + lane * 16); }
#pragma unroll
            for (int kk = 0; kk < 8; ++kk) {
                const f32x2 c0 = __builtin_amdgcn_cvt_pk_f32_fp8((int)u8[kk].x, false), c1 = __builtin_amdgcn_cvt_pk_f32_fp8((int)u8[kk].x, true);
                const f32x2 c2 = __builtin_amdgcn_cvt_pk_f32_fp8((int)u8[kk].y, false), c3 = __builtin_amdgcn_cvt_pk_f32_fp8((int)u8[kk].y, true);
                const f32x2 c4 = __builtin_amdgcn_cvt_pk_f32_fp8((int)u8[kk].z, false), c5 = __builtin_amdgcn_cvt_pk_f32_fp8((int)u8[kk].z, true);
                const f32x2 c6 = __builtin_amdgcn_cvt_pk_f32_fp8((int)u8[kk].w, false), c7 = __builtin_amdgcn_cvt_pk_f32_fp8((int)u8[kk].w, true);
                pv[hh * 8 + kk] = ((xf[0] * c0.x + xf[1] * c0.y) + (xf[2] * c1.x + xf[3] * c1.y)) + ((xf[4] * c2.x + xf[5] * c2.y) + (xf[6] * c3.x + xf[7] * c3.y))
                       + ((xf[8] * c4.x + xf[9] * c4.y) + (xf[10] * c5.x + xf[11] * c5.y)) + ((xf[12] * c6.x + xf[13] * c6.y) + (xf[14] * c7.x + xf[15] * c7.y));
            }
            __builtin_amdgcn_sched_barrier(0);
            }
            { const bool bit = (lane & 32) != 0;
#pragma unroll
              for (int j = 0; j < 8; ++j) { const float send = bit ? pv[j] : pv[j + 8], keep = bit ? pv[j + 8] : pv[j]; pv[j] = keep + __shfl_xor(send, 32); } }
            { const bool bit = (lane & 16) != 0;
#pragma unroll
              for (int j = 0; j < 4; ++j) { const float send = bit ? pv[j] : pv[j + 4], keep = bit ? pv[j + 4] : pv[j]; pv[j] = keep + __shfl_xor(send, 16); } }
            { const bool bit = (lane & 8) != 0;
#pragma unroll
              for (int j = 0; j < 2; ++j) { const float send = bit ? pv[j] : pv[j + 2], keep = bit ? pv[j + 2] : pv[j]; pv[j] = keep + __shfl_xor(send, 8); } }
            { const bool bit = (lane & 4) != 0; const float send = bit ? pv[0] : pv[1], keep = bit ? pv[1] : pv[0]; pv[0] = keep + __shfl_xor(send, 4); }
            float dot = pv[0]; dot += __shfl_xor(dot, 1); dot += __shfl_xor(dot, 2);
            const float gt = __shfl(gR[rr], lbase + kkL);
            const float w_ = gt * gelu_erf(dot * (1.f / 64.f)) * (1.f / 16.f);
            wreg = ((lane & 3) == sub) ? w_ : wreg;
        }
#pragma unroll 1
        for (int sub = 0; sub < 4; ++sub) {
            const int lbase = (sub >> 1) * 16 + (sub & 1) * 32;
#pragma unroll
            for (int hh = 0; hh < 2; ++hh) {
            v4u v8[8];
#pragma unroll
            for (int k8 = 0; k8 < 8; ++k8) { const int eid = __builtin_amdgcn_readlane(eR[rr], lbase + hh * 8 + k8); v8[k8] = *(const v4u*)(PV + (size_t)eid * 1024 + lane * 16); }
#pragma unroll
            for (int k8 = 0; k8 < 8; ++k8) {
                const int kk = hh * 8 + k8;
                const int sl = (((kk >> 3) & 1) << 5) | (((kk >> 2) & 1) << 4) | (((kk >> 1) & 1) << 3) | ((kk & 1) << 2);
                const float w_ = __builtin_bit_cast(float, __builtin_amdgcn_readlane(__builtin_bit_cast(int, wreg), sl + sub));
                const f32x2 c0 = __builtin_amdgcn_cvt_pk_f32_fp8((int)v8[k8].x, false), c1 = __builtin_amdgcn_cvt_pk_f32_fp8((int)v8[k8].x, true);
                const f32x2 c2 = __builtin_amdgcn_cvt_pk_f32_fp8((int)v8[k8].y, false), c3 = __builtin_amdgcn_cvt_pk_f32_fp8((int)v8[k8].y, true);
                const f32x2 c4 = __builtin_amdgcn_cvt_pk_f32_fp8((int)v8[k8].z, false), c5 = __builtin_amdgcn_cvt_pk_f32_fp8((int)v8[k8].z, true);
                const f32x2 c6 = __builtin_amdgcn_cvt_pk_f32_fp8((int)v8[k8].w, false), c7 = __builtin_amdgcn_cvt_pk_f32_fp8((int)v8[k8].w, true);
                oacc[0] += w_ * c0.x; oacc[1] += w_ * c0.y; oacc[2] += w_ * c1.x; oacc[3] += w_ * c1.y; oacc[4] += w_ * c2.x; oacc[5] += w_ * c2.y; oacc[6] += w_ * c3.x; oacc[7] += w_ * c3.y;
                oacc[8] += w_ * c4.x; oacc[9] += w_ * c4.y; oacc[10] += w_ * c5.x; oacc[11] += w_ * c5.y; oacc[12] += w_ * c6.x; oacc[13] += w_ * c6.y; oacc[14] += w_ * c7.x; oacc[15] += w_ * c7.y;
            }
            __builtin_amdgcn_sched_barrier(0);
            }
        }
    }
    const float* hp = (const float*)(ws + WS_H) + (size_t)tok * 1024 + lane * 16;
    float y[16];
#pragma unroll
    for (int q = 0; q < 4; ++q) { const f32x4 hv = *(const f32x4*)(hp + 4 * q); y[4 * q] = hv.x + oacc[4 * q]; y[4 * q + 1] = hv.y + oacc[4 * q + 1]; y[4 * q + 2] = hv.z + oacc[4 * q + 2]; y[4 * q + 3] = hv.w + oacc[4 * q + 3]; }
    float ss = 0.f;
#pragma unroll
    for (int e = 0; e < 16; ++e) ss += y[e] * y[e];
    const float rstd = rsqrtf(wave_sum(ss) * (1.f / D) + 1e-6f);
    const float* gp = gfin + lane * 16; float* op = outp + (size_t)tok * 1024 + lane * 16;
#pragma unroll
    for (int q = 0; q < 4; ++q) { const f32x4 gv = *(const f32x4*)(gp + 4 * q);
        *(f32x4*)(op + 4 * q) = (f32x4){y[4 * q] * rstd * gv.x, y[4 * q + 1] * rstd * gv.y, y[4 * q + 2] * rstd * gv.z, y[4 * q + 3] * rstd * gv.w}; }
}

typedef unsigned gu32_unused;
#define XB_TMO      128
#define XB_XCNT(j)  (256  + 64 * (j))
#define XB_XSUB(j)  (1280 + 64 * (j))
#define XB_XGEN(j)  (2304 + 64 * (j))
#define XB_TOP      3328
#define XB_TOPGEN   3392
#define XCD_BAR_WORDS 3456
#define XB_SPIN_CAP (1u << 18)

__device__ __forceinline__ unsigned xb_ld(unsigned* p)              { return __hip_atomic_load(p, __ATOMIC_RELAXED, __HIP_MEMORY_SCOPE_AGENT); }
__device__ __forceinline__ unsigned xb_add(unsigned* p, unsigned v) { return __hip_atomic_fetch_add(p, v, __ATOMIC_RELAXED, __HIP_MEMORY_SCOPE_AGENT); }
__device__ __forceinline__ unsigned xb_xcc_id() { return (unsigned)__builtin_amdgcn_s_getreg((3 << 11) | 20) & 0xFu; }
#define XB_SPIN(cond, bar) do { unsigned _sp = 0; while (cond) { __builtin_amdgcn_s_sleep(1); \
    if ((++_sp & 255u) == 0u) { if (xb_ld(&(bar)[XB_TMO])) break; if (_sp > XB_SPIN_CAP) { atomicAdd(&(bar)[XB_TMO], 1u); break; } } } } while (0)

struct XcdBarrier {
    unsigned* bar; unsigned x;
    volatile LAS unsigned* st;
};

__device__ __forceinline__ XcdBarrier xcd_barrier_post(unsigned* bar, volatile LAS unsigned* st) {
    XcdBarrier b; b.bar = bar; b.x = xb_xcc_id(); b.st = st;
    if (threadIdx.x == 0) (void)xb_add(&bar[XB_XCNT(b.x)], 1u);
    return b;
}
__device__ __forceinline__ void xcd_barrier_complete(unsigned* bar, unsigned x, unsigned& nloc, unsigned& nx) {
    const unsigned G = gridDim.x * gridDim.y * gridDim.z;
    unsigned sum, cnt, mine, sp = 0u;
    for (;;) {
        sum = 0u; cnt = 0u; mine = 0u;
#pragma unroll
        for (unsigned j = 0; j < 16; ++j) { const unsigned c = xb_ld(&bar[XB_XCNT(j)]); sum += c; cnt += (c > 0u) ? 1u : 0u; mine = (j == x) ? c : mine; }
        if (sum == G) break;
        __builtin_amdgcn_s_sleep(1);
        if ((++sp & 255u) == 0u) { if (xb_ld(&bar[XB_TMO])) break; if (sp > XB_SPIN_CAP) { atomicAdd(&bar[XB_TMO], 1u); break; } }
    }
    nloc = mine > 0u ? mine : 1u; nx = cnt > 0u ? cnt : 1u;
}

__device__ __forceinline__ void xcd_barrier(const XcdBarrier& b) {
    asm volatile("s_waitcnt vmcnt(0)" ::: "memory");
    __syncthreads();
    if (threadIdx.x == 0) {
        unsigned* bar = b.bar;
        __builtin_amdgcn_s_waitcnt(0);
        unsigned nloc = b.st[0], nx = b.st[1];
        if (nloc == 0u) { xcd_barrier_complete(bar, b.x, nloc, nx); b.st[0] = nloc; b.st[1] = nx; }
        const unsigned old = xb_add(&bar[XB_XSUB(b.x)], 1u);
        const unsigned gen = old / nloc;
        if (old + 1u == (gen + 1u) * nloc) {
            __builtin_amdgcn_fence(__ATOMIC_RELEASE, "agent");
            asm volatile("s_waitcnt vmcnt(0)" ::: "memory");
            const unsigned og = xb_add(&bar[XB_TOP], 1u);
            const unsigned tg = og / nx;
            if (og + 1u == (tg + 1u) * nx) xb_add(&bar[XB_TOPGEN], 1u);
            else XB_SPIN(xb_ld(&bar[XB_TOPGEN]) == tg, bar);
            __builtin_amdgcn_fence(__ATOMIC_ACQUIRE, "agent");
            xb_add(&bar[XB_XGEN(b.x)], 1u);
            asm volatile("s_waitcnt vmcnt(0)" ::: "memory");
        } else {
            XB_SPIN(xb_ld(&bar[XB_XGEN(b.x)]) == gen, bar);
            __builtin_amdgcn_fence(__ATOMIC_ACQUIRE, "agent");
            asm volatile("s_waitcnt vmcnt(0)" ::: "memory");
        }
    }
    __syncthreads();
}

constexpr int NPHASE = 14;
__global__ void __launch_bounds__(NTHR, 2) hybrid_fwd(Args args) {
    extern __shared__ __attribute__((aligned(16))) unsigned char lds_raw[];
    LAS unsigned char* lds = (LAS unsigned char*)lds_raw;
    unsigned char* ws = args.ws;
    const int tid = threadIdx.x, lane = tid & 63, wave = __builtin_amdgcn_readfirstlane(tid >> 6);
    const int G = gridDim.x, bx = blockIdx.x;
    const int gw = bx * NWAVES + wave, NGW = G * NWAVES;
    const int lo = args.ph_lo, hi = args.ph_hi;
    const bool coop = (hi - lo) > 1;
    volatile LAS unsigned* MISC = (volatile LAS unsigned*)(lds + 131072 + 320);
    for (int u = tid; u < (LDS_BYTES - 131072) / 4; u += NTHR) ((LAS unsigned*)(lds + 131072))[u] = 0u;
    __syncthreads();
    XcdBarrier xbar; xbar.bar = (unsigned*)(ws + WS_CTL) + 4096; xbar.x = 0; xbar.st = nullptr;
    if (coop) xbar = xcd_barrier_post((unsigned*)(ws + WS_CTL) + 4096, MISC + 8);
#ifndef PH_MASK
#define PH_MASK 0x3fff
#endif
#define IN(k) (((PH_MASK >> (k)) & 1) && lo <= (k) && (k) < hi)
#ifndef REP_MASK
#define REP_MASK 0
#endif
#ifndef REP_WHICH
#define REP_WHICH 0
#endif
#define NREP(k) (1 + ((REP_MASK >> (k)) & 1))
#define SEAM(k) do { if (coop && IN(k) && IN((k) + 1)) { if ((k) == 0) cg::this_grid().sync(); else xcd_barrier(xbar); } } while (0)
    const float* x = args.in[0];
    EpiAll ea; ea.mode = 0; ea.ws = ws; ea.x = x; ea.cmp_pos = args.in[6]; ea.part = nullptr;

    if (IN(0)) for (int rep = 0; rep < NREP(0); ++rep) {
        LAS float* scr = (LAS float*)(lds + wave * 16384);
        constexpr int I_WIN = 16 * 160, I_C1 = 32 * 8, I_AB = 8 * 32, I_OUT = 16 * 32, I_CQ = 16 * 16, I_CKV = 16 * 32, I_CO = 8 * 32;
        constexpr int NIT = I_WIN + 2 * I_C1 + 2 * I_AB + I_OUT + I_CQ + I_CKV + I_CO;
        for (int it = gw; it < NIT; it += NGW) {
            int r = it;
            if (r < I_WIN) { transpose_item(args.in[3], 1024, NIN, 160, (bf16*)(ws + WS_WIN_T), scr, r, lane); continue; } r -= I_WIN;
            if (r < I_C1) { transpose_item(args.in[7], 2048, 256, 8, (bf16*)(ws + WS_CKW1_T), scr, r, lane); continue; } r -= I_C1;
            if (r < I_C1) { transpose_item(args.in[9], 2048, 256, 8, (bf16*)(ws + WS_CVW1_T), scr, r, lane); continue; } r -= I_C1;
            if (r < I_AB) { transpose_item(args.in[11], 512, 1024, 32, (bf16*)(ws + WS_WA_T), scr, r, lane); continue; } r -= I_AB;
            if (r < I_AB) { transpose_item(args.in[12], 512, 1024, 32, (bf16*)(ws + WS_WB_T), scr, r, lane); continue; } r -= I_AB;
            if (r < I_OUT) { transpose_item(args.in[13], 1024, 1024, 32, (bf16*)(ws + WS_WOUT_T), scr, r, lane); continue; } r -= I_OUT;
            if (r < I_CQ) { transpose_item(args.in[16], 1024, 512, 16, (bf16*)(ws + WS_WCQ_T), scr, r, lane); continue; } r -= I_CQ;
            if (r < I_CKV) { transpose_item(args.in[17], 1024, 1024, 32, (bf16*)(ws + WS_WCKV_T), scr, r, lane); continue; } r -= I_CKV;
            transpose_item(args.in[18], 512, 1024, 32, (bf16*)(ws + WS_WCO_T), scr, r, lane);
        }
        for (int m = gw; m < T; m += NGW) rms_row_to_bf16(x + (size_t)m * D, args.in[2], (bf16*)(ws + WS_U) + (size_t)m * D, lane);
        for (int m = gw; m < 512; m += NGW) rms_row_to_bf16(args.in[1] + (size_t)m * D, args.in[15], (bf16*)(ws + WS_MEMN) + (size_t)m * D, lane);
        __syncthreads();
        {
            LAS float* skl = (LAS float*)lds;
            LAS float* wql = (LAS float*)(lds + 128 * 132 * 4);
            const float* SK = args.in[21]; const float* WQ = args.in[20];
            for (int item = bx; item < 256; item += G) {
                const int hc = item >> 4, k0 = (item & 15) * 64;
                for (int e = tid; e < 128 * 128; e += NTHR) { const int key = e >> 7, d = e & 127; skl[d * 132 + key] = SK[(size_t)(hc * 128 + key) * 128 + d]; }
                for (int e = tid; e < 64 * 128; e += NTHR) { const int k = e >> 7, d = e & 127; wql[d * 68 + k] = WQ[(size_t)(k0 + k) * 2048 + hc * 128 + d]; }
                __syncthreads();
                const int key4 = (tid & 31) * 4, kk4 = (tid >> 5) * 4;
                float acc[4][4];
#pragma unroll
                for (int i = 0; i < 4; ++i)
#pragma unroll
                    for (int j = 0; j < 4; ++j) acc[i][j] = 0.f;
                for (int d = 0; d < 128; ++d) {
                    const f32x4 av = *(const LAS f32x4*)(skl + d * 132 + key4), bv = *(const LAS f32x4*)(wql + d * 68 + kk4);
#pragma unroll
                    for (int i = 0; i < 4; ++i)
#pragma unroll
                        for (int j = 0; j < 4; ++j) acc[i][j] += av[i] * bv[j];
                }
#pragma unroll
                for (int i = 0; i < 4; ++i) { v2u w; w.x = pk2(acc[i][0], acc[i][1]); w.y = pk2(acc[i][2], acc[i][3]);
                    *(v2u*)((bf16*)(ws + WS_WPS_T) + (size_t)(hc * 128 + key4 + i) * 1024 + k0 + kk4) = w; }
                __syncthreads();
            }
        }
    }
    SEAM(0);
    if (IN(1)) for (int rep = 0; rep < NREP(1); ++rep) { ea.mode = EM_G1; run_gemm(lds, (const bf16*)(ws + WS_U), (const bf16*)(ws + WS_WIN_T), T, NIN_PAD, 1024, 1024, G, bx, ea); }
    SEAM(1);
    if (IN(2)) {
        if (bx < 64) {
            const int ci = bx >> 2, kv = ci >> 3, sp = ci & 7;
            ea.mode = EM_PART; ea.part = (float*)(ws + WS_HIDP) + (size_t)ci * 1024 * 256;
            run_gemm(lds, (const bf16*)(ws + (kv ? WS_VCI : WS_KCI)) + sp * 256, (const bf16*)(ws + (kv ? WS_CVW1_T : WS_CKW1_T)) + sp * 256, 1024, 256, 256, 2048, G, bx & 3, ea);
        } else {
            ea.mode = EM_KVMEM;
            run_gemm(lds, (const bf16*)(ws + WS_MEMN), (const bf16*)(ws + WS_WCKV_T), 512, 1024, 1024, 1024, G, (bx >= 128 && bx < 136) ? bx - 128 : 1 << 20, ea);
        }
    }
    SEAM(2);
    if (IN(3)) {
        LAS float* hl = (LAS float*)lds;
        const float* HP = (const float*)(ws + WS_HIDP);
        for (int it = bx; it < 256; it += G) {
            for (int e = tid; e < 2048; e += NTHR) { const int kv = e >> 10, rr = (e >> 8) & 3, c = e & 255, row = it * 4 + rr; float s_ = 0.f;
#pragma unroll
                for (int sp = 0; sp < 8; ++sp) s_ += HP[((size_t)((kv * 8 + sp) * 1024 + row)) * 256 + c];
                hl[e] = gelu_erf(s_); }
            __syncthreads();
            { const int kv = tid >> 8, rr = (tid >> 6) & 3, d = tid & 63, row = it * 4 + rr; const float* w2 = kv ? args.in[10] : args.in[8]; float a_ = 0.f;
              for (int j = 0; j < 256; ++j) a_ += hl[(kv * 4 + rr) * 256 + j] * w2[j * 64 + d];
              if (kv == 0) ((bf16*)(ws + WS_KCMP))[(size_t)row * 64 + d] = f2bf1(a_);
              else ((bf16*)(ws + WS_VCMP_T))[((size_t)((row >> 8) * 64 + d)) * 256 + (row & 255)] = f2bf1(a_); }
            __syncthreads();
        }
    }
    SEAM(3);
    if (IN(4)) for (int rep = 0; rep < NREP(4); ++rep) {
        const int xq = bx & 7;
        unsigned* qctrD = (unsigned*)(ws + WS_CTL) + 1024 + 64 * xq + 512 * rep;
        unsigned* qctrN = (unsigned*)(ws + WS_CTL) + 2048 + 64 * xq + 512 * rep;
        volatile LAS int* qslot = (volatile LAS int*)(lds + 131072 + 64);
        if (rep == 0 || REP_WHICH == 0) {
            for (;;) {
                if (tid == 0) *qslot = (int)atomicAdd(qctrD, 1u);
                __syncthreads();
                const int n = __builtin_amdgcn_readfirstlane(*qslot);
                __syncthreads();
                if (n >= 64) break;
                diff_wg_item(ws, args.in[4], args.in[5], xq, 63 - n, lds, tid, wave, lane);
            }
        }
        if (rep == 0 || REP_WHICH == 1) {
            LAS float* wl = (LAS float*)(lds + wave * 16384);
            for (;;) {
                int n = 0;
                if (lane == 0) n = (int)atomicAdd(qctrN, 1u);
                n = __builtin_amdgcn_readfirstlane(n);
                if (n >= 1024) break;
                nsa_item(ws, xq >> 1, 2047 - (2 * n + (xq & 1)), wl, lane);
            }
        }
    }
    SEAM(4);
    if (IN(5)) {
        ea.mode = EM_MA; run_gemm(lds, (const bf16*)(ws + WS_OA), (const bf16*)(ws + WS_WA_T), T, 1024, 512, 512, G, bx, ea);
        ea.mode = EM_MB; run_gemm(lds, (const bf16*)(ws + WS_OB), (const bf16*)(ws + WS_WB_T), T, 1024, 512, 512, G, bx, ea);
    }
    SEAM(5);
    if (IN(6)) { ea.mode = EM_H1; run_gemm(lds, (const bf16*)(ws + WS_U), (const bf16*)(ws + WS_WOUT_T), T, 1024, 1024, 1024, G, bx, ea); }
    SEAM(6);
    if (IN(7)) for (int rep = 0; rep < NREP(7); ++rep) {
        for (int m = gw; m < T; m += NGW) rms_row_to_bf16((const float*)(ws + WS_H) + (size_t)m * D, args.in[14], (bf16*)(ws + WS_U) + (size_t)m * D, lane);
        const size_t NV = (size_t)16384 * 1024 / 16;
        for (size_t e = (size_t)gw * 64 + lane; e < 2 * NV; e += (size_t)NGW * 64) {
            const bool second = e >= NV; const size_t ee = second ? e - NV : e;
            const float* src = (second ? args.in[23] : args.in[22]) + ee * 16; unsigned char* dst = ws + (second ? WS_PV : WS_PU) + ee * 16;
            const float sc = second ? 16.f : 64.f;
            v4u w;
#pragma unroll
            for (int q = 0; q < 4; ++q) { const f32x4 a = *(const f32x4*)(src + 4 * q); int p = 0;
                p = __builtin_amdgcn_cvt_pk_fp8_f32(a.x * sc, a.y * sc, p, false); p = __builtin_amdgcn_cvt_pk_fp8_f32(a.z * sc, a.w * sc, p, true); w[q] = (unsigned)p; }
            *(v4u*)dst = w;
        }
    }
    SEAM(7);
    if (IN(8)) { ea.mode = EM_QC; run_gemm(lds, (const bf16*)(ws + WS_U), (const bf16*)(ws + WS_WCQ_T), T, 512, 1024, 1024, G, bx, ea); }
    SEAM(8);
    if (IN(9)) for (int rep = 0; rep < NREP(9); ++rep) { for (int it = gw; it < 4096; it += NGW) cross_item(ws, it >> 2, it & 3, lane); }
    SEAM(9);
    if (IN(10)) { ea.mode = EM_H2; run_gemm(lds, (const bf16*)(ws + WS_OC), (const bf16*)(ws + WS_WCO_T), T, 1024, 512, 512, G, bx, ea); }
    SEAM(10);
    if (IN(11)) { for (int m = gw; m < T; m += NGW) rms_row_to_bf16((const float*)(ws + WS_H) + (size_t)m * D, args.in[19], (bf16*)(ws + WS_U) + (size_t)m * D, lane); }
    SEAM(11);
    if (IN(12)) for (int rep = 0; rep < NREP(12); ++rep) { ea.mode = EM_SC; run_gemm(lds, (const bf16*)(ws + WS_U), (const bf16*)(ws + WS_WPS_T), T, 2048, 1024, 1024, G, bx, ea); }
    SEAM(12);
    if (IN(13)) for (int rep = 0; rep < NREP(13); ++rep) { for (int tok = gw; tok < T; tok += NGW) { int ln = lane; asm volatile("" : "+v"(ln)); peer_token(ws, args.in[24], args.out, tok, ln); } }
#undef IN
#undef SEAM
}

#ifndef N_LAUNCH_MODE
#define N_LAUNCH_MODE 1
#endif
extern "C" void kernel_launch(void* const* d_in, const int* in_sizes, int n_in, void* d_out, int out_size, void* d_ws, size_t ws_size, hipStream_t stream) {
    static int grid = 0;
    if (grid == 0) {
        if (n_in != 25 || out_size != T * D || ws_size < WS_END) { fprintf(stderr, "kernel_launch: unexpected shapes (n_in %d out %d ws %zu)\n", n_in, out_size, ws_size); grid = -1; return; }
        int dev = 0, cus = 0, per_cu = 0;
        hipGetDevice(&dev); hipDeviceGetAttribute(&cus, hipDeviceAttributeMultiprocessorCount, dev);
        if (hipFuncSetAttribute((const void*)hybrid_fwd, hipFuncAttributeMaxDynamicSharedMemorySize, LDS_BYTES) != hipSuccess) { fprintf(stderr, "kernel_launch: hipFuncSetAttribute failed\n"); grid = -1; return; }
        if (hipOccupancyMaxActiveBlocksPerMultiprocessor(&per_cu, (const void*)hybrid_fwd, NTHR, LDS_BYTES) != hipSuccess || per_cu < 1) { fprintf(stderr, "kernel_launch: occupancy query says %d\n", per_cu); per_cu = 1; }
        (void)hipGetLastError();
        grid = cus * 1;
        if (grid > 256) grid = 256;
    }
    if (grid < 0) return;
    hipMemsetAsync((char*)d_ws + WS_CTL, 0, CTL_BYTES, stream);
    Args a{};
    for (int i = 0; i < 25; ++i) a.in[i] = (const float*)d_in[i];
    a.out = (float*)d_out; a.ws = (unsigned char*)d_ws;
#if N_LAUNCH_MODE == 1
    a.ph_lo = 0; a.ph_hi = NPHASE;
    void* kargs[] = {&a};
    hipError_t e = hipLaunchCooperativeKernel((const void*)hybrid_fwd, dim3(grid), dim3(NTHR), kargs, LDS_BYTES, stream);
    if (e != hipSuccess) fprintf(stderr, "cooperative launch failed: %s (grid %d)\n", hipGetErrorString(e), grid);
#else
    for (int p = 0; p < NPHASE; ++p) { a.ph_lo = p; a.ph_hi = p + 1; hipLaunchKernelGGL(hybrid_fwd, dim3(grid), dim3(NTHR), LDS_BYTES, stream, a); }
#endif
}
```

```cpp
#include <hip/hip_runtime.h>
#include <hip/hip_cooperative_groups.h>
#include <cstdio>
#include <cstdint>
namespace cg = cooperative_groups;
namespace pg8 {
#define PG8_LAS __attribute__((address_space(3)))
typedef unsigned short bf16_t;
typedef short bf16x8 __attribute__((ext_vector_type(8)));
typedef float f32x4 __attribute__((ext_vector_type(4)));
typedef unsigned u32x4 __attribute__((ext_vector_type(4)));
constexpr int BM = 256, BK = 64, HALF = 128, HTB = HALF * BK * 2  , STAGE_BYTES = 8 * HTB, NXCD = 8, WGM = 8;

__host__ __device__ __forceinline__ int lds_byte(int r, int c) { const int st = (r >> 4) * 2 + (c >> 5), rr = r & 15, cc = c & 31, ob = rr * 64 + cc * 2; return st * 1024 + (ob ^ (((ob >> 9) & 1) << 5)); }
__host__ __device__ __forceinline__ void stage_rc(int b, int& R, int& C) { const int st = b / 1024, sb = b % 1024, swz = sb ^ (((sb >> 9) & 1) << 5); R = (st >> 1) * 16 + swz / 64; C = (st & 1) * 32 + (swz % 64) / 2; }
__host__ __device__ __forceinline__ int perm32(int rho) { const int n = rho >> 4, i = rho & 15; return 8 * (i >> 2) + 4 * n + (i & 3); }

struct Unit { int pm, pn; };
struct Gemm { const bf16_t* A; const bf16_t* Bt; int M, N, K, ld; };

struct StaticOrder {
    int nM, nN, nwg, G, c;
    __host__ __device__ void init(int M, int N, int G_, int c_) { nM = M / BM; nN = N / BM; nwg = nM * nN; G = G_; c = c_; }
    __host__ __device__ bool next(int i, Unit& u) const {
        const long L = (long)i * G + c; if (L >= nwg) return false;
        int wgid = (int)L; { const int q = nwg / NXCD, r = nwg % NXCD, xcd = wgid % NXCD, off = wgid / NXCD; wgid = (xcd < r ? xcd * (q + 1) : r * (q + 1) + (xcd - r) * q) + off; }
        const int nig = WGM * nN, gid = wgid / nig, fm = gid * WGM, gsz = (nM - fm) < WGM ? (nM - fm) : WGM;
        u.pm = fm + ((wgid % nig) % gsz); u.pn = (wgid % nig) / gsz; return true;
    }
    __device__ __forceinline__ void a_ready(const Unit&) const {}
    __device__ __forceinline__ void done(const Unit&) const {}
};

__device__ __forceinline__ unsigned cvt_pk_bf16(float lo, float hi) { unsigned r; asm volatile("v_cvt_pk_bf16_f32 %0, %1, %2" : "=v"(r) : "v"(lo), "v"(hi)); return r; }
template <class F> struct EpiF {
    static constexpr bool PERM = true, AFTER_DRAIN = false;
    F f;
    __device__ __forceinline__ void operator()(const f32x4 (&acc)[2][2][4][2], const Unit& u, int wr, int wc, int fr, int fq) const {
        const int row0 = u.pm * BM + wr * 64 + fr, col0 = u.pn * BM + wc * 32 + 8 * fq;
#pragma unroll
        for (int ai = 0; ai < 2; ++ai)
#pragma unroll
            for (int m = 0; m < 4; ++m)
#pragma unroll
                for (int bj = 0; bj < 2; ++bj) f(row0 + ai * HALF + m * 16, col0 + bj * HALF, acc[ai][bj][m][0], acc[ai][bj][m][1]);
    }
};
template <class Epi, class Sched, bool ALIGN_EPI = false, bool SP2 = false>
__device__ __forceinline__ void gemm_phase(PG8_LAS unsigned char* lds, const Gemm g, const Sched& S, const Epi& E) {
    const int tid = threadIdx.x, wid = __builtin_amdgcn_readfirstlane(tid >> 6), lane = tid & 63, wr = wid >> 2, wc = wid & 3, fr = lane & 15, fq = lane >> 4;
    const int K = g.K, nt = K / BK;
    unsigned voffA[2], voffB[2];
#pragma unroll
    for (int i = 0; i < 2; ++i) { int R, C; stage_rc(tid * 16 + i * 8192, R, C); const int Rb = Epi::PERM ? ((R & ~31) + perm32(R & 31)) : R;
        voffA[i] = (unsigned)(R * g.ld + C) * 2u; voffB[i] = (unsigned)(Rb * g.ld + C) * 2u; }
    const size_t kstep = (size_t)(BK * 2);
    const size_t hstep = (size_t)HALF * g.ld * 2;
    const size_t tstep = 2 * hstep;
    const unsigned ldsw = (unsigned)wid * 1024u;
    const int aoff = lds_byte(wr * 64 + fr, fq * 8), boff = lds_byte(wc * 32 + fr, fq * 8);
#define PG8_SA(b, h) (((b) * 2 + (h)) * HTB)
#define PG8_SB(b, h) ((4 + (b) * 2 + (h)) * HTB)
#define PG8_STAGE(bufoff, gbase, voff) do { _Pragma("unroll") for (int _i = 0; _i < 2; ++_i) \
        __builtin_amdgcn_global_load_lds((const unsigned*)((const char*)(gbase) + (voff)[_i]), (PG8_LAS unsigned*)(lds + (bufoff) + ldsw + _i * 8192), 16, 0, 0); } while (0)
#define PG8_LDA(dst, b, h) do { _Pragma("unroll") for (int m = 0; m < 4; ++m) _Pragma("unroll") for (int k = 0; k < 2; ++k) dst[m][k] = *(const PG8_LAS bf16x8*)(lds + PG8_SA(b, h) + aoff + m * 2048 + k * 1024); } while (0)
#define PG8_LDB(dst, b, h) do { _Pragma("unroll") for (int n = 0; n < 2; ++n) _Pragma("unroll") for (int k = 0; k < 2; ++k) dst[n][k] = *(const PG8_LAS bf16x8*)(lds + PG8_SB(b, h) + boff + n * 2048 + k * 1024); } while (0)
#define PG8_MMA(ai, bj, At, Bt) do { __builtin_amdgcn_s_setprio(1); _Pragma("unroll") for (int m = 0; m < 4; ++m) _Pragma("unroll") for (int n = 0; n < 2; ++n) _Pragma("unroll") for (int k = 0; k < 2; ++k) \
        acc[ai][bj][m][n] = __builtin_amdgcn_mfma_f32_16x16x32_bf16(Bt[n][k], At[m][k], acc[ai][bj][m][n], 0, 0, 0); __builtin_amdgcn_s_setprio(0); } while (0)
#define PG8_WAIT_V(n) asm volatile("s_waitcnt vmcnt(" #n ")" ::: "memory")
#define PG8_WAIT_L(n) asm volatile("s_waitcnt lgkmcnt(" #n ")" ::: "memory")
#define PG8_BAR __builtin_amdgcn_s_barrier()
#define PG8_SCHED __builtin_amdgcn_sched_barrier(0)
    Unit cur, nxt; int ui = 0;
    if (!S.next(0, cur)) return;
    f32x4 acc[2][2][4][2];
#pragma unroll
    for (int a = 0; a < 2; ++a)
#pragma unroll
        for (int b = 0; b < 2; ++b)
#pragma unroll
            for (int m = 0; m < 4; ++m)
#pragma unroll
                for (int n = 0; n < 2; ++n) acc[a][b][m][n] = (f32x4){0.f, 0.f, 0.f, 0.f};
    bf16x8 At[4][2], B0[2][2], B1[2][2];
    const char* cA = (const char*)g.A + (size_t)cur.pm * tstep; const char* cB = (const char*)g.Bt + (size_t)cur.pn * tstep;
    S.a_ready(cur);
    if constexpr (SP2) {
        PG8_STAGE(PG8_SB(0, 0), cB, voffB); PG8_STAGE(PG8_SB(0, 1), cB + hstep, voffB); PG8_STAGE(PG8_SA(0, 0), cA, voffA); PG8_STAGE(PG8_SA(0, 1), cA + hstep, voffA);
        if (wr == 1) PG8_BAR;
        PG8_WAIT_V(2); PG8_BAR;
        PG8_STAGE(PG8_SB(1, 0), cB + kstep, voffB); PG8_STAGE(PG8_SA(1, 0), cA + kstep, voffA); PG8_STAGE(PG8_SB(1, 1), cB + hstep + kstep, voffB);
        PG8_WAIT_V(6); PG8_BAR;
    } else {
        PG8_STAGE(PG8_SB(0, 0), cB, voffB); PG8_STAGE(PG8_SA(0, 0), cA, voffA); PG8_STAGE(PG8_SB(0, 1), cB + hstep, voffB); PG8_STAGE(PG8_SA(0, 1), cA + hstep, voffA);
        if (wr == 1) PG8_BAR;
        PG8_WAIT_V(4); PG8_BAR;
        PG8_STAGE(PG8_SB(1, 0), cB + kstep, voffB); PG8_STAGE(PG8_SA(1, 0), cA + kstep, voffA); PG8_STAGE(PG8_SB(1, 1), cB + hstep + kstep, voffB);
        PG8_WAIT_V(6); PG8_BAR;
    }
    for (;;) {
        const bool has_next = S.next(ui + 1, nxt);
        const char* nA = has_next ? (const char*)g.A + (size_t)nxt.pm * tstep : cA; const char* nB = has_next ? (const char*)g.Bt + (size_t)nxt.pn * tstep : cB;
        for (int t = 0; t < nt; t += 2) {
            const bool last = (t == nt - 2);
            const char* a1 = cA + (size_t)(t + 1) * kstep;
            const char* a2 = last ? nA : cA + (size_t)(t + 2) * kstep; const char* b2 = last ? nB : cB + (size_t)(t + 2) * kstep;
            const char* a3 = a2 + kstep; const char* b3 = b2 + kstep;
            if (last && has_next) S.a_ready(nxt);
            if constexpr (SP2) {
            PG8_LDB(B0, 0, 0); PG8_LDB(B1, 0, 1); PG8_SCHED; PG8_LDA(At, 0, 0); PG8_STAGE(PG8_SA(1, 1), a1 + hstep, voffA);
            PG8_WAIT_V(8); PG8_WAIT_L(0); PG8_BAR; PG8_MMA(0, 0, At, B0); PG8_MMA(0, 1, At, B1); PG8_BAR; PG8_SCHED;
            PG8_LDA(At, 0, 1); PG8_STAGE(PG8_SB(0, 0), b2, voffB); PG8_STAGE(PG8_SB(0, 1), b2 + hstep, voffB); PG8_STAGE(PG8_SA(0, 0), a2, voffA);
            PG8_WAIT_V(8); PG8_WAIT_L(0); PG8_BAR; PG8_MMA(1, 0, At, B0); PG8_MMA(1, 1, At, B1); PG8_BAR; PG8_SCHED;
            PG8_LDB(B0, 1, 0); PG8_LDB(B1, 1, 1); PG8_SCHED; PG8_LDA(At, 1, 0); PG8_STAGE(PG8_SA(0, 1), a2 + hstep, voffA);
            PG8_WAIT_V(8); PG8_WAIT_L(0); PG8_BAR; PG8_MMA(0, 0, At, B0); PG8_MMA(0, 1, At, B1); PG8_BAR; PG8_SCHED;
            PG8_LDA(At, 1, 1); PG8_STAGE(PG8_SB(1, 0), b3, voffB); PG8_STAGE(PG8_SB(1, 1), b3 + hstep, voffB); PG8_STAGE(PG8_SA(1, 0), a3, voffA);
            PG8_WAIT_V(8); PG8_WAIT_L(0); PG8_BAR; PG8_MMA(1, 0, At, B0); PG8_MMA(1, 1, At, B1); PG8_BAR; PG8_SCHED;
            } else {
            PG8_LDB(B0, 0, 0); PG8_SCHED; PG8_LDA(At, 0, 0); PG8_STAGE(PG8_SA(1, 1), a1 + hstep, voffA);
            PG8_WAIT_L(8); PG8_BAR; PG8_WAIT_L(0); PG8_MMA(0, 0, At, B0); PG8_BAR; PG8_SCHED;
            PG8_LDB(B1, 0, 1); PG8_STAGE(PG8_SB(0, 0), b2, voffB);
            PG8_BAR; PG8_WAIT_L(0); PG8_MMA(0, 1, At, B1); PG8_BAR;
            PG8_LDA(At, 0, 1); PG8_STAGE(PG8_SA(0, 0), a2, voffA);
            PG8_BAR; PG8_WAIT_L(0); PG8_MMA(1, 0, At, B0); PG8_BAR; PG8_SCHED;
            PG8_STAGE(PG8_SB(0, 1), b2 + hstep, voffB);
            PG8_WAIT_V(6); PG8_BAR; PG8_MMA(1, 1, At, B1); PG8_BAR;
            PG8_LDB(B0, 1, 0); PG8_SCHED; PG8_LDA(At, 1, 0); PG8_STAGE(PG8_SA(0, 1), a2 + hstep, voffA);
            PG8_WAIT_L(8); PG8_BAR; PG8_WAIT_L(0); PG8_MMA(0, 0, At, B0); PG8_BAR; PG8_SCHED;
            PG8_LDB(B1, 1, 1); PG8_STAGE(PG8_SB(1, 0), b3, voffB);
            PG8_BAR; PG8_WAIT_L(0); PG8_MMA(0, 1, At, B1); PG8_BAR;
            PG8_LDA(At, 1, 1); PG8_STAGE(PG8_SA(1, 0), a3, voffA);
            PG8_BAR; PG8_WAIT_L(0); PG8_MMA(1, 0, At, B0); PG8_BAR; PG8_SCHED;
            PG8_STAGE(PG8_SB(1, 1), b3 + hstep, voffB);
            PG8_WAIT_V(6); PG8_BAR; PG8_MMA(1, 1, At, B1); PG8_BAR;
            }
        }
        if constexpr (ALIGN_EPI) { if (wr == 0) PG8_BAR; }
        if constexpr (!Epi::AFTER_DRAIN) { E(acc, cur, wr, wc, fr, fq); S.done(cur); }
        if (!has_next) break;
#pragma unroll
        for (int a = 0; a < 2; ++a)
#pragma unroll
            for (int b = 0; b < 2; ++b)
#pragma unroll
                for (int m = 0; m < 4; ++m)
#pragma unroll
                    for (int n = 0; n < 2; ++n) acc[a][b][m][n] = (f32x4){0.f, 0.f, 0.f, 0.f};
        cur = nxt; cA = nA; cB = nB; ++ui;
        if constexpr (ALIGN_EPI) { if (wr == 1) PG8_BAR; }
    }
    PG8_WAIT_V(0);
    if constexpr (!ALIGN_EPI) { if (wr == 0) PG8_BAR; }
    PG8_BAR;
    if constexpr (Epi::AFTER_DRAIN) { E.fused(acc, cur, wr, wc, fr, fq, lds, wid, lane); S.done(cur); }
#undef PG8_SA
#undef PG8_SB
#undef PG8_STAGE
#undef PG8_LDA
#undef PG8_LDB
#undef PG8_MMA
#undef PG8_WAIT_V
#undef PG8_WAIT_L
#undef PG8_BAR
#undef PG8_SCHED
}
}

#define LAS __attribute__((address_space(3)))
typedef unsigned short bf16;
typedef unsigned v4u __attribute__((ext_vector_type(4)));
typedef unsigned v2u __attribute__((ext_vector_type(2)));
typedef float f32x4 __attribute__((ext_vector_type(4)));
typedef float f32x2 __attribute__((ext_vector_type(2)));
typedef short bf16x8 __attribute__((ext_vector_type(8)));
#define LDS_WAIT() asm volatile("s_waitcnt lgkmcnt(0)" ::: "memory")
#define MFMA16(a, b, c) __builtin_amdgcn_mfma_f32_16x16x32_bf16((a), (b), (c), 0, 0, 0)

constexpr int NWAVES = 8, NTHR = 512;
constexpr int NB = 2, S = 8192, T = NB * S, D = 1024;
constexpr int LDS_BYTES = 147456;
constexpr float LOG2E = 1.4426950408889634f;
constexpr int NIN = 4888, NIN_PAD = 5120;

constexpr size_t MiB = 1u << 20;
constexpr size_t WS_CTL = 0, CTL_BYTES = 256 * 1024;
constexpr size_t WS_MEMN = 1 * MiB, WS_WIN_T = 2 * MiB, WS_CKW1_T = 12 * MiB, WS_CVW1_T = 13 * MiB, WS_WA_T = 14 * MiB, WS_WB_T = 15 * MiB, WS_WOUT_T = 16 * MiB,
                 WS_WCQ_T = 18 * MiB, WS_WCKV_T = 19 * MiB, WS_WCO_T = 21 * MiB, WS_WPS_T = 22 * MiB;
constexpr size_t WS_KCMP = 26 * MiB, WS_VCMP_T = 26 * MiB + 256 * 1024, WS_KMEM = 27 * MiB, WS_VMEM_T = 27 * MiB + 512 * 1024, WS_GB = 28 * MiB;
constexpr size_t WS_U = 32 * MiB;
constexpr size_t WS_QA = 64 * MiB, WS_KA = 80 * MiB, WS_VAT = 96 * MiB, WS_QB = 112 * MiB;
constexpr size_t WS_PU = 152 * MiB, WS_PV = 168 * MiB;
constexpr size_t WS_MERGED = 64 * MiB;
constexpr size_t WS_SS1 = WS_CTL + 131072, WS_SS2 = WS_CTL + 196608;
constexpr size_t WS_KCI = 128 * MiB, WS_VCI = 132 * MiB, WS_KS = 136 * MiB, WS_VST = 140 * MiB, WS_KW = 144 * MiB, WS_VWT = 148 * MiB;
constexpr size_t WS_OA = 32 * MiB, WS_OB = 48 * MiB, WS_HIDP = 32 * MiB;
constexpr size_t WS_GA = 184 * MiB, WS_GBT = 216 * MiB;
constexpr size_t WS_H = 192 * MiB;
constexpr size_t WS_QC = 96 * MiB, WS_OC = 112 * MiB, WS_SCORES = 64 * MiB;
constexpr size_t WS_END = 256 * MiB;

__device__ __forceinline__ unsigned pk2(float lo, float hi) { return pg8::cvt_pk_bf16(lo, hi); }
typedef __bf16 bf16x2_t __attribute__((ext_vector_type(2)));
__device__ __forceinline__ unsigned pk2s(float lo, float hi) { typedef float f2_ __attribute__((ext_vector_type(2))); const f2_ v = {lo, hi}; const bf16x2_t b = __builtin_convertvector(v, bf16x2_t); return __builtin_bit_cast(unsigned, b); }
__device__ __forceinline__ unsigned short f2bf1(float f) { return (unsigned short)(pk2(f, 0.f) & 0xffffu); }
__device__ __forceinline__ float bflo(unsigned u) { return __builtin_bit_cast(float, u << 16); }
__device__ __forceinline__ float bfhi(unsigned u) { return __builtin_bit_cast(float, u & 0xffff0000u); }
__device__ __forceinline__ float wave_sum(float v) {
#pragma unroll
    for (int o = 1; o < 64; o <<= 1) v += __shfl_xor(v, o);
    return v;
}
__device__ __forceinline__ float sigm(float x) { return 1.f / (1.f + __expf(-x)); }
__device__ __forceinline__ float gelu_erf(float x) { return 0.5f * x * (1.f + erff(x * 0.70710678118654752f)); }
__device__ __forceinline__ float ex2(float x) { return __builtin_amdgcn_exp2f(x); }
__device__ __forceinline__ void store8bf(bf16* dst, const float* v) { v4u w; w.x = pk2(v[0], v[1]); w.y = pk2(v[2], v[3]); w.z = pk2(v[4], v[5]); w.w = pk2(v[6], v[7]); *(v4u*)dst = w; }
__device__ __forceinline__ bf16x8 ldg8(const bf16* p) { return *(const bf16x8*)p; }
__device__ __forceinline__ bf16x8 pack8(float a0, float a1, float a2, float a3, float a4, float a5, float a6, float a7) {
    v4u w; w.x = pk2s(a0, a1); w.y = pk2s(a2, a3); w.z = pk2s(a4, a5); w.w = pk2s(a6, a7); return __builtin_bit_cast(bf16x8, w);
}

struct Args { const float* in[25]; float* out; unsigned char* ws; int ph_lo, ph_hi; };

enum { EM_G1 = 0, EM_PART, EM_KVMEM, EM_MA, EM_MB, EM_H1, EM_QC, EM_H2, EM_SC };
struct EpiAll {
    int mode; unsigned char* ws; const float* x; const float* cmp_pos; float* part; const float* gn; mutable float carry;
    __device__ __forceinline__ void norm_side(const f32x4& h0, const f32x4& h1_, int row, int col, float* ss) const {
        const f32x4 g0 = *(const f32x4*)(gn + col), g1 = *(const f32x4*)(gn + col + 4);
        const float u[8] = {h0[0] * g0[0], h0[1] * g0[1], h0[2] * g0[2], h0[3] * g0[3], h1_[0] * g1[0], h1_[1] * g1[1], h1_[2] * g1[2], h1_[3] * g1[3]};
        store8bf((bf16*)(ws + WS_U) + (size_t)row * 1024 + col, u);
        float s_ = (h0[0] * h0[0] + h0[1] * h0[1]) + (h0[2] * h0[2] + h0[3] * h0[3]) + (h1_[0] * h1_[0] + h1_[1] * h1_[1]) + (h1_[2] * h1_[2] + h1_[3] * h1_[3]);
        if ((col & 128) == 0) { carry = s_; return; }
        s_ += carry;
        s_ += __shfl_xor(s_, 16); s_ += __shfl_xor(s_, 32);
        if ((threadIdx.x & 48) == 0) atomicAdd(ss + row, s_);
    }
    __device__ __forceinline__ void operator()(int row, int col, const f32x4& v0, const f32x4& v1) const {
        float v[8] = {v0[0], v0[1], v0[2], v0[3], v1[0], v1[1], v1[2], v1[3]};
        switch (mode) {
        case EM_G1: {
            if (col >= NIN) return;
            const int b = row >> 13, s = row & (S - 1);
            if (col < 1024) {
                const bool isq = col < 512; bf16* dst = (bf16*)(ws + (isq ? WS_QA : WS_KA)) + (size_t)row * 512 + (col & 511);
                const float sc = isq ? 0.125f * LOG2E : 1.f;
#pragma unroll
                for (int i = 0; i < 8; ++i) v[i] *= sc;
                store8bf(dst, v);
            } else if (col < 1536) {
                bf16* dst = (bf16*)(ws + WS_VAT) + (size_t)(b * 512 + (col - 1024)) * S + s;
#pragma unroll
                for (int i = 0; i < 8; ++i) dst[(size_t)i * S] = f2bf1(v[i]);
            } else if (col < 2048) {
#pragma unroll
                for (int i = 0; i < 8; ++i) v[i] *= 0.125f * LOG2E;
                store8bf((bf16*)(ws + WS_QB) + (size_t)row * 512 + (col - 1536), v);
            } else if (col < 2816) {
                const int c2 = col - 2048, j = c2 >> 7, gg = (c2 >> 6) & 1, d = c2 & 63; const size_t bg = (size_t)(b * 2 + gg);
                if (j == 0 || j == 1) {
                    const float* cp = cmp_pos + (s & 31) * 64 + d;
#pragma unroll
                    for (int i = 0; i < 8; ++i) v[i] += cp[i];
                    store8bf((bf16*)(ws + (j == 0 ? WS_KCI : WS_VCI)) + (bg * S + s) * 64 + d, v);
                } else if (j == 2 || j == 4) {
                    store8bf((bf16*)(ws + (j == 2 ? WS_KS : WS_KW)) + (bg * S + s) * 64 + d, v);
                } else {
                    bf16* dst = (bf16*)(ws + (j == 3 ? WS_VST : WS_VWT)) + (bg * 64 + d) * S + s;
#pragma unroll
                    for (int i = 0; i < 8; ++i) dst[(size_t)i * S] = f2bf1(v[i]);
                }
            } else if (col < 2840) {
                float* dst = (float*)(ws + WS_GB) + (size_t)row * 24 + (col - 2816);
                *(f32x4*)dst = (f32x4){sigm(v[0]), sigm(v[1]), sigm(v[2]), sigm(v[3])}; *(f32x4*)(dst + 4) = (f32x4){sigm(v[4]), sigm(v[5]), sigm(v[6]), sigm(v[7])};
            } else {
                const bool ia = col < 3864; bf16* dst = (bf16*)(ws + (ia ? WS_GA : WS_GBT)) + (size_t)row * 1024 + (col - (ia ? 2840 : 3864));
#pragma unroll
                for (int i = 0; i < 8; ++i) v[i] = sigm(v[i]);
                store8bf(dst, v);
            }
        } break;
        case EM_PART: { float* dst = part + (size_t)row * 256 + col; *(f32x4*)dst = v0; *(f32x4*)(dst + 4) = v1; } break;
        case EM_KVMEM: {
            const int b = row >> 8, m = row & 255, c2 = col & 511, h = c2 >> 7, d = c2 & 127;
            if (col < 512) store8bf((bf16*)(ws + WS_KMEM) + ((size_t)((b * 4 + h) * 256 + m)) * 128 + d, v);
            else { bf16* dst = (bf16*)(ws + WS_VMEM_T) + ((size_t)((b * 4 + h) * 128 + d)) * 256 + m;
#pragma unroll
                for (int i = 0; i < 8; ++i) dst[i * 256] = f2bf1(v[i]); }
        } break;
        case EM_MA: {
            const v4u gq = *(const v4u*)((const bf16*)(ws + WS_GA) + (size_t)row * 1024 + col);
            const float g[8] = {bflo(gq.x), bfhi(gq.x), bflo(gq.y), bfhi(gq.y), bflo(gq.z), bfhi(gq.z), bflo(gq.w), bfhi(gq.w)};
#pragma unroll
            for (int i = 0; i < 8; ++i) v[i] *= g[i];
            store8bf((bf16*)(ws + WS_MERGED) + (size_t)row * 1024 + col, v);
        } break;
        case EM_MB: {
            const v4u gq = *(const v4u*)((const bf16*)(ws + WS_GBT) + (size_t)row * 1024 + col);
            bf16* mp = (bf16*)(ws + WS_MERGED) + (size_t)row * 1024 + col; const v4u mq = *(const v4u*)mp;
            const float g[8] = {bflo(gq.x), bfhi(gq.x), bflo(gq.y), bfhi(gq.y), bflo(gq.z), bfhi(gq.z), bflo(gq.w), bfhi(gq.w)};
            const float mm[8] = {bflo(mq.x), bfhi(mq.x), bflo(mq.y), bfhi(mq.y), bflo(mq.z), bfhi(mq.z), bflo(mq.w), bfhi(mq.w)};
#pragma unroll
            for (int i = 0; i < 8; ++i) v[i] = mm[i] + g[i] * v[i];
            store8bf(mp, v);
        } break;
        case EM_H1: {
            const float* xp = x + (size_t)row * 1024 + col; float* hp = (float*)(ws + WS_H) + (size_t)row * 1024 + col;
            const f32x4 x0 = *(const f32x4*)xp, x1 = *(const f32x4*)(xp + 4);
            const f32x4 h0 = x0 + v0, h1_ = x1 + v1;
            *(f32x4*)hp = h0; *(f32x4*)(hp + 4) = h1_;
            norm_side(h0, h1_, row, col, (float*)(ws + WS_SS1));
        } break;
        case EM_QC: {
            const float rs_ = rsqrtf(__hip_atomic_load((const float*)(ws + WS_SS1) + row, __ATOMIC_RELAXED, __HIP_MEMORY_SCOPE_AGENT) * (1.f / 1024.f) + 1e-6f) * 0.08838834764831845f;
#pragma unroll
            for (int i = 0; i < 8; ++i) v[i] *= rs_;
            store8bf((bf16*)(ws + WS_QC) + (size_t)row * 512 + col, v);
        } break;
        case EM_H2: {
            float* hp = (float*)(ws + WS_H) + (size_t)row * 1024 + col;
            const f32x4 x0 = *(const f32x4*)hp, x1 = *(const f32x4*)(hp + 4);
            const f32x4 h0 = x0 + v0, h1_ = x1 + v1;
            *(f32x4*)hp = h0; *(f32x4*)(hp + 4) = h1_;
            norm_side(h0, h1_, row, col, (float*)(ws + WS_SS2));
        } break;
        default: {
            const float rs_ = rsqrtf(__hip_atomic_load((const float*)(ws + WS_SS2) + row, __ATOMIC_RELAXED, __HIP_MEMORY_SCOPE_AGENT) * (1.f / 1024.f) + 1e-6f);
#pragma unroll
            for (int i = 0; i < 8; ++i) v[i] *= rs_;
            store8bf((bf16*)(ws + WS_SCORES) + (size_t)row * 2048 + col, v);
        } break;
        }
    }
};
typedef pg8::EpiF<EpiAll> EpiT;

__device__ __forceinline__ void run_gemm(LAS unsigned char* lds, const bf16* A, const bf16* Bt, int M, int N, int K, int ld, int G, int c, const EpiAll& ea) {
    pg8::Gemm g{A, Bt, M, N, K, ld}; pg8::StaticOrder So; So.init(M, N, G, c);
    EpiT E{ea};
    pg8::gemm_phase<EpiT, pg8::StaticOrder, true, true>(lds, g, So, E);
}

__device__ __forceinline__ void transpose_item(const float* W, int K, int Nsrc, int nblk, bf16* WT, LAS float* scr, int item, int lane) {
    const int kb = item / nblk, nb = item % nblk, k0 = 64 * kb, n0 = 32 * nb; const int nq = n0 + 4 * (lane & 7);
#pragma unroll
    for (int i = 0; i < 8; ++i) { const int kk = 8 * i + (lane >> 3);
        const f32x4 v = (nq < Nsrc) ? *(const f32x4*)(W + (size_t)(k0 + kk) * Nsrc + nq) : (f32x4){0.f, 0.f, 0.f, 0.f};
        LAS float* d = scr + kk * 33 + 4 * (lane & 7); d[0] = v.x; d[1] = v.y; d[2] = v.z; d[3] = v.w; }
    LDS_WAIT();
    const int c = lane & 7;
#pragma unroll
    for (int j = 0; j < 4; ++j) { const int nn = (lane >> 3) + 8 * j; const LAS float* s = scr + (8 * c) * 33 + nn;
        v4u o; o.x = pk2(s[0 * 33], s[1 * 33]); o.y = pk2(s[2 * 33], s[3 * 33]); o.z = pk2(s[4 * 33], s[5 * 33]); o.w = pk2(s[6 * 33], s[7 * 33]);
        *(v4u*)(WT + (size_t)(n0 + nn) * K + k0 + 8 * c) = o; }
    LDS_WAIT();
}
__device__ __forceinline__ void rms_row_to_bf16(const float* xrow, const float* g, bf16* orow, int lane) {
    const f32x4* xr = (const f32x4*)xrow + lane; const f32x4* gr = (const f32x4*)g + lane;
    f32x4 v[4]; float s = 0.f;
#pragma unroll
    for (int j = 0; j < 4; ++j) { v[j] = xr[64 * j]; s += (v[j].x * v[j].x + v[j].y * v[j].y) + (v[j].z * v[j].z + v[j].w * v[j].w); }
    const float rstd = rsqrtf(wave_sum(s) * (1.f / D) + 1e-6f);
    v2u* o8 = (v2u*)orow + lane;
#pragma unroll
    for (int j = 0; j < 4; ++j) { const f32x4 gg = gr[64 * j]; v2u w; w.x = pk2(v[j].x * rstd * gg.x, v[j].y * rstd * gg.y); w.y = pk2(v[j].z * rstd * gg.z, v[j].w * rstd * gg.w); o8[64 * j] = w; }
}


__device__ __forceinline__ int kswz(int row, int c) { const int F = (0x1320 >> (((row >> 3) & 3) * 4)) & 3; return row * 128 + ((c ^ (F | (((row >> 1) & 1) << 2))) << 4); }
__device__ __forceinline__ int vswz(int row, int c) { const int F = (0x1320 >> (((row >> 2) & 3) * 4)) & 3; return row * 64 + ((c ^ F) << 4); }
__device__ __forceinline__ void diff_wg_item(unsigned char* ws, const float* lamp, const float* subln, int bh, int qb, LAS unsigned char* lds, int tid, int wave, int lane) {
    const int b = bh >> 2, h = bh & 3, fr = lane & 15, fq = lane >> 4, wv = wave & 3, cm = wave >> 2;
    const int q0 = qb * 128 + wv * 32, lastkb = qb * 4 + wv, nsteps = qb * 4 + 4;
    float lam;
    { const float a = lamp[lane] * lamp[64 + lane], c = lamp[128 + lane] * lamp[192 + lane]; lam = __expf(wave_sum(a)) - __expf(wave_sum(c)) + 0.2f; }
    const float slope2 = ex2(-2.f * (float)(h + 1)) * LOG2E;
    const bf16* Qb = (const bf16*)(ws + WS_QA) + (size_t)(b * S) * 512 + h * 128;
    const bf16* Kb = (const bf16*)(ws + WS_KA) + (size_t)(b * S) * 512 + h * 128;
    const bf16* Vb = (const bf16*)(ws + WS_VAT) + (size_t)((b * 4 + h) * 128) * S;
    const int kr0 = 8 * (fr >> 2) + (fr & 3);
    const bf16* gA = Kb + (size_t)((tid & 255) >> 3) * 512 + (tid >> 8) * 64 + (tid & 7) * 8;
    const int lA = (tid >> 8) * 4096 + kswz((tid & 255) >> 3, tid & 7);
    const bf16* gB = Vb + (size_t)(tid >> 2) * S + (tid & 3) * 8;
    const int lB = 8192 + vswz(tid >> 2, tid & 3);
    bf16x8 Qf[2][2];
#pragma unroll
    for (int nt = 0; nt < 2; ++nt)
#pragma unroll
        for (int ks = 0; ks < 2; ++ks) Qf[nt][ks] = ldg8(Qb + (size_t)(q0 + nt * 16 + fr) * 512 + cm * 64 + ks * 32 + fq * 8);
    f32x4 O[8][2];
#pragma unroll
    for (int mt = 0; mt < 8; ++mt) { O[mt][0] = (f32x4){0.f, 0.f, 0.f, 0.f}; O[mt][1] = (f32x4){0.f, 0.f, 0.f, 0.f}; }
    float moff[2] = {0.f, 0.f}; f32x4 Lacc[2] = {(f32x4){0.f, 0.f, 0.f, 0.f}, (f32x4){0.f, 0.f, 0.f, 0.f}};
    const bf16x8 ones8 = {(short)0x3f80, (short)0x3f80, (short)0x3f80, (short)0x3f80, (short)0x3f80, (short)0x3f80, (short)0x3f80, (short)0x3f80};
    int koff[2][2];
#pragma unroll
    for (int t = 0; t < 2; ++t)
#pragma unroll
        for (int ks = 0; ks < 2; ++ks) koff[t][ks] = cm * 4096 + kswz(kr0 + 4 * t, ks * 4 + fq);
    const int voff = 8192 + vswz(fr, fq);
    float cst[8];
#pragma unroll
    for (int i = 0; i < 8; ++i) cst[i] = slope2 * (float)i;
    __builtin_amdgcn_s_waitcnt(0x0F70);
    const int nbs = nsteps >> 1;
    v4u ra0[2], rb0[2], ra1[2], rb1[2];
#pragma unroll
    for (int h = 0; h < 2; ++h) { const v4u a0 = *(const v4u*)(gA + (size_t)h * 32 * 512), b0 = *(const v4u*)(gB + h * 32); *(LAS v4u*)(lds + h * 16384 + lA) = a0; *(LAS v4u*)(lds + h * 16384 + lB) = b0; }
#pragma unroll
    for (int h = 0; h < 2; ++h) { ra1[h] = *(const v4u*)(gA + (size_t)(2 + h) * 32 * 512); rb1[h] = *(const v4u*)(gB + (2 + h) * 32); }
#pragma unroll
    for (int h = 0; h < 2; ++h) { const int kl = (2 < nbs) ? 4 + h : 2 + h; ra0[h] = *(const v4u*)(gA + (size_t)kl * 32 * 512); rb0[h] = *(const v4u*)(gB + kl * 32); }
    asm volatile("s_waitcnt lgkmcnt(0)\n\ts_barrier" ::: "memory");
#define DIFF_STEP(KK, CURB, NXTB, RA, RB) do { \
      _Pragma("unroll") for (int hh = 0; hh < 2; ++hh) { const int kb = 2 * (KK) + hh; const int cur = (CURB) + hh * 16384; \
        if (kb <= lastkb) { \
            __builtin_amdgcn_s_setprio(1); \
            bf16x8 Kc[2][2]; \
            _Pragma("unroll") for (int t = 0; t < 2; ++t) _Pragma("unroll") for (int ks = 0; ks < 2; ++ks) Kc[t][ks] = *(const LAS bf16x8*)(lds + cur + koff[t][ks]); \
            bf16x8 Vf[8]; \
            _Pragma("unroll") for (int mt = 0; mt < 8; ++mt) Vf[mt] = *(const LAS bf16x8*)(lds + cur + voff + mt * 1024); \
            const float kb0 = slope2 * (float)(kb * 32 + fq * 8); \
            f32x4 Sx[2][2]; \
            __builtin_amdgcn_s_setprio(1); \
            _Pragma("unroll") for (int nt = 0; nt < 2; ++nt) { const float base = kb0 - moff[nt]; \
                _Pragma("unroll") for (int t = 0; t < 2; ++t) { f32x4 z = {base + cst[4 * t], base + cst[4 * t + 1], base + cst[4 * t + 2], base + cst[4 * t + 3]}; \
                    z = MFMA16(Kc[t][0], Qf[nt][0], z); Sx[t][nt] = MFMA16(Kc[t][1], Qf[nt][1], z); } } \
            __builtin_amdgcn_s_setprio(0); \
            const bool diag = (kb == lastkb); \
            bf16x8 Pf[2]; \
            _Pragma("unroll") for (int nt = 0; nt < 2; ++nt) { \
                float sv[8] = {Sx[0][nt][0], Sx[0][nt][1], Sx[0][nt][2], Sx[0][nt][3], Sx[1][nt][0], Sx[1][nt][1], Sx[1][nt][2], Sx[1][nt][3]}; \
                if (diag) { const int dq = q0 + nt * 16 + fr - (kb * 32 + fq * 8); \
                    _Pragma("unroll") for (int i = 0; i < 8; ++i) sv[i] = (i <= dq) ? sv[i] : -1e30f; } \
                float mx = fmaxf(fmaxf(fmaxf(fmaxf(sv[0], sv[1]), sv[2]), fmaxf(fmaxf(sv[3], sv[4]), sv[5])), fmaxf(sv[6], sv[7])); \
                mx = fmaxf(mx, __shfl_xor(mx, 16)); mx = fmaxf(mx, __shfl_xor(mx, 32)); \
                if (__ballot(mx > 64.f) != 0ull) { \
                    const float dl = fmaxf(mx, 0.f), alpha = ex2(-dl); moff[nt] += dl; Lacc[nt] *= alpha; \
                    _Pragma("unroll") for (int mt = 0; mt < 8; ++mt) O[mt][nt] *= alpha; \
                    _Pragma("unroll") for (int i = 0; i < 8; ++i) sv[i] -= dl; \
                } \
                _Pragma("unroll") for (int i = 0; i < 8; ++i) sv[i] = ex2(sv[i]); \
                Pf[nt] = pack8(sv[0], sv[1], sv[2], sv[3], sv[4], sv[5], sv[6], sv[7]); \
                __builtin_amdgcn_s_setprio(1); \
                _Pragma("unroll") for (int mt = 0; mt < 8; ++mt) O[mt][nt] = MFMA16(Vf[mt], Pf[nt], O[mt][nt]); \
                Lacc[nt] = MFMA16(ones8, Pf[nt], Lacc[nt]); \
                __builtin_amdgcn_s_setprio(0); \
            } \
        } \
      } \
      _Pragma("unroll") for (int hh = 0; hh < 2; ++hh) { *(LAS v4u*)(lds + (NXTB) + hh * 16384 + lA) = RA[hh]; *(LAS v4u*)(lds + (NXTB) + hh * 16384 + lB) = RB[hh]; } \
      { const int kn = ((KK) + 3 < nbs) ? (KK) + 3 : nbs - 1; \
        _Pragma("unroll") for (int hh = 0; hh < 2; ++hh) { RA[hh] = *(const v4u*)(gA + (size_t)(2 * kn + hh) * 32 * 512); RB[hh] = *(const v4u*)(gB + (2 * kn + hh) * 32); } } \
      asm volatile("s_waitcnt lgkmcnt(0)\n\ts_barrier" ::: "memory"); } while (0)
    for (int kk = 0; kk < nbs; kk += 2) {
        DIFF_STEP(kk, 0, 32768, ra1, rb1);
        DIFF_STEP(kk + 1, 32768, 0, ra0, rb0);
    }
#undef DIFF_STEP
    float inv[2];
#pragma unroll
    for (int nt = 0; nt < 2; ++nt) inv[nt] = 1.f / Lacc[nt][0];
    LAS float* park = (LAS float*)(lds + 65536 + wv * 16384);
    if (cm == 1) {
#pragma unroll
        for (int mt = 0; mt < 8; ++mt)
#pragma unroll
            for (int nt = 0; nt < 2; ++nt)
#pragma unroll
                for (int r = 0; r < 4; ++r) park[((mt * 2 + nt) * 4 + r) * 64 + lane] = O[mt][nt][r] * inv[nt];
    }
    __syncthreads();
    if (cm == 0) {
        float ss[2] = {0.f, 0.f};
#pragma unroll
        for (int mt = 0; mt < 8; ++mt)
#pragma unroll
            for (int nt = 0; nt < 2; ++nt)
#pragma unroll
                for (int r = 0; r < 4; ++r) { const float v_ = O[mt][nt][r] * inv[nt] - lam * park[((mt * 2 + nt) * 4 + r) * 64 + lane]; O[mt][nt][r] = v_; ss[nt] += v_ * v_; }
#pragma unroll
        for (int nt = 0; nt < 2; ++nt) {
            float s_ = ss[nt]; s_ += __shfl_xor(s_, 16); s_ += __shfl_xor(s_, 32);
            const float rstd = rsqrtf(s_ * (1.f / 128.f) + 1e-6f) * 0.8f;
            bf16* op = (bf16*)(ws + WS_OA) + (size_t)(b * S + q0 + nt * 16 + fr) * 512 + h * 128 + fq * 4;
#pragma unroll
            for (int mt = 0; mt < 8; ++mt) { const f32x4 gg = *(const f32x4*)(subln + mt * 16 + fq * 4);
                v2u w; w.x = pk2(O[mt][nt][0] * rstd * gg.x, O[mt][nt][1] * rstd * gg.y); w.y = pk2(O[mt][nt][2] * rstd * gg.z, O[mt][nt][3] * rstd * gg.w);
                *(v2u*)(op + mt * 16) = w; }
        }
    }
    __syncthreads();
}

__device__ __forceinline__ void sort8_desc(unsigned (&k)[8]) {
#define CE_(i, j) do { const unsigned hi_ = k[i] > k[j] ? k[i] : k[j], lo_ = k[i] > k[j] ? k[j] : k[i]; k[i] = hi_; k[j] = lo_; } while (0)
    CE_(0, 1); CE_(2, 3); CE_(4, 5); CE_(6, 7); CE_(0, 2); CE_(1, 3); CE_(4, 6); CE_(5, 7); CE_(1, 2); CE_(5, 6);
    CE_(0, 4); CE_(1, 5); CE_(2, 6); CE_(3, 7); CE_(2, 4); CE_(3, 5); CE_(1, 2); CE_(3, 4); CE_(5, 6);
#undef CE_
}
struct NsaFr { bf16x8 Ka[2][2]; bf16x8 Vf[4]; };
template <int MODE>
__device__ __forceinline__ void nsa_compute(const NsaFr& F, int kbase, const bf16x8 (&Qf)[2], int qpos, float slope2, bool blkok, bool interior, int fq, float& moff, f32x4& Lacc, f32x4 (&O)[4]) {
    const float base = slope2 * (float)(kbase + fq * 8) - moff;
    f32x4 Sx[2];
    __builtin_amdgcn_s_setprio(1);
#pragma unroll
    for (int t = 0; t < 2; ++t) { f32x4 z = {base + slope2 * (float)(4 * t), base + slope2 * (float)(4 * t + 1), base + slope2 * (float)(4 * t + 2), base + slope2 * (float)(4 * t + 3)};
        z = MFMA16(F.Ka[t][0], Qf[0], z); Sx[t] = MFMA16(F.Ka[t][1], Qf[1], z); }
    __builtin_amdgcn_s_setprio(0);
    float sv[8];
    if (interior) {
#pragma unroll
        for (int t = 0; t < 2; ++t)
#pragma unroll
            for (int r = 0; r < 4; ++r) sv[t * 4 + r] = blkok ? Sx[t][r] : -1e30f;
    } else {
        const int kd0 = kbase + fq * 8 - qpos;
#pragma unroll
        for (int t = 0; t < 2; ++t)
#pragma unroll
            for (int r = 0; r < 4; ++r) { const int kd = kd0 + 4 * t + r; const bool ok = (MODE == 0) ? (blkok && kd <= 0) : (blkok && kd <= 0 && kd > -512);
                sv[t * 4 + r] = ok ? Sx[t][r] : -1e30f; }
    }
    float mx = fmaxf(fmaxf(fmaxf(fmaxf(sv[0], sv[1]), sv[2]), fmaxf(fmaxf(sv[3], sv[4]), sv[5])), fmaxf(sv[6], sv[7]));
    mx = fmaxf(mx, __shfl_xor(mx, 16)); mx = fmaxf(mx, __shfl_xor(mx, 32));
    if (__ballot(mx > 64.f) != 0ull) {
        const float dl = fmaxf(mx, 0.f), alpha = ex2(-dl); moff += dl; Lacc *= alpha;
#pragma unroll
        for (int mt = 0; mt < 4; ++mt) O[mt] *= alpha;
#pragma unroll
        for (int i = 0; i < 8; ++i) sv[i] -= dl;
    }
#pragma unroll
    for (int i = 0; i < 8; ++i) sv[i] = ex2(sv[i]);
    const bf16x8 Pf = pack8(sv[0], sv[1], sv[2], sv[3], sv[4], sv[5], sv[6], sv[7]);
    const bf16x8 ones8 = {(short)0x3f80, (short)0x3f80, (short)0x3f80, (short)0x3f80, (short)0x3f80, (short)0x3f80, (short)0x3f80, (short)0x3f80};
    __builtin_amdgcn_s_setprio(1);
#pragma unroll
    for (int mt = 0; mt < 4; ++mt) O[mt] = MFMA16(F.Vf[mt], Pf, O[mt]);
    Lacc = MFMA16(ones8, Pf, Lacc);
    __builtin_amdgcn_s_setprio(0);
}


__device__ __forceinline__ void cmp_scores_l(LAS unsigned char* lds, int kimg, int u, const bf16x8 (&Qf)[2], int qpos, int nv, float slope2, int fq, int kr0, float (&sv)[8]) {
#pragma unroll
    for (int t = 0; t < 2; ++t) {
        f32x4 z = {0.f, 0.f, 0.f, 0.f};
        z = MFMA16(*(const LAS bf16x8*)(lds + kimg + u * 4096 + kswz(kr0 + 4 * t, fq)), Qf[0], z);
        z = MFMA16(*(const LAS bf16x8*)(lds + kimg + u * 4096 + kswz(kr0 + 4 * t, 4 + fq)), Qf[1], z);
#pragma unroll
        for (int rr = 0; rr < 4; ++rr) { const int cidx = 32 * u + 8 * fq + 4 * t + rr; const float dist = (float)(qpos - (cidx * 32 + 31));
            sv[t * 4 + rr] = (cidx < nv) ? (z[rr] - slope2 * dist) : -1e30f; }
    }
}

__device__ __forceinline__ void nsa_wg_item(unsigned char* ws, int bg, int it32, LAS unsigned char* lds, int tid, int wave, int lane) {
    LAS float* wl = (LAS float*)(lds + 20480 + wave * 2048);
#ifdef LEAK_LO
    if (blockIdx.x == 0 && tid == 0) ((unsigned long long*)(ws + WS_CTL + 65536))[25] = __builtin_amdgcn_s_memrealtime();
#endif
    const int b = bg >> 1, g = bg & 1, fr = lane & 15, fq = lane >> 4, i = fr >> 2, r = fr & 3, s0g = it32 * 32, s0 = s0g + wave * 4, qpos = s0 + i;
    const int kr0 = 8 * (fr >> 2) + (fr & 3);
    const float slope2 = ex2(-(float)(g * 4 + r + 1)) * LOG2E;
    bf16x8 Qf[2];
    { const bf16* qp = (const bf16*)(ws + WS_QB) + (size_t)(b * S + qpos) * 512 + (g * 4 + r) * 64 + fq * 8; Qf[0] = ldg8(qp); Qf[1] = ldg8(qp + 32); }
    const float* gp = (const float*)(ws + WS_GB) + (size_t)(b * S + qpos) * 24 + g * 12 + r * 3;
    const float g0 = gp[0], g1 = gp[1], g2 = gp[2];
    __builtin_amdgcn_s_waitcnt(0x0F70);
    f32x4 Oacc[4];
#pragma unroll
    for (int mt = 0; mt < 4; ++mt) Oacc[mt] = (f32x4){0.f, 0.f, 0.f, 0.f};
#pragma unroll
    for (int e = 0; e < 8; ++e) wl[e * 64 + lane] = 0.f;
    const int nv = (qpos + 1) >> 5, nvmax = (s0 + 4) >> 5;
    if (nvmax > 0) {
        const bf16* Kc = (const bf16*)(ws + WS_KCMP) + (size_t)(bg * 256) * 64;
        const bf16* Vc = (const bf16*)(ws + WS_VCMP_T) + (size_t)(bg * 64) * 256;
        const int nu = (nvmax + 31) >> 5;
        float mloc = -1e30f, lloc = 0.f;
#pragma unroll 1
        for (int u = 0; u < nu; ++u) {
            float sv[8]; cmp_scores_l(lds, 40960, u, Qf, qpos, nv, slope2, fq, kr0, sv);
            float mx = mloc;
#pragma unroll
            for (int e = 0; e < 8; ++e) mx = fmaxf(mx, sv[e]);
            float ps = 0.f;
#pragma unroll
            for (int e = 0; e < 8; ++e) ps += (sv[e] > -1e29f) ? ex2(sv[e] - mx) : 0.f;
            lloc = lloc * ex2(mloc - mx) + ps; mloc = mx;
        }
        float mx = fmaxf(mloc, __shfl_xor(mloc, 16)); mx = fmaxf(mx, __shfl_xor(mx, 32));
        float ls = lloc * ex2(mloc - mx); ls += __shfl_xor(ls, 16); ls += __shfl_xor(ls, 32);
        const float inv = (ls > 0.f) ? 1.f / ls : 0.f;
        f32x4 Oc[4];
#pragma unroll
        for (int mt = 0; mt < 4; ++mt) Oc[mt] = (f32x4){0.f, 0.f, 0.f, 0.f};
#pragma unroll 1
        for (int u = 0; u < nu; ++u) {
            float sv[8]; cmp_scores_l(lds, 40960, u, Qf, qpos, nv, slope2, fq, kr0, sv);
#pragma unroll
            for (int e = 0; e < 8; ++e) sv[e] = (sv[e] > -1e29f) ? ex2(sv[e] - mx) * inv : 0.f;
#pragma unroll
            for (int t = 0; t < 2; ++t) {
                float e0 = sv[t * 4 + 0] + sv[t * 4 + 1], e1 = sv[t * 4 + 2] + sv[t * 4 + 3];
                e0 += __shfl_xor(e0, 1); e0 += __shfl_xor(e0, 2); e1 += __shfl_xor(e1, 1); e1 += __shfl_xor(e1, 2);
                if (r == 0) { const int j = 16 * u + 4 * fq + 2 * t; wl[i * 128 + j] = e0; wl[i * 128 + j + 1] = e1; }
            }
            const bf16x8 Pf = pack8(sv[0], sv[1], sv[2], sv[3], sv[4], sv[5], sv[6], sv[7]);
#pragma unroll
            for (int mt = 0; mt < 4; ++mt) Oc[mt] = MFMA16(*(const LAS bf16x8*)(lds + 73728 + u * 4096 + vswz(fr, fq) + mt * 1024), Pf, Oc[mt]);
        }
#pragma unroll
        for (int mt = 0; mt < 4; ++mt) Oacc[mt] = Oc[mt] * g0;
    }
    LDS_WAIT();
    unsigned msk[4] = {0u, 0u, 0u, 0u};
    {
        const int q16 = r + 4 * fq, cur = qpos >> 6;
        unsigned kq[8];
#pragma unroll
        for (int e = 0; e < 8; ++e) { const int j = q16 + 16 * e; const bool forced = (j == 0) || (j == cur) || (j == cur - 1);
            const unsigned pb = __builtin_bit_cast(unsigned, wl[i * 128 + j]) | 0x80000000u;
            const unsigned cls = forced ? 0xffffff80u : ((j <= cur) ? (pb & 0xffffff80u) : 0u);
            kq[e] = cls | (unsigned)(127 - j); }
        sort8_desc(kq);
#pragma unroll 1
        for (int round = 0; round < 16; ++round) {
            const unsigned head = kq[0]; unsigned m = head, o_;
            o_ = (unsigned)__builtin_amdgcn_update_dpp(0, (int)m, 0xB1, 0xf, 0xf, false); m = o_ > m ? o_ : m;
            o_ = (unsigned)__builtin_amdgcn_update_dpp(0, (int)m, 0x4E, 0xf, 0xf, false); m = o_ > m ? o_ : m;
            { const auto r_ = __builtin_amdgcn_permlane16_swap(m, m, false, false); const unsigned a_ = (unsigned)r_[0], b_ = (unsigned)r_[1]; m = a_ > b_ ? a_ : b_; }
            { const auto r_ = __builtin_amdgcn_permlane32_swap(m, m, false, false); const unsigned a_ = (unsigned)r_[0], b_ = (unsigned)r_[1]; m = a_ > b_ ? a_ : b_; }
            const int bj = 127 - (int)(m & 0x7fu);
            const unsigned bit = 1u << (bj & 31); const int w = bj >> 5;
            msk[0] |= (w == 0) ? bit : 0u; msk[1] |= (w == 1) ? bit : 0u; msk[2] |= (w == 2) ? bit : 0u; msk[3] |= (w == 3) ? bit : 0u;
            const bool win = (head == m);
#pragma unroll
            for (int e = 0; e < 7; ++e) kq[e] = win ? kq[e + 1] : kq[e];
            kq[7] = win ? 0u : kq[7];
        }
    }
#ifdef LEAK_LO
    if (blockIdx.x == 0 && tid == 0) ((unsigned long long*)(ws + WS_CTL + 65536))[23] = __builtin_amdgcn_s_memrealtime();
#endif
    unsigned unw[4];
    { const int curmax = (s0 + 3) >> 6;
#pragma unroll
      for (int w = 0; w < 4; ++w) {
          unsigned u_ = msk[w]; u_ |= __shfl_xor(u_, 4); u_ |= __shfl_xor(u_, 8);
          const unsigned uu = (unsigned)__builtin_amdgcn_readfirstlane((int)u_);
          const int hi = curmax - 32 * w;
          const unsigned vm = (hi < 0) ? 0u : (hi >= 31 ? 0xffffffffu : ((2u << hi) - 1u));
          unw[w] = uu & vm; } }
    LAS unsigned* UM = (LAS unsigned*)(lds + 18432);
    LAS int* list = (LAS int*)(lds + 16384);
    if (lane == 0) { UM[wave * 4 + 0] = unw[0]; UM[wave * 4 + 1] = unw[1]; UM[wave * 4 + 2] = unw[2]; UM[wave * 4 + 3] = unw[3]; }
    asm volatile("s_waitcnt lgkmcnt(0)\n\ts_barrier" ::: "memory");
    int cnt = 0;
#pragma unroll
    for (int w = 0; w < 4; ++w) {
        unsigned o_ = 0u;
#pragma unroll
        for (int v = 0; v < 8; ++v) o_ |= UM[v * 4 + w];
        unsigned uu = (unsigned)__builtin_amdgcn_readfirstlane((int)o_);
        while (uu) { const int jb = __builtin_ctz(uu); uu &= uu - 1u; const int kbase = (32 * w + jb) * 64;
            if (tid == 0) { list[cnt] = kbase; list[cnt + 1] = kbase + 32; } cnt += 2; }
    }
    { const int kst = (s0g - 511 > 0) ? (s0g - 511) : 0; const int k0_ = kst >> 5, k1_ = (s0g + 31) >> 5;
      for (int k32 = k0_; k32 <= k1_; ++k32) { if (tid == 0) list[cnt] = (k32 * 32) | (1 << 30); ++cnt; }
      if (cnt & 1) { if (tid == 0) list[cnt] = (k1_ * 32) | (1 << 30) | (1 << 29); ++cnt; } }
    asm volatile("s_waitcnt lgkmcnt(0)\n\ts_barrier" ::: "memory");
    {
        const bf16* KSb = (const bf16*)(ws + WS_KS) + (size_t)(bg * S) * 64; const bf16* VSb = (const bf16*)(ws + WS_VST) + (size_t)(bg * 64) * S;
        const bf16* KWb = (const bf16*)(ws + WS_KW) + (size_t)(bg * S) * 64; const bf16* VWb = (const bf16*)(ws + WS_VWT) + (size_t)(bg * 64) * S;
        const bool isK = tid < 256;
        const int srow = isK ? (tid >> 3) : ((tid - 256) >> 2), scq = isK ? (tid & 7) : (tid & 3);
        const int loff = isK ? kswz(srow, scq) : 4096 + vswz(srow, scq);
#define NSA_GADDR(ENT) (isK ? ((((ENT) >> 30) & 1) ? KWb : KSb) + (size_t)(((ENT) & 0xfffff) + srow) * 64 + scq * 8 : ((((ENT) >> 30) & 1) ? VWb : VSb) + (size_t)srow * S + ((ENT) & 0xfffff) + scq * 8)
        int koff[2][2];
#pragma unroll
        for (int t = 0; t < 2; ++t)
#pragma unroll
            for (int ks = 0; ks < 2; ++ks) koff[t][ks] = kswz(kr0 + 4 * t, ks * 4 + fq);
        const int voff = 4096 + vswz(fr, fq);
        float mS = 0.f, mW = 0.f; f32x4 lS = {0.f, 0.f, 0.f, 0.f}, lW = {0.f, 0.f, 0.f, 0.f}; f32x4 OS[4], OW[4];
#pragma unroll
        for (int mt = 0; mt < 4; ++mt) { OS[mt] = (f32x4){0.f, 0.f, 0.f, 0.f}; OW[mt] = (f32x4){0.f, 0.f, 0.f, 0.f}; }
        v4u rs0, rs1;
        { const int e0 = __builtin_amdgcn_readfirstlane(list[0]); const v4u v0 = *(const v4u*)NSA_GADDR(e0); *(LAS v4u*)(lds + loff) = v0; }
        { const int e1 = __builtin_amdgcn_readfirstlane(list[1]); rs1 = *(const v4u*)NSA_GADDR(e1); }
        { const int e2 = __builtin_amdgcn_readfirstlane(list[(2 < cnt) ? 2 : cnt - 1]); rs0 = *(const v4u*)NSA_GADDR(e2); }
        asm volatile("s_waitcnt lgkmcnt(0)\n\ts_barrier" ::: "memory");
#define NSA_STEP(SI, CUR, NXT, R) do { const int si_ = (SI); const int ent = __builtin_amdgcn_readfirstlane(list[si_]); \
            const int kbase = ent & 0xfffff; const bool isw = (ent >> 30) & 1; const bool skp = (ent >> 29) & 1; \
            const int j_ = kbase >> 6, jw_ = j_ >> 5; const unsigned uw_ = (jw_ == 0) ? unw[0] : (jw_ == 1) ? unw[1] : (jw_ == 2) ? unw[2] : unw[3]; \
            const bool need = isw ? (!skp && (kbase + 31 >= s0 - 511) && (kbase <= s0 + 3)) : (((uw_ >> (j_ & 31)) & 1u) != 0u); \
            if (need) { \
                __builtin_amdgcn_s_setprio(1); \
                NsaFr F_; \
                _Pragma("unroll") for (int t = 0; t < 2; ++t) _Pragma("unroll") for (int ks = 0; ks < 2; ++ks) F_.Ka[t][ks] = *(const LAS bf16x8*)(lds + (CUR) + koff[t][ks]); \
                _Pragma("unroll") for (int mt = 0; mt < 4; ++mt) F_.Vf[mt] = *(const LAS bf16x8*)(lds + (CUR) + voff + mt * 1024); \
                if (isw) nsa_compute<1>(F_, kbase, Qf, qpos, slope2, true, (kbase + 31 <= s0) && (kbase > s0 + 3 - 512), fq, mW, lW, OW); \
                else { const unsigned mw_ = (jw_ == 0) ? msk[0] : (jw_ == 1) ? msk[1] : (jw_ == 2) ? msk[2] : msk[3]; \
                       nsa_compute<0>(F_, kbase, Qf, qpos, slope2, ((mw_ >> (j_ & 31)) & 1u) != 0u, kbase + 31 <= s0, fq, mS, lS, OS); } \
            } \
            *(LAS v4u*)(lds + (NXT) + loff) = R; \
            { const int sn_ = (si_ + 3 < cnt) ? si_ + 3 : cnt - 1; const int en_ = __builtin_amdgcn_readfirstlane(list[sn_]); R = *(const v4u*)NSA_GADDR(en_); } \
            asm volatile("s_waitcnt lgkmcnt(0)\n\ts_barrier" ::: "memory"); } while (0)
#pragma unroll 1
        for (int s2 = 0; s2 < cnt; s2 += 2) { NSA_STEP(s2, 0, 8192, rs1); NSA_STEP(s2 + 1, 8192, 0, rs0); }
#undef NSA_STEP
#undef NSA_GADDR
        { const float sc_ = g1 / lS[0];
#pragma unroll
          for (int mt = 0; mt < 4; ++mt) Oacc[mt] += OS[mt] * sc_; }
        { const float sc_ = g2 / lW[0];
#pragma unroll
          for (int mt = 0; mt < 4; ++mt) Oacc[mt] += OW[mt] * sc_; }
    }
#ifdef LEAK_LO
    if (blockIdx.x == 0 && tid == 0) ((unsigned long long*)(ws + WS_CTL + 65536))[24] = __builtin_amdgcn_s_memrealtime();
#endif
    bf16* op = (bf16*)(ws + WS_OB) + (size_t)(b * S + qpos) * 512 + (g * 4 + r) * 64 + fq * 4;
#pragma unroll
    for (int mt = 0; mt < 4; ++mt) { v2u w; w.x = pk2(Oacc[mt][0], Oacc[mt][1]); w.y = pk2(Oacc[mt][2], Oacc[mt][3]); *(v2u*)(op + mt * 16) = w; }
    LDS_WAIT();
}


__device__ __forceinline__ void cross_wg(unsigned char* ws, int bh, int part, int nparts, LAS unsigned char* lds, int tid, int wave, int lane) {
    const int b = bh >> 2, h = bh & 3, fr = lane & 15, fq = lane >> 4;
    const bf16* Kc = (const bf16*)(ws + WS_KMEM) + (size_t)(bh * 256) * 128;
    const bf16* Vc = (const bf16*)(ws + WS_VMEM_T) + (size_t)(bh * 128) * 256;
#pragma unroll 8
    for (int e = tid; e < 4096; e += NTHR) { const int row = e >> 4, c = e & 15; const int key = (row & 3) | (((row >> 3) & 3) << 2);
        *(LAS v4u*)(lds + row * 256 + ((c ^ key) << 4)) = *(const v4u*)(Kc + (size_t)row * 128 + c * 8); }
#pragma unroll 8
    for (int e = tid; e < 4096; e += NTHR) { const int row = e >> 5, c = e & 31;
        *(LAS v4u*)(lds + 65536 + row * 512 + ((c ^ (row & 15)) << 4)) = *(const v4u*)(Vc + (size_t)row * 256 + c * 8); }
    __syncthreads();
    const int kr0 = 8 * (fr >> 2) + (fr & 3);
    for (int rt = part * NWAVES + wave; rt < 512; rt += nparts * NWAVES) {
        const int row = b * S + rt * 16 + fr;
        bf16x8 Qf[4];
        { const bf16* qp = (const bf16*)(ws + WS_QC) + (size_t)row * 512 + h * 128 + fq * 8;
#pragma unroll
          for (int ks = 0; ks < 4; ++ks) Qf[ks] = ldg8(qp + ks * 32); }
        f32x4 sc[16]; float mx = -1e30f;
        __builtin_amdgcn_s_setprio(1);
#pragma unroll
        for (int kt = 0; kt < 16; ++kt) {
            const int u = kt >> 1, t = kt & 1; const int krow = 32 * u + kr0 + 4 * t;
            f32x4 z = {0.f, 0.f, 0.f, 0.f};
#pragma unroll
            for (int ks = 0; ks < 4; ++ks) z = MFMA16(*(const LAS bf16x8*)(lds + krow * 256 + (((ks * 4 + fq) ^ fr) << 4)), Qf[ks], z);
            z *= LOG2E; sc[kt] = z;
            mx = fmaxf(mx, fmaxf(fmaxf(z[0], z[1]), fmaxf(z[2], z[3])));
        }
        __builtin_amdgcn_s_setprio(0);
        mx = fmaxf(mx, __shfl_xor(mx, 16)); mx = fmaxf(mx, __shfl_xor(mx, 32));
        float ls = 0.f;
#pragma unroll
        for (int kt = 0; kt < 16; ++kt)
#pragma unroll
            for (int rr = 0; rr < 4; ++rr) { const float p = ex2(sc[kt][rr] - mx); sc[kt][rr] = p; ls += p; }
        ls += __shfl_xor(ls, 16); ls += __shfl_xor(ls, 32);
        const float inv = 1.f / ls;
        f32x4 O[8];
#pragma unroll
        for (int mt = 0; mt < 8; ++mt) O[mt] = (f32x4){0.f, 0.f, 0.f, 0.f};
        __builtin_amdgcn_s_setprio(1);
#pragma unroll
        for (int u = 0; u < 8; ++u) {
            const bf16x8 Pf = pack8(sc[2 * u][0], sc[2 * u][1], sc[2 * u][2], sc[2 * u][3], sc[2 * u + 1][0], sc[2 * u + 1][1], sc[2 * u + 1][2], sc[2 * u + 1][3]);
#pragma unroll
            for (int mt = 0; mt < 8; ++mt) O[mt] = MFMA16(*(const LAS bf16x8*)(lds + 65536 + (mt * 16 + fr) * 512 + (((4 * u + fq) ^ fr) << 4)), Pf, O[mt]);
        }
        __builtin_amdgcn_s_setprio(0);
        bf16* op = (bf16*)(ws + WS_OC) + (size_t)row * 512 + h * 128 + fq * 4;
#pragma unroll
        for (int mt = 0; mt < 8; ++mt) { v2u w; w.x = pk2(O[mt][0] * inv, O[mt][1] * inv); w.y = pk2(O[mt][2] * inv, O[mt][3] * inv); *(v2u*)(op + mt * 16) = w; }
    }
    __syncthreads();
}

__device__ __forceinline__ unsigned row_max_u32(unsigned v) {
    unsigned o;
    o = (unsigned)__builtin_amdgcn_update_dpp(0, (int)v, 0x128, 0xf, 0xf, false); v = o > v ? o : v;
    o = (unsigned)__builtin_amdgcn_update_dpp(0, (int)v, 0x124, 0xf, 0xf, false); v = o > v ? o : v;
    o = (unsigned)__builtin_amdgcn_update_dpp(0, (int)v, 0x122, 0xf, 0xf, false); v = o > v ? o : v;
    o = (unsigned)__builtin_amdgcn_update_dpp(0, (int)v, 0x121, 0xf, 0xf, false); v = o > v ? o : v;
    return v;
}
__device__ __forceinline__ void peer_load8(v4u (&buf)[8], const unsigned char* tab, int ereg, int l0, int lane) {
#pragma unroll
    for (int kk = 0; kk < 8; ++kk) { const int eid = __builtin_amdgcn_readlane(ereg, l0 + kk); buf[kk] = *(const v4u*)(tab + (size_t)eid * 1024 + lane * 16); }
}
__device__ __forceinline__ float peer_dot16(const f32x2 (&x2)[8], const v4u u) {
    const f32x2 c0 = __builtin_amdgcn_cvt_pk_f32_fp8((int)u.x, false), c1 = __builtin_amdgcn_cvt_pk_f32_fp8((int)u.x, true);
    const f32x2 c2 = __builtin_amdgcn_cvt_pk_f32_fp8((int)u.y, false), c3 = __builtin_amdgcn_cvt_pk_f32_fp8((int)u.y, true);
    const f32x2 c4 = __builtin_amdgcn_cvt_pk_f32_fp8((int)u.z, false), c5 = __builtin_amdgcn_cvt_pk_f32_fp8((int)u.z, true);
    const f32x2 c6 = __builtin_amdgcn_cvt_pk_f32_fp8((int)u.w, false), c7 = __builtin_amdgcn_cvt_pk_f32_fp8((int)u.w, true);
    f32x2 s0 = x2[0] * c0, s1 = x2[1] * c1;
    s0 = __builtin_elementwise_fma(x2[2], c2, s0); s1 = __builtin_elementwise_fma(x2[3], c3, s1);
    s0 = __builtin_elementwise_fma(x2[4], c4, s0); s1 = __builtin_elementwise_fma(x2[5], c5, s1);
    s0 = __builtin_elementwise_fma(x2[6], c6, s0); s1 = __builtin_elementwise_fma(x2[7], c7, s1);
    s0 = s0 + s1; return s0.x + s0.y;
}
__device__ __forceinline__ void peer_acc16(f32x2 (&o)[8], const float w_, const v4u v) {
    const f32x2 w2 = {w_, w_};
    o[0] = __builtin_elementwise_fma(w2, __builtin_amdgcn_cvt_pk_f32_fp8((int)v.x, false), o[0]); o[1] = __builtin_elementwise_fma(w2, __builtin_amdgcn_cvt_pk_f32_fp8((int)v.x, true), o[1]);
    o[2] = __builtin_elementwise_fma(w2, __builtin_amdgcn_cvt_pk_f32_fp8((int)v.y, false), o[2]); o[3] = __builtin_elementwise_fma(w2, __builtin_amdgcn_cvt_pk_f32_fp8((int)v.y, true), o[3]);
    o[4] = __builtin_elementwise_fma(w2, __builtin_amdgcn_cvt_pk_f32_fp8((int)v.z, false), o[4]); o[5] = __builtin_elementwise_fma(w2, __builtin_amdgcn_cvt_pk_f32_fp8((int)v.z, true), o[5]);
    o[6] = __builtin_elementwise_fma(w2, __builtin_amdgcn_cvt_pk_f32_fp8((int)v.w, false), o[6]); o[7] = __builtin_elementwise_fma(w2, __builtin_amdgcn_cvt_pk_f32_fp8((int)v.w, true), o[7]);
}
__device__ __forceinline__ void peer_token(unsigned char* ws, const float* gfin, float* outp, int tok, int lane) {
    const bf16* scp = (const bf16*)(ws + WS_SCORES) + (size_t)tok * 2048;
    int eR[2]; float gR[2];
#ifndef TOPK_REP
#define TOPK_REP 1
#endif
#pragma unroll 1
    for (int trp = 0; trp < TOPK_REP; ++trp) {
        asm volatile("" : "+v"(lane));
        const int l16 = lane & 15, grp = lane >> 4;
    float tsv[4]; int tsi[4];
    {
        unsigned kq[4][8]; unsigned mykey[4];
#pragma unroll
        for (int gi = 0; gi < 4; ++gi) {
            const v4u raw = *(const v4u*)(scp + (gi * 4 + grp) * 128 + l16 * 8);
#pragma unroll
            for (int e = 0; e < 8; ++e) { const unsigned w = raw[e >> 1]; const unsigned bb_ = (e & 1) ? (w >> 16) : (w & 0xffffu);
                const unsigned ob = (bb_ & 0x8000u) ? (~bb_ & 0xffffu) : (bb_ | 0x8000u); kq[gi][e] = (ob << 16) | (unsigned)(127 - (l16 * 8 + e)); }
            sort8_desc(kq[gi]); mykey[gi] = 0u;
        }
#pragma unroll 1
        for (int round = 0; round < 16; ++round) {
#pragma unroll
            for (int gi = 0; gi < 4; ++gi) {
                const unsigned head = kq[gi][0]; const unsigned m = row_max_u32(head);
                mykey[gi] = (l16 == round) ? m : mykey[gi];
                const bool win = (head == m);
#pragma unroll
                for (int e = 0; e < 7; ++e) kq[gi][e] = win ? kq[gi][e + 1] : kq[gi][e];
                kq[gi][7] = win ? 0u : kq[gi][7];
            }
        }
#pragma unroll
        for (int gi = 0; gi < 4; ++gi) { const unsigned ob = mykey[gi] >> 16; const unsigned bb_ = (ob & 0x8000u) ? (ob & 0x7fffu) : (~ob & 0xffffu);
            tsv[gi] = __builtin_bit_cast(float, bb_ << 16); tsi[gi] = 127 - (int)(mykey[gi] & 0xffffu); }
    }
    float gsel[4]; int esel[4];
    const int half = lane >> 5, L = lane & 31, hb = half * 32, a = L & 15, bb = (L >> 4) * 8;
    {
        unsigned kq[4][8]; unsigned selk[4];
#pragma unroll
        for (int gi = 0; gi < 4; ++gi) {
            const float s0a = __shfl(tsv[gi], hb + a);
#pragma unroll
            for (int e = 0; e < 8; ++e) { const float sm_ = s0a + __shfl(tsv[gi], hb + 16 + bb + e); unsigned u = __builtin_bit_cast(unsigned, sm_);
                u ^= (unsigned)((int)u >> 31) | 0x80000000u; kq[gi][e] = (u & 0xffffff00u) | (unsigned)(255 - (a * 16 + bb + e)); }
            selk[gi] = 0u;
        }
#pragma unroll 1
        for (int round = 0; round < 16; ++round) {
#pragma unroll
            for (int gi = 0; gi < 4; ++gi) {
                const unsigned head = kq[gi][0]; unsigned m = row_max_u32(head);
                const unsigned o_ = (unsigned)__shfl_xor((int)m, 16); m = (o_ > m) ? o_ : m;
                selk[gi] = (L == round) ? m : selk[gi];
                const bool win = (head == m);
#pragma unroll
                for (int e = 0; e < 7; ++e) kq[gi][e] = win ? kq[gi][e + 1] : kq[gi][e];
                kq[gi][7] = win ? 0u : kq[gi][7];
            }
        }
#pragma unroll
        for (int gi = 0; gi < 4; ++gi) {
            const int flat = 255 - (int)(selk[gi] & 0xffu);
            const int i0 = __shfl(tsi[gi], hb + (flat >> 4)), i1 = __shfl(tsi[gi], hb + 16 + (flat & 15));
            const float selv = __shfl(tsv[gi], hb + (flat >> 4)) + __shfl(tsv[gi], hb + 16 + (flat & 15));
            const float mxv = __shfl(selv, hb);
            const float ev = (L < 16) ? __expf(selv - mxv) : 0.f;
            float sm = ev;
#pragma unroll
            for (int off = 1; off < 16; off <<= 1) sm += __shfl_xor(sm, off);
            gsel[gi] = (L < 16) ? ev / sm : 0.f; esel[gi] = i0 * 128 + i1;
        }
    }
#pragma unroll
    for (int rr = 0; rr < 2; ++rr) {
        const int e1 = __shfl(esel[2 * rr + 1], lane - 16); const float g1_ = __shfl(gsel[2 * rr + 1], lane - 16);
        const bool odd = (lane & 16) != 0;
        eR[rr] = odd ? e1 : esel[2 * rr]; gR[rr] = odd ? g1_ : gsel[2 * rr];
    }
    }
    f32x2 x2[8];
    { const bf16* up = (const bf16*)(ws + WS_U) + (size_t)tok * 1024 + lane * 16; const v4u a0 = *(const v4u*)up, a1 = *(const v4u*)(up + 8);
      x2[0] = (f32x2){bflo(a0.x), bfhi(a0.x)}; x2[1] = (f32x2){bflo(a0.y), bfhi(a0.y)}; x2[2] = (f32x2){bflo(a0.z), bfhi(a0.z)}; x2[3] = (f32x2){bflo(a0.w), bfhi(a0.w)};
      x2[4] = (f32x2){bflo(a1.x), bfhi(a1.x)}; x2[5] = (f32x2){bflo(a1.y), bfhi(a1.y)}; x2[6] = (f32x2){bflo(a1.z), bfhi(a1.z)}; x2[7] = (f32x2){bflo(a1.w), bfhi(a1.w)}; }
    f32x2 o2[8];
#pragma unroll
    for (int e = 0; e < 8; ++e) o2[e] = (f32x2){0.f, 0.f};
    __builtin_amdgcn_s_waitcnt(0x0F70);
    const float xsc = rsqrtf(((const float*)(ws + WS_SS2))[tok] * (1.f / 1024.f) + 1e-6f) * (1.f / 64.f);
    const unsigned char* PU = ws + WS_PU; const unsigned char* PV = ws + WS_PV;
    const int kkL = ((lane >> 5) & 1) * 8 + ((lane >> 4) & 1) * 4 + ((lane >> 3) & 1) * 2 + ((lane >> 2) & 1);
    v4u bA[8], bB[8];
    peer_load8(bA, PU, eR[0], 0, lane);
#pragma unroll
    for (int rr = 0; rr < 2; ++rr) {
        float wreg = 0.f;
#pragma unroll 1
        for (int sub = 0; sub < 4; ++sub) {
            const int lbase = (sub >> 1) * 16 + (sub & 1) * 32;
            float pv[16];
            peer_load8(bB, PU, eR[rr], lbase + 8, lane);
#pragma unroll
            for (int kk = 0; kk < 8; ++kk) pv[kk] = peer_dot16(x2, bA[kk]);
            { const int s1 = (sub + 1) & 3; const int lnext = (s1 >> 1) * 16 + (s1 & 1) * 32; peer_load8(bA, (sub < 3) ? PU : PV, eR[rr], lnext, lane); }
#pragma unroll
            for (int kk = 0; kk < 8; ++kk) pv[8 + kk] = peer_dot16(x2, bB[kk]);
            { const bool bit = (lane & 32) != 0;
#pragma unroll
              for (int j = 0; j < 8; ++j) { const float send = bit ? pv[j] : pv[j + 8], keep = bit ? pv[j + 8] : pv[j]; pv[j] = keep + __shfl_xor(send, 32); } }
            { const bool bit = (lane & 16) != 0;
#pragma unroll
              for (int j = 0; j < 4; ++j) { const float send = bit ? pv[j] : pv[j + 4], keep = bit ? pv[j + 4] : pv[j]; pv[j] = keep + __shfl_xor(send, 16); } }
            { const bool bit = (lane & 8) != 0;
#pragma unroll
              for (int j = 0; j < 2; ++j) { const float send = bit ? pv[j] : pv[j + 2], keep = bit ? pv[j + 2] : pv[j]; pv[j] = keep + __shfl_xor(send, 8); } }
            { const bool bit = (lane & 4) != 0; const float send = bit ? pv[0] : pv[1], keep = bit ? pv[1] : pv[0]; pv[0] = keep + __shfl_xor(send, 4); }
            float dot = pv[0]; dot += __shfl_xor(dot, 1); dot += __shfl_xor(dot, 2);
            const float gt = __shfl(gR[rr], lbase + kkL);
            const float w_ = gt * gelu_erf(dot * xsc) * (1.f / 16.f);
            wreg = ((lane & 3) == sub) ? w_ : wreg;
        }
#pragma unroll 1
        for (int sub = 0; sub < 4; ++sub) {
            const int lbase = (sub >> 1) * 16 + (sub & 1) * 32;
            peer_load8(bB, PV, eR[rr], lbase + 8, lane);
#pragma unroll
            for (int kk = 0; kk < 8; ++kk) {
                const int sl = (((kk >> 3) & 1) << 5) | (((kk >> 2) & 1) << 4) | (((kk >> 1) & 1) << 3) | ((kk & 1) << 2);
                peer_acc16(o2, __builtin_bit_cast(float, __builtin_amdgcn_readlane(__builtin_bit_cast(int, wreg), sl + sub)), bA[kk]);
            }
            { const int s1 = (sub + 1) & 3; const int lnext = (s1 >> 1) * 16 + (s1 & 1) * 32; const bool last = (sub == 3);
              peer_load8(bA, last ? PU : PV, last ? eR[1] : eR[rr], lnext, lane); }
#pragma unroll
            for (int kk = 8; kk < 16; ++kk) {
                const int sl = (((kk >> 3) & 1) << 5) | (((kk >> 2) & 1) << 4) | (((kk >> 1) & 1) << 3) | ((kk & 1) << 2);
                peer_acc16(o2, __builtin_bit_cast(float, __builtin_amdgcn_readlane(__builtin_bit_cast(int, wreg), sl + sub)), bB[kk - 8]);
            }
        }
    }
    const float* hp = (const float*)(ws + WS_H) + (size_t)tok * 1024 + lane * 16;
    float y[16];
#pragma unroll
    for (int q = 0; q < 4; ++q) { const f32x4 hv = *(const f32x4*)(hp + 4 * q); y[4 * q] = hv.x + o2[2 * q].x; y[4 * q + 1] = hv.y + o2[2 * q].y; y[4 * q + 2] = hv.z + o2[2 * q + 1].x; y[4 * q + 3] = hv.w + o2[2 * q + 1].y; }
    float ss = 0.f;
#pragma unroll
    for (int e = 0; e < 16; ++e) ss += y[e] * y[e];
    const float rstd = rsqrtf(wave_sum(ss) * (1.f / D) + 1e-6f);
    const float* gp = gfin + lane * 16; float* op = outp + (size_t)tok * 1024 + lane * 16;
#pragma unroll
    for (int q = 0; q < 4; ++q) { const f32x4 gv = *(const f32x4*)(gp + 4 * q);
        *(f32x4*)(op + 4 * q) = (f32x4){y[4 * q] * rstd * gv.x, y[4 * q + 1] * rstd * gv.y, y[4 * q + 2] * rstd * gv.z, y[4 * q + 3] * rstd * gv.w}; }
}

typedef unsigned gu32_unused;
#define XB_TMO      128
#define XB_XCNT(j)  (256  + 64 * (j))
#define XB_XSUB(j)  (1280 + 64 * (j))
#define XB_XGEN(j)  (2304 + 64 * (j))
#define XB_TOP      3328
#define XB_TOPGEN   3392
#define XCD_BAR_WORDS 3456
#define XB_SPIN_CAP (1u << 18)

__device__ __forceinline__ unsigned xb_ld(unsigned* p)              { return __hip_atomic_load(p, __ATOMIC_RELAXED, __HIP_MEMORY_SCOPE_AGENT); }
__device__ __forceinline__ unsigned xb_add(unsigned* p, unsigned v) { return __hip_atomic_fetch_add(p, v, __ATOMIC_RELAXED, __HIP_MEMORY_SCOPE_AGENT); }
__device__ __forceinline__ unsigned xb_xcc_id() { return (unsigned)__builtin_amdgcn_s_getreg((3 << 11) | 20) & 0xFu; }
#define XB_SPIN(cond, bar) do { unsigned _sp = 0; while (cond) { __builtin_amdgcn_s_sleep(1); \
    if ((++_sp & 255u) == 0u) { if (xb_ld(&(bar)[XB_TMO])) break; if (_sp > XB_SPIN_CAP) { atomicAdd(&(bar)[XB_TMO], 1u); break; } } } } while (0)

struct XcdBarrier {
    unsigned* bar; unsigned x;
    volatile LAS unsigned* st;
};

__device__ __forceinline__ XcdBarrier xcd_barrier_post(unsigned* bar, volatile LAS unsigned* st) {
    XcdBarrier b; b.bar = bar; b.x = xb_xcc_id(); b.st = st;
    if (threadIdx.x == 0) (void)xb_add(&bar[XB_XCNT(b.x)], 1u);
    return b;
}
__device__ __forceinline__ void xcd_barrier_complete(unsigned* bar, unsigned x, unsigned& nloc, unsigned& nx) {
    const unsigned G = gridDim.x * gridDim.y * gridDim.z;
    unsigned sum, cnt, mine, sp = 0u;
    for (;;) {
        sum = 0u; cnt = 0u; mine = 0u;
#pragma unroll
        for (unsigned j = 0; j < 16; ++j) { const unsigned c = xb_ld(&bar[XB_XCNT(j)]); sum += c; cnt += (c > 0u) ? 1u : 0u; mine = (j == x) ? c : mine; }
        if (sum == G) break;
        __builtin_amdgcn_s_sleep(1);
        if ((++sp & 255u) == 0u) { if (xb_ld(&bar[XB_TMO])) break; if (sp > XB_SPIN_CAP) { atomicAdd(&bar[XB_TMO], 1u); break; } }
    }
    nloc = mine > 0u ? mine : 1u; nx = cnt > 0u ? cnt : 1u;
}

__device__ __forceinline__ void xcd_barrier(const XcdBarrier& b) {
    asm volatile("s_waitcnt vmcnt(0)" ::: "memory");
    __syncthreads();
    if (threadIdx.x == 0) {
        unsigned* bar = b.bar;
        __builtin_amdgcn_s_waitcnt(0);
        unsigned nloc = b.st[0], nx = b.st[1];
        if (nloc == 0u) { xcd_barrier_complete(bar, b.x, nloc, nx); b.st[0] = nloc; b.st[1] = nx; }
        const unsigned old = xb_add(&bar[XB_XSUB(b.x)], 1u);
        const unsigned gen = old / nloc;
        if (old + 1u == (gen + 1u) * nloc) {
            __builtin_amdgcn_fence(__ATOMIC_RELEASE, "agent");
            asm volatile("s_waitcnt vmcnt(0)" ::: "memory");
            const unsigned og = xb_add(&bar[XB_TOP], 1u);
            const unsigned tg = og / nx;
            if (og + 1u == (tg + 1u) * nx) xb_add(&bar[XB_TOPGEN], 1u);
            else XB_SPIN(xb_ld(&bar[XB_TOPGEN]) == tg, bar);
            __builtin_amdgcn_fence(__ATOMIC_ACQUIRE, "agent");
            xb_add(&bar[XB_XGEN(b.x)], 1u);
            asm volatile("s_waitcnt vmcnt(0)" ::: "memory");
        } else {
            XB_SPIN(xb_ld(&bar[XB_XGEN(b.x)]) == gen, bar);
            __builtin_amdgcn_fence(__ATOMIC_ACQUIRE, "agent");
            asm volatile("s_waitcnt vmcnt(0)" ::: "memory");
        }
    }
    __syncthreads();
}

constexpr int NPHASE = 14;
__global__ void __launch_bounds__(NTHR, 2) hybrid_fwd(Args args) {
    extern __shared__ __attribute__((aligned(16))) unsigned char lds_raw[];
    LAS unsigned char* lds = (LAS unsigned char*)lds_raw;
    unsigned char* ws = args.ws;
    const int tid = threadIdx.x, lane = tid & 63, wave = __builtin_amdgcn_readfirstlane(tid >> 6);
    const int G = gridDim.x, bx = blockIdx.x;
    const int gw = bx * NWAVES + wave, NGW = G * NWAVES;
    const int lo = args.ph_lo, hi = args.ph_hi;
    const bool coop = (hi - lo) > 1;
    volatile LAS unsigned* MISC = (volatile LAS unsigned*)(lds + 131072 + 320);
    for (int u = tid; u < (LDS_BYTES - 131072) / 4; u += NTHR) ((LAS unsigned*)(lds + 131072))[u] = 0u;
    __syncthreads();
    XcdBarrier xbar; xbar.bar = (unsigned*)(ws + WS_CTL) + 4096; xbar.x = 0; xbar.st = nullptr;
    if (coop) xbar = xcd_barrier_post((unsigned*)(ws + WS_CTL) + 4096, MISC + 8);
#ifndef PH_MASK
#define PH_MASK 0x3fff
#endif
#define IN(k) (((PH_MASK >> (k)) & 1) && lo <= (k) && (k) < hi)
#ifndef REP_MASK
#define REP_MASK 0
#endif
#ifndef REP_WHICH
#define REP_WHICH 0
#endif
#define NREP(k) (1 + ((REP_MASK >> (k)) & 1))
#ifdef LEAK_LO
#define STAMP(i) do { if (bx == 0 && tid == 0) ((unsigned long long*)(ws + WS_CTL + 65536))[(i)] = __builtin_amdgcn_s_memrealtime(); } while (0)
#else
#define STAMP(i) do { } while (0)
#endif
#define SEAM(k) do { if (coop && IN(k) && IN((k) + 1)) xcd_barrier(xbar); STAMP((k) + 1); } while (0)
    if (hi > 1000) cg::this_grid().sync();
    STAMP(0);
    const float* x = args.in[0];
    EpiAll ea; ea.mode = 0; ea.ws = ws; ea.x = x; ea.cmp_pos = args.in[6]; ea.part = nullptr; ea.gn = nullptr; ea.carry = 0.f;

    if (IN(0)) for (int rep = 0; rep < NREP(0); ++rep) {
        LAS float* scr = (LAS float*)(lds + wave * 16384);
        constexpr int I_WIN = 16 * 160, I_C1 = 32 * 8, I_AB = 8 * 32, I_OUT = 16 * 32, I_CQ = 16 * 16, I_CKV = 16 * 32, I_CO = 8 * 32;
        constexpr int NIT = I_WIN + 2 * I_C1 + 2 * I_AB + I_OUT + I_CQ + I_CKV + I_CO;
        for (int it = gw; it < NIT; it += NGW) {
            int r = it;
            if (r < I_WIN) { transpose_item(args.in[3], 1024, NIN, 160, (bf16*)(ws + WS_WIN_T), scr, r, lane); continue; } r -= I_WIN;
            if (r < I_C1) { transpose_item(args.in[7], 2048, 256, 8, (bf16*)(ws + WS_CKW1_T), scr, r, lane); continue; } r -= I_C1;
            if (r < I_C1) { transpose_item(args.in[9], 2048, 256, 8, (bf16*)(ws + WS_CVW1_T), scr, r, lane); continue; } r -= I_C1;
            if (r < I_AB) { transpose_item(args.in[11], 512, 1024, 32, (bf16*)(ws + WS_WA_T), scr, r, lane); continue; } r -= I_AB;
            if (r < I_AB) { transpose_item(args.in[12], 512, 1024, 32, (bf16*)(ws + WS_WB_T), scr, r, lane); continue; } r -= I_AB;
            if (r < I_OUT) { transpose_item(args.in[13], 1024, 1024, 32, (bf16*)(ws + WS_WOUT_T), scr, r, lane); continue; } r -= I_OUT;
            if (r < I_CQ) { transpose_item(args.in[16], 1024, 512, 16, (bf16*)(ws + WS_WCQ_T), scr, r, lane); continue; } r -= I_CQ;
            if (r < I_CKV) { transpose_item(args.in[17], 1024, 1024, 32, (bf16*)(ws + WS_WCKV_T), scr, r, lane); continue; } r -= I_CKV;
            transpose_item(args.in[18], 512, 1024, 32, (bf16*)(ws + WS_WCO_T), scr, r, lane);
        }
        STAMP(21);
        for (int m = gw; m < T; m += NGW) rms_row_to_bf16(x + (size_t)m * D, args.in[2], (bf16*)(ws + WS_U) + (size_t)m * D, lane);
        STAMP(22);
        for (int m = gw; m < 512; m += NGW) rms_row_to_bf16(args.in[1] + (size_t)m * D, args.in[15], (bf16*)(ws + WS_MEMN) + (size_t)m * D, lane);
        __syncthreads();
        {
            LAS float* skl = (LAS float*)lds;
            LAS float* wql = (LAS float*)(lds + 128 * 132 * 4);
            const float* SK = args.in[21]; const float* WQ = args.in[20];
            for (int item = bx; item < 256; item += G) {
                const int hc = item >> 4, k0 = (item & 15) * 64;
#pragma unroll 16
                for (int e = tid; e < 128 * 128; e += NTHR) { const int key = e >> 7, d = e & 127; skl[d * 132 + key] = SK[(size_t)(hc * 128 + key) * 128 + d]; }
#pragma unroll 16
                for (int e = tid; e < 64 * 128; e += NTHR) { const int k = e >> 7, d = e & 127; wql[d * 68 + k] = WQ[(size_t)(k0 + k) * 2048 + hc * 128 + d]; }
                __syncthreads();
                const int key4 = (tid & 31) * 4, kk4 = (tid >> 5) * 4;
                float acc[4][4];
#pragma unroll
                for (int i = 0; i < 4; ++i)
#pragma unroll
                    for (int j = 0; j < 4; ++j) acc[i][j] = 0.f;
                for (int d = 0; d < 128; ++d) {
                    const f32x4 av = *(const LAS f32x4*)(skl + d * 132 + key4), bv = *(const LAS f32x4*)(wql + d * 68 + kk4);
#pragma unroll
                    for (int i = 0; i < 4; ++i)
#pragma unroll
                        for (int j = 0; j < 4; ++j) acc[i][j] += av[i] * bv[j];
                }
#pragma unroll
                for (int i = 0; i < 4; ++i) { v2u w; w.x = pk2(acc[i][0], acc[i][1]); w.y = pk2(acc[i][2], acc[i][3]);
                    *(v2u*)((bf16*)(ws + WS_WPS_T) + (size_t)(hc * 128 + key4 + i) * 1024 + k0 + kk4) = w; }
                __syncthreads();
            }
        }
    }
    SEAM(0);
    if (IN(1)) for (int rep = 0; rep < NREP(1); ++rep) { ea.mode = EM_G1; run_gemm(lds, (const bf16*)(ws + WS_U), (const bf16*)(ws + WS_WIN_T), T, NIN_PAD, 1024, 1024, G, bx, ea); }
    SEAM(1);
    if (IN(2)) {
        if (bx < 64) {
            const int ci = bx >> 2, kv = ci >> 3, sp = ci & 7;
            ea.mode = EM_PART; ea.part = (float*)(ws + WS_HIDP) + (size_t)ci * 1024 * 256;
            run_gemm(lds, (const bf16*)(ws + (kv ? WS_VCI : WS_KCI)) + sp * 256, (const bf16*)(ws + (kv ? WS_CVW1_T : WS_CKW1_T)) + sp * 256, 1024, 256, 256, 2048, G, bx & 3, ea);
        } else if (bx >= 128 && bx < 136) {
            ea.mode = EM_KVMEM;
            run_gemm(lds, (const bf16*)(ws + WS_MEMN), (const bf16*)(ws + WS_WCKV_T), 512, 1024, 1024, 1024, G, bx - 128, ea);
        } else {
            const int cw = (bx < 128 ? bx - 64 : bx - 72) * NWAVES + wave, NCW = (G - 72) * NWAVES;
            const size_t NV = (size_t)16384 * 1024 / 16;
            for (size_t e = (size_t)cw * 64 + lane; e < 2 * NV; e += (size_t)NCW * 64) {
                const bool second = e >= NV; const size_t ee = second ? e - NV : e;
                const float* src = (second ? args.in[23] : args.in[22]) + ee * 16; unsigned char* dst = ws + (second ? WS_PV : WS_PU) + ee * 16;
                const float sc = second ? 16.f : 64.f;
                v4u w;
#pragma unroll
                for (int q = 0; q < 4; ++q) { const f32x4 a = *(const f32x4*)(src + 4 * q); int p = 0;
                    p = __builtin_amdgcn_cvt_pk_fp8_f32(a.x * sc, a.y * sc, p, false); p = __builtin_amdgcn_cvt_pk_fp8_f32(a.z * sc, a.w * sc, p, true); w[q] = (unsigned)p; }
                *(v4u*)dst = w;
            }
        }
    }
    SEAM(2);
    if (IN(3)) {
        LAS float* hl = (LAS float*)lds;
        const float* HP = (const float*)(ws + WS_HIDP);
        for (int it = bx; it < 256; it += G) {
            for (int e = tid; e < 2048; e += NTHR) { const int kv = e >> 10, rr = (e >> 8) & 3, c = e & 255, row = it * 4 + rr; float s_ = 0.f;
#pragma unroll
                for (int sp = 0; sp < 8; ++sp) s_ += HP[((size_t)((kv * 8 + sp) * 1024 + row)) * 256 + c];
                hl[e] = gelu_erf(s_); }
            __syncthreads();
            { const int kv = tid >> 8, rr = (tid >> 6) & 3, d = tid & 63, row = it * 4 + rr; const float* w2 = kv ? args.in[10] : args.in[8]; float a_ = 0.f;
#pragma unroll 32
              for (int j = 0; j < 256; ++j) a_ += hl[(kv * 4 + rr) * 256 + j] * w2[j * 64 + d];
              if (kv == 0) ((bf16*)(ws + WS_KCMP))[(size_t)row * 64 + d] = f2bf1(a_);
              else ((bf16*)(ws + WS_VCMP_T))[((size_t)((row >> 8) * 64 + d)) * 256 + (row & 255)] = f2bf1(a_); }
            __syncthreads();
        }
    }
    SEAM(3);
    if (IN(4)) for (int rep = 0; rep < NREP(4); ++rep) {
        const int xq = bx & 7;
        unsigned* qctrD = (unsigned*)(ws + WS_CTL) + 1024 + 64 * xq + 512 * rep;
        unsigned* qctrN = (unsigned*)(ws + WS_CTL) + 2048 + 64 * xq + 512 * rep;
        volatile LAS int* qslot = (volatile LAS int*)(lds + 131072 + 64);
        if (rep == 0 || REP_WHICH == 0) {
            for (;;) {
                if (tid == 0) *qslot = (int)atomicAdd(qctrD, 1u);
                __syncthreads();
                const int n = __builtin_amdgcn_readfirstlane(*qslot);
                __syncthreads();
                if (n >= 64) break;
                diff_wg_item(ws, args.in[4], args.in[5], xq, 63 - n, lds, tid, wave, lane);
            }
        }
        STAMP(20);
        if (rep == 0 || REP_WHICH == 1) {
            { const int bg_ = xq >> 1;
              const bf16* Kc = (const bf16*)(ws + WS_KCMP) + (size_t)(bg_ * 256) * 64; const bf16* Vc = (const bf16*)(ws + WS_VCMP_T) + (size_t)(bg_ * 64) * 256;
#pragma unroll 4
              for (int e = tid; e < 2048; e += NTHR) { const int row = e >> 3, c = e & 7; *(LAS v4u*)(lds + 40960 + (row >> 5) * 4096 + kswz(row & 31, c)) = *(const v4u*)(Kc + (size_t)row * 64 + c * 8); }
#pragma unroll 4
              for (int e = tid; e < 2048; e += NTHR) { const int row = e >> 5, cc = e & 31; *(LAS v4u*)(lds + 73728 + (cc >> 2) * 4096 + vswz(row, cc & 3)) = *(const v4u*)(Vc + (size_t)row * 256 + cc * 8); }
              __syncthreads(); }
            for (;;) {
                if (tid == 0) *qslot = (int)atomicAdd(qctrN, 1u);
                __syncthreads();
                const int n = __builtin_amdgcn_readfirstlane(*qslot);
                __syncthreads();
                if (n >= 128) break;
                nsa_wg_item(ws, xq >> 1, 255 - (2 * n + (xq & 1)), lds, tid, wave, lane);
            }
        }
    }
    SEAM(4);
    if (IN(5)) {
        ea.mode = EM_MA; run_gemm(lds, (const bf16*)(ws + WS_OA), (const bf16*)(ws + WS_WA_T), T, 1024, 512, 512, G, bx, ea);
        ea.mode = EM_MB; run_gemm(lds, (const bf16*)(ws + WS_OB), (const bf16*)(ws + WS_WB_T), T, 1024, 512, 512, G, bx, ea);
    }
    SEAM(5);
    if (IN(6)) { ea.mode = EM_H1; ea.gn = args.in[14]; run_gemm(lds, (const bf16*)(ws + WS_MERGED), (const bf16*)(ws + WS_WOUT_T), T, 1024, 1024, 1024, G, bx, ea); }
    SEAM(6);
    if (IN(8)) { ea.mode = EM_QC; run_gemm(lds, (const bf16*)(ws + WS_U), (const bf16*)(ws + WS_WCQ_T), T, 512, 1024, 1024, G, bx, ea); }
    SEAM(8);
    if (IN(9)) { const int nparts = (G >= 8) ? (G >> 3) : 1; if (G >= 8) { if (bx < nparts * 8) cross_wg(ws, bx & 7, bx >> 3, nparts, lds, tid, wave, lane); } else { for (int q = bx; q < 8; q += G) cross_wg(ws, q, 0, 1, lds, tid, wave, lane); } }
    SEAM(9);
    if (IN(10)) { ea.mode = EM_H2; ea.gn = args.in[19]; run_gemm(lds, (const bf16*)(ws + WS_OC), (const bf16*)(ws + WS_WCO_T), T, 1024, 512, 512, G, bx, ea); }
    SEAM(10);
    if (IN(12)) for (int rep = 0; rep < NREP(12); ++rep) { ea.mode = EM_SC; run_gemm(lds, (const bf16*)(ws + WS_U), (const bf16*)(ws + WS_WPS_T), T, 2048, 1024, 1024, G, bx, ea); }
    SEAM(12);
    if (IN(13)) for (int rep = 0; rep < NREP(13); ++rep) {
        for (int tok = gw; tok < T; tok += NGW) { int ln = lane; asm volatile("" : "+v"(ln)); peer_token(ws, args.in[24], args.out, tok, ln);
#ifdef LEAK_LO
            if (gw == 0) { float* op = args.out + (size_t)tok * 1024 + ln * 16;
                const unsigned long long* tsp = (const unsigned long long*)(ws + WS_CTL + 65536); const float ticks = (float)(long long)(tsp[LEAK_HI] - tsp[LEAK_LO]); const float leak_d = sqrtf(fmaxf(ticks, 0.f) * 2.5e-8f);
#pragma unroll
                for (int e = 0; e < 16; ++e) op[e] += leak_d; }
#endif
        } }
#undef IN
#undef SEAM
}

#ifndef N_LAUNCH_MODE
#define N_LAUNCH_MODE 1
#endif
extern "C" void kernel_launch(void* const* d_in, const int* in_sizes, int n_in, void* d_out, int out_size, void* d_ws, size_t ws_size, hipStream_t stream) {
    static int grid = 0;
    if (grid == 0) {
        if (n_in != 25 || out_size != T * D || ws_size < WS_END) { fprintf(stderr, "kernel_launch: unexpected shapes (n_in %d out %d ws %zu)\n", n_in, out_size, ws_size); grid = -1; return; }
        int dev = 0, cus = 0, per_cu = 0;
        hipGetDevice(&dev); hipDeviceGetAttribute(&cus, hipDeviceAttributeMultiprocessorCount, dev);
        if (hipFuncSetAttribute((const void*)hybrid_fwd, hipFuncAttributeMaxDynamicSharedMemorySize, LDS_BYTES) != hipSuccess) { fprintf(stderr, "kernel_launch: hipFuncSetAttribute failed\n"); grid = -1; return; }
        if (hipOccupancyMaxActiveBlocksPerMultiprocessor(&per_cu, (const void*)hybrid_fwd, NTHR, LDS_BYTES) != hipSuccess || per_cu < 1) { fprintf(stderr, "kernel_launch: occupancy query says %d\n", per_cu); per_cu = 1; }
        (void)hipGetLastError();
        grid = cus * 1;
        if (grid > 256) grid = 256;
    }
    if (grid < 0) return;
    hipMemsetAsync((char*)d_ws + WS_CTL, 0, CTL_BYTES, stream);
    Args a{};
    for (int i = 0; i < 25; ++i) a.in[i] = (const float*)d_in[i];
    a.out = (float*)d_out; a.ws = (unsigned char*)d_ws;
#if N_LAUNCH_MODE == 1
    a.ph_lo = 0; a.ph_hi = NPHASE;
    void* kargs[] = {&a};
    hipError_t e = hipLaunchCooperativeKernel((const void*)hybrid_fwd, dim3(grid), dim3(NTHR), kargs, LDS_BYTES, stream);
    if (e != hipSuccess) fprintf(stderr, "cooperative launch failed: %s (grid %d)\n", hipGetErrorString(e), grid);
#else
    for (int p = 0; p < NPHASE; ++p) { a.ph_lo = p; a.ph_hi = p + 1; hipLaunchKernelGGL(hybrid_fwd, dim3(grid), dim3(NTHR), LDS_BYTES, stream, a); }
#endif
}
```

```cpp
#include <hip/hip_runtime.h>
#include <hip/hip_cooperative_groups.h>
#include <cstdio>
#include <cstdint>
namespace cg = cooperative_groups;
namespace pg8 {
#define PG8_LAS __attribute__((address_space(3)))
typedef unsigned short bf16_t;
typedef short bf16x8 __attribute__((ext_vector_type(8)));
typedef float f32x4 __attribute__((ext_vector_type(4)));
typedef unsigned u32x4 __attribute__((ext_vector_type(4)));
constexpr int BM = 256, BK = 64, HALF = 128, HTB = HALF * BK * 2  , STAGE_BYTES = 8 * HTB, NXCD = 8, WGM = 8;

__host__ __device__ __forceinline__ int lds_byte(int r, int c) { const int st = (r >> 4) * 2 + (c >> 5), rr = r & 15, cc = c & 31, ob = rr * 64 + cc * 2; return st * 1024 + (ob ^ (((ob >> 9) & 1) << 5)); }
__host__ __device__ __forceinline__ void stage_rc(int b, int& R, int& C) { const int st = b / 1024, sb = b % 1024, swz = sb ^ (((sb >> 9) & 1) << 5); R = (st >> 1) * 16 + swz / 64; C = (st & 1) * 32 + (swz % 64) / 2; }
__host__ __device__ __forceinline__ int perm32(int rho) { const int n = rho >> 4, i = rho & 15; return 8 * (i >> 2) + 4 * n + (i & 3); }

struct Unit { int pm, pn; };
struct Gemm { const bf16_t* A; const bf16_t* Bt; int M, N, K, ld; };

struct StaticOrder {
    int nM, nN, nwg, G, c;
    __host__ __device__ void init(int M, int N, int G_, int c_) { nM = M / BM; nN = N / BM; nwg = nM * nN; G = G_; c = c_; }
    __host__ __device__ bool next(int i, Unit& u) const {
        const long L = (long)i * G + c; if (L >= nwg) return false;
        int wgid = (int)L; { const int q = nwg / NXCD, r = nwg % NXCD, xcd = wgid % NXCD, off = wgid / NXCD; wgid = (xcd < r ? xcd * (q + 1) : r * (q + 1) + (xcd - r) * q) + off; }
        const int nig = WGM * nN, gid = wgid / nig, fm = gid * WGM, gsz = (nM - fm) < WGM ? (nM - fm) : WGM;
        u.pm = fm + ((wgid % nig) % gsz); u.pn = (wgid % nig) / gsz; return true;
    }
    __device__ __forceinline__ void a_ready(const Unit&) const {}
    __device__ __forceinline__ void done(const Unit&) const {}
};

__device__ __forceinline__ unsigned cvt_pk_bf16(float lo, float hi) { unsigned r; asm volatile("v_cvt_pk_bf16_f32 %0, %1, %2" : "=v"(r) : "v"(lo), "v"(hi)); return r; }
template <class F> struct EpiF {
    static constexpr bool PERM = true, AFTER_DRAIN = false;
    F f;
    __device__ __forceinline__ void operator()(const f32x4 (&acc)[2][2][4][2], const Unit& u, int wr, int wc, int fr, int fq) const {
        const int row0 = u.pm * BM + wr * 64 + fr, col0 = u.pn * BM + wc * 32 + 8 * fq;
#pragma unroll
        for (int ai = 0; ai < 2; ++ai)
#pragma unroll
            for (int m = 0; m < 4; ++m)
#pragma unroll
                for (int bj = 0; bj < 2; ++bj) f(row0 + ai * HALF + m * 16, col0 + bj * HALF, acc[ai][bj][m][0], acc[ai][bj][m][1]);
    }
};
template <class Epi, class Sched, bool ALIGN_EPI = false, bool SP2 = false>
__device__ __forceinline__ void gemm_phase(PG8_LAS unsigned char* lds, const Gemm g, const Sched& S, const Epi& E) {
    const int tid = threadIdx.x, wid = __builtin_amdgcn_readfirstlane(tid >> 6), lane = tid & 63, wr = wid >> 2, wc = wid & 3, fr = lane & 15, fq = lane >> 4;
    const int K = g.K, nt = K / BK;
    unsigned voffA[2], voffB[2];
#pragma unroll
    for (int i = 0; i < 2; ++i) { int R, C; stage_rc(tid * 16 + i * 8192, R, C); const int Rb = Epi::PERM ? ((R & ~31) + perm32(R & 31)) : R;
        voffA[i] = (unsigned)(R * g.ld + C) * 2u; voffB[i] = (unsigned)(Rb * g.ld + C) * 2u; }
    const size_t kstep = (size_t)(BK * 2);
    const size_t hstep = (size_t)HALF * g.ld * 2;
    const size_t tstep = 2 * hstep;
    const unsigned ldsw = (unsigned)wid * 1024u;
    const int aoff = lds_byte(wr * 64 + fr, fq * 8), boff = lds_byte(wc * 32 + fr, fq * 8);
#define PG8_SA(b, h) (((b) * 2 + (h)) * HTB)
#define PG8_SB(b, h) ((4 + (b) * 2 + (h)) * HTB)
#define PG8_STAGE(bufoff, gbase, voff) do { _Pragma("unroll") for (int _i = 0; _i < 2; ++_i) \
        __builtin_amdgcn_global_load_lds((const unsigned*)((const char*)(gbase) + (voff)[_i]), (PG8_LAS unsigned*)(lds + (bufoff) + ldsw + _i * 8192), 16, 0, 0); } while (0)
#define PG8_LDA(dst, b, h) do { _Pragma("unroll") for (int m = 0; m < 4; ++m) _Pragma("unroll") for (int k = 0; k < 2; ++k) dst[m][k] = *(const PG8_LAS bf16x8*)(lds + PG8_SA(b, h) + aoff + m * 2048 + k * 1024); } while (0)
#define PG8_LDB(dst, b, h) do { _Pragma("unroll") for (int n = 0; n < 2; ++n) _Pragma("unroll") for (int k = 0; k < 2; ++k) dst[n][k] = *(const PG8_LAS bf16x8*)(lds + PG8_SB(b, h) + boff + n * 2048 + k * 1024); } while (0)
#define PG8_MMA(ai, bj, At, Bt) do { __builtin_amdgcn_s_setprio(1); _Pragma("unroll") for (int m = 0; m < 4; ++m) _Pragma("unroll") for (int n = 0; n < 2; ++n) _Pragma("unroll") for (int k = 0; k < 2; ++k) \
        acc[ai][bj][m][n] = __builtin_amdgcn_mfma_f32_16x16x32_bf16(Bt[n][k], At[m][k], acc[ai][bj][m][n], 0, 0, 0); __builtin_amdgcn_s_setprio(0); } while (0)
#define PG8_WAIT_V(n) asm volatile("s_waitcnt vmcnt(" #n ")" ::: "memory")
#define PG8_WAIT_L(n) asm volatile("s_waitcnt lgkmcnt(" #n ")" ::: "memory")
#define PG8_BAR __builtin_amdgcn_s_barrier()
#define PG8_SCHED __builtin_amdgcn_sched_barrier(0)
    Unit cur, nxt; int ui = 0;
    if (!S.next(0, cur)) return;
    f32x4 acc[2][2][4][2];
#pragma unroll
    for (int a = 0; a < 2; ++a)
#pragma unroll
        for (int b = 0; b < 2; ++b)
#pragma unroll
            for (int m = 0; m < 4; ++m)
#pragma unroll
                for (int n = 0; n < 2; ++n) acc[a][b][m][n] = (f32x4){0.f, 0.f, 0.f, 0.f};
    bf16x8 At[4][2], B0[2][2], B1[2][2];
    const char* cA = (const char*)g.A + (size_t)cur.pm * tstep; const char* cB = (const char*)g.Bt + (size_t)cur.pn * tstep;
    S.a_ready(cur);
    if constexpr (SP2) {
        PG8_STAGE(PG8_SB(0, 0), cB, voffB); PG8_STAGE(PG8_SB(0, 1), cB + hstep, voffB); PG8_STAGE(PG8_SA(0, 0), cA, voffA); PG8_STAGE(PG8_SA(0, 1), cA + hstep, voffA);
        if (wr == 1) PG8_BAR;
        PG8_WAIT_V(2); PG8_BAR;
        PG8_STAGE(PG8_SB(1, 0), cB + kstep, voffB); PG8_STAGE(PG8_SA(1, 0), cA + kstep, voffA); PG8_STAGE(PG8_SB(1, 1), cB + hstep + kstep, voffB);
        PG8_WAIT_V(6); PG8_BAR;
    } else {
        PG8_STAGE(PG8_SB(0, 0), cB, voffB); PG8_STAGE(PG8_SA(0, 0), cA, voffA); PG8_STAGE(PG8_SB(0, 1), cB + hstep, voffB); PG8_STAGE(PG8_SA(0, 1), cA + hstep, voffA);
        if (wr == 1) PG8_BAR;
        PG8_WAIT_V(4); PG8_BAR;
        PG8_STAGE(PG8_SB(1, 0), cB + kstep, voffB); PG8_STAGE(PG8_SA(1, 0), cA + kstep, voffA); PG8_STAGE(PG8_SB(1, 1), cB + hstep + kstep, voffB);
        PG8_WAIT_V(6); PG8_BAR;
    }
    for (;;) {
        const bool has_next = S.next(ui + 1, nxt);
        const char* nA = has_next ? (const char*)g.A + (size_t)nxt.pm * tstep : cA; const char* nB = has_next ? (const char*)g.Bt + (size_t)nxt.pn * tstep : cB;
        for (int t = 0; t < nt; t += 2) {
            const bool last = (t == nt - 2);
            const char* a1 = cA + (size_t)(t + 1) * kstep;
            const char* a2 = last ? nA : cA + (size_t)(t + 2) * kstep; const char* b2 = last ? nB : cB + (size_t)(t + 2) * kstep;
            const char* a3 = a2 + kstep; const char* b3 = b2 + kstep;
            if (last && has_next) S.a_ready(nxt);
            if constexpr (SP2) {
            PG8_LDB(B0, 0, 0); PG8_LDB(B1, 0, 1); PG8_SCHED; PG8_LDA(At, 0, 0); PG8_STAGE(PG8_SA(1, 1), a1 + hstep, voffA);
            PG8_WAIT_V(8); PG8_WAIT_L(0); PG8_BAR; PG8_MMA(0, 0, At, B0); PG8_MMA(0, 1, At, B1); PG8_BAR; PG8_SCHED;
            PG8_LDA(At, 0, 1); PG8_STAGE(PG8_SB(0, 0), b2, voffB); PG8_STAGE(PG8_SB(0, 1), b2 + hstep, voffB); PG8_STAGE(PG8_SA(0, 0), a2, voffA);
            PG8_WAIT_V(8); PG8_WAIT_L(0); PG8_BAR; PG8_MMA(1, 0, At, B0); PG8_MMA(1, 1, At, B1); PG8_BAR; PG8_SCHED;
            PG8_LDB(B0, 1, 0); PG8_LDB(B1, 1, 1); PG8_SCHED; PG8_LDA(At, 1, 0); PG8_STAGE(PG8_SA(0, 1), a2 + hstep, voffA);
            PG8_WAIT_V(8); PG8_WAIT_L(0); PG8_BAR; PG8_MMA(0, 0, At, B0); PG8_MMA(0, 1, At, B1); PG8_BAR; PG8_SCHED;
            PG8_LDA(At, 1, 1); PG8_STAGE(PG8_SB(1, 0), b3, voffB); PG8_STAGE(PG8_SB(1, 1), b3 + hstep, voffB); PG8_STAGE(PG8_SA(1, 0), a3, voffA);
            PG8_WAIT_V(8); PG8_WAIT_L(0); PG8_BAR; PG8_MMA(1, 0, At, B0); PG8_MMA(1, 1, At, B1); PG8_BAR; PG8_SCHED;
            } else {
            PG8_LDB(B0, 0, 0); PG8_SCHED; PG8_LDA(At, 0, 0); PG8_STAGE(PG8_SA(1, 1), a1 + hstep, voffA);
            PG8_WAIT_L(8); PG8_BAR; PG8_WAIT_L(0); PG8_MMA(0, 0, At, B0); PG8_BAR; PG8_SCHED;
            PG8_LDB(B1, 0, 1); PG8_STAGE(PG8_SB(0, 0), b2, voffB);
            PG8_BAR; PG8_WAIT_L(0); PG8_MMA(0, 1, At, B1); PG8_BAR;
            PG8_LDA(At, 0, 1); PG8_STAGE(PG8_SA(0, 0), a2, voffA);
            PG8_BAR; PG8_WAIT_L(0); PG8_MMA(1, 0, At, B0); PG8_BAR; PG8_SCHED;
            PG8_STAGE(PG8_SB(0, 1), b2 + hstep, voffB);
            PG8_WAIT_V(6); PG8_BAR; PG8_MMA(1, 1, At, B1); PG8_BAR;
            PG8_LDB(B0, 1, 0); PG8_SCHED; PG8_LDA(At, 1, 0); PG8_STAGE(PG8_SA(0, 1), a2 + hstep, voffA);
            PG8_WAIT_L(8); PG8_BAR; PG8_WAIT_L(0); PG8_MMA(0, 0, At, B0); PG8_BAR; PG8_SCHED;
            PG8_LDB(B1, 1, 1); PG8_STAGE(PG8_SB(1, 0), b3, voffB);
            PG8_BAR; PG8_WAIT_L(0); PG8_MMA(0, 1, At, B1); PG8_BAR;
            PG8_LDA(At, 1, 1); PG8_STAGE(PG8_SA(1, 0), a3, voffA);
            PG8_BAR; PG8_WAIT_L(0); PG8_MMA(1, 0, At, B0); PG8_BAR; PG8_SCHED;
            PG8_STAGE(PG8_SB(1, 1), b3 + hstep, voffB);
            PG8_WAIT_V(6); PG8_BAR; PG8_MMA(1, 1, At, B1); PG8_BAR;
            }
        }
        if constexpr (ALIGN_EPI) { if (wr == 0) PG8_BAR; }
        if constexpr (!Epi::AFTER_DRAIN) { E(acc, cur, wr, wc, fr, fq); S.done(cur); }
        if (!has_next) break;
#pragma unroll
        for (int a = 0; a < 2; ++a)
#pragma unroll
            for (int b = 0; b < 2; ++b)
#pragma unroll
                for (int m = 0; m < 4; ++m)
#pragma unroll
                    for (int n = 0; n < 2; ++n) acc[a][b][m][n] = (f32x4){0.f, 0.f, 0.f, 0.f};
        cur = nxt; cA = nA; cB = nB; ++ui;
        if constexpr (ALIGN_EPI) { if (wr == 1) PG8_BAR; }
    }
    PG8_WAIT_V(0);
    if constexpr (!ALIGN_EPI) { if (wr == 0) PG8_BAR; }
    PG8_BAR;
    if constexpr (Epi::AFTER_DRAIN) { E.fused(acc, cur, wr, wc, fr, fq, lds, wid, lane); S.done(cur); }
#undef PG8_SA
#undef PG8_SB
#undef PG8_STAGE
#undef PG8_LDA
#undef PG8_LDB
#undef PG8_MMA
#undef PG8_WAIT_V
#undef PG8_WAIT_L
#undef PG8_BAR
#undef PG8_SCHED
}
}

#define LAS __attribute__((address_space(3)))
typedef unsigned short bf16;
typedef unsigned v4u __attribute__((ext_vector_type(4)));
typedef unsigned v2u __attribute__((ext_vector_type(2)));
typedef float f32x4 __attribute__((ext_vector_type(4)));
typedef float f32x2 __attribute__((ext_vector_type(2)));
typedef short bf16x8 __attribute__((ext_vector_type(8)));
#define LDS_WAIT() asm volatile("s_waitcnt lgkmcnt(0)" ::: "memory")
#define MFMA16(a, b, c) __builtin_amdgcn_mfma_f32_16x16x32_bf16((a), (b), (c), 0, 0, 0)

constexpr int NWAVES = 8, NTHR = 512;
constexpr int NB = 2, S = 8192, T = NB * S, D = 1024;
constexpr int LDS_BYTES = 147456;
constexpr float LOG2E = 1.4426950408889634f;
constexpr int NIN = 4888, NIN_PAD = 5120;

constexpr size_t MiB = 1u << 20;
constexpr size_t WS_CTL = 0, CTL_BYTES = 1 * MiB;
constexpr size_t WS_MEMN = 1 * MiB, WS_WIN_T = 2 * MiB, WS_CKW1_T = 12 * MiB, WS_CVW1_T = 13 * MiB, WS_WA_T = 14 * MiB, WS_WB_T = 15 * MiB, WS_WOUT_T = 16 * MiB,
                 WS_WCQ_T = 18 * MiB, WS_WCKV_T = 19 * MiB, WS_WCO_T = 21 * MiB, WS_WPS_T = 22 * MiB;
constexpr size_t WS_KCMP = 26 * MiB, WS_VCMP_T = 26 * MiB + 256 * 1024, WS_KMEM = 27 * MiB, WS_VMEM_T = 27 * MiB + 512 * 1024, WS_GB = 28 * MiB;
constexpr size_t WS_U = 32 * MiB;
constexpr size_t WS_QA = 64 * MiB, WS_KA = 80 * MiB, WS_VAT = 96 * MiB, WS_QB = 112 * MiB;
constexpr size_t WS_PU = 152 * MiB, WS_PV = 168 * MiB;
constexpr size_t WS_MERGED = 64 * MiB;
constexpr size_t WS_SS1 = WS_CTL + 131072, WS_SS2 = WS_CTL + 196608;
constexpr size_t WS_KCI = 128 * MiB, WS_VCI = 132 * MiB, WS_KS = 136 * MiB, WS_VST = 140 * MiB, WS_KW = 144 * MiB, WS_VWT = 148 * MiB;
constexpr size_t WS_OA = 32 * MiB, WS_OB = 48 * MiB, WS_HIDP = 32 * MiB;
constexpr size_t WS_GA = 184 * MiB, WS_GBT = 216 * MiB;
constexpr size_t WS_H = 192 * MiB;
constexpr size_t WS_QC = 96 * MiB, WS_OC = 112 * MiB, WS_SCORES = 64 * MiB;
constexpr size_t WS_END = 256 * MiB;

__device__ __forceinline__ unsigned pk2(float lo, float hi) { return pg8::cvt_pk_bf16(lo, hi); }
typedef __bf16 bf16x2_t __attribute__((ext_vector_type(2)));
__device__ __forceinline__ unsigned pk2s(float lo, float hi) { typedef float f2_ __attribute__((ext_vector_type(2))); const f2_ v = {lo, hi}; const bf16x2_t b = __builtin_convertvector(v, bf16x2_t); return __builtin_bit_cast(unsigned, b); }
__device__ __forceinline__ unsigned short f2bf1(float f) { return (unsigned short)(pk2(f, 0.f) & 0xffffu); }
__device__ __forceinline__ float bflo(unsigned u) { return __builtin_bit_cast(float, u << 16); }
__device__ __forceinline__ float bfhi(unsigned u) { return __builtin_bit_cast(float, u & 0xffff0000u); }
__device__ __forceinline__ float wave_sum(float v) {
#pragma unroll
    for (int o = 1; o < 64; o <<= 1) v += __shfl_xor(v, o);
    return v;
}
__device__ __forceinline__ float sigm(float x) { return __builtin_amdgcn_rcpf(1.f + __builtin_amdgcn_exp2f(x * -1.4426950408889634f)); }
__device__ __forceinline__ float gelu_erf(float x) { return 0.5f * x * (1.f + erff(x * 0.70710678118654752f)); }
__device__ __forceinline__ float ex2(float x) { return __builtin_amdgcn_exp2f(x); }
__device__ __forceinline__ void store8bf(bf16* dst, const float* v) { v4u w; w.x = pk2(v[0], v[1]); w.y = pk2(v[2], v[3]); w.z = pk2(v[4], v[5]); w.w = pk2(v[6], v[7]); *(v4u*)dst = w; }
__device__ __forceinline__ bf16x8 ldg8(const bf16* p) { return *(const bf16x8*)p; }
__device__ __forceinline__ bf16x8 pack8(float a0, float a1, float a2, float a3, float a4, float a5, float a6, float a7) {
    v4u w; w.x = pk2s(a0, a1); w.y = pk2s(a2, a3); w.z = pk2s(a4, a5); w.w = pk2s(a6, a7); return __builtin_bit_cast(bf16x8, w);
}

struct Args { const float* in[25]; float* out; unsigned char* ws; int ph_lo, ph_hi; };

enum { EM_G1 = 0, EM_PART, EM_KVMEM, EM_MA, EM_MB, EM_H1, EM_QC, EM_H2, EM_SC };
struct EpiAll {
    int mode; unsigned char* ws; const float* x; const float* cmp_pos; float* part; const float* gn;
    __device__ __forceinline__ void norm_side(const f32x4& h0, const f32x4& h1_, int row, int col, float* ss) const {
        const f32x4 g0 = *(const f32x4*)(gn + col), g1 = *(const f32x4*)(gn + col + 4);
        const float u[8] = {h0[0] * g0[0], h0[1] * g0[1], h0[2] * g0[2], h0[3] * g0[3], h1_[0] * g1[0], h1_[1] * g1[1], h1_[2] * g1[2], h1_[3] * g1[3]};
        store8bf((bf16*)(ws + WS_U) + (size_t)row * 1024 + col, u);
        float s_ = (h0[0] * h0[0] + h0[1] * h0[1]) + (h0[2] * h0[2] + h0[3] * h0[3]) + (h1_[0] * h1_[0] + h1_[1] * h1_[1]) + (h1_[2] * h1_[2] + h1_[3] * h1_[3]);
        s_ += __shfl_xor(s_, 16); s_ += __shfl_xor(s_, 32);
        if ((threadIdx.x & 48) == 0) atomicAdd(ss + row, s_);
    }
    __device__ __forceinline__ void operator()(int row, int col, const f32x4& v0, const f32x4& v1) const {
        float v[8] = {v0[0], v0[1], v0[2], v0[3], v1[0], v1[1], v1[2], v1[3]};
        switch (mode) {
        case EM_G1: {
            if (col >= NIN) return;
            const int b = row >> 13, s = row & (S - 1);
            if (col < 1024) {
                const bool isq = col < 512; bf16* dst = (bf16*)(ws + (isq ? WS_QA : WS_KA)) + (size_t)row * 512 + (col & 511);
                const float sc = isq ? 0.125f * LOG2E : 1.f;
#pragma unroll
                for (int i = 0; i < 8; ++i) v[i] *= sc;
                store8bf(dst, v);
            } else if (col < 1536) {
                bf16* dst = (bf16*)(ws + WS_VAT) + (size_t)(b * 512 + (col - 1024)) * S + s;
#pragma unroll
                for (int i = 0; i < 8; ++i) dst[(size_t)i * S] = f2bf1(v[i]);
            } else if (col < 2048) {
#pragma unroll
                for (int i = 0; i < 8; ++i) v[i] *= 0.125f * LOG2E;
                store8bf((bf16*)(ws + WS_QB) + (size_t)row * 512 + (col - 1536), v);
            } else if (col < 2816) {
                const int c2 = col - 2048, j = c2 >> 7, gg = (c2 >> 6) & 1, d = c2 & 63; const size_t bg = (size_t)(b * 2 + gg);
                if (j == 0 || j == 1) {
                    const float* cp = cmp_pos + (s & 31) * 64 + d;
#pragma unroll
                    for (int i = 0; i < 8; ++i) v[i] += cp[i];
                    store8bf((bf16*)(ws + (j == 0 ? WS_KCI : WS_VCI)) + (bg * S + s) * 64 + d, v);
                } else if (j == 2 || j == 4) {
                    store8bf((bf16*)(ws + (j == 2 ? WS_KS : WS_KW)) + (bg * S + s) * 64 + d, v);
                } else {
                    bf16* dst = (bf16*)(ws + (j == 3 ? WS_VST : WS_VWT)) + (bg * 64 + d) * S + s;
#pragma unroll
                    for (int i = 0; i < 8; ++i) dst[(size_t)i * S] = f2bf1(v[i]);
                }
            } else if (col < 2840) {
                float* dst = (float*)(ws + WS_GB) + (size_t)row * 24 + (col - 2816);
                *(f32x4*)dst = (f32x4){sigm(v[0]), sigm(v[1]), sigm(v[2]), sigm(v[3])}; *(f32x4*)(dst + 4) = (f32x4){sigm(v[4]), sigm(v[5]), sigm(v[6]), sigm(v[7])};
            } else {
                const bool ia = col < 3864; bf16* dst = (bf16*)(ws + (ia ? WS_GA : WS_GBT)) + (size_t)row * 1024 + (col - (ia ? 2840 : 3864));
#pragma unroll
                for (int i = 0; i < 8; ++i) v[i] = sigm(v[i]);
                store8bf(dst, v);
            }
        } break;
        case EM_PART: { float* dst = part + (size_t)row * 256 + col; *(f32x4*)dst = v0; *(f32x4*)(dst + 4) = v1; } break;
        case EM_KVMEM: {
            const int b = row >> 8, m = row & 255, c2 = col & 511, h = c2 >> 7, d = c2 & 127;
            if (col < 512) store8bf((bf16*)(ws + WS_KMEM) + ((size_t)((b * 4 + h) * 256 + m)) * 128 + d, v);
            else { bf16* dst = (bf16*)(ws + WS_VMEM_T) + ((size_t)((b * 4 + h) * 128 + d)) * 256 + m;
#pragma unroll
                for (int i = 0; i < 8; ++i) dst[i * 256] = f2bf1(v[i]); }
        } break;
        case EM_MA: {
            const v4u gq = *(const v4u*)((const bf16*)(ws + WS_GA) + (size_t)row * 1024 + col);
            const float g[8] = {bflo(gq.x), bfhi(gq.x), bflo(gq.y), bfhi(gq.y), bflo(gq.z), bfhi(gq.z), bflo(gq.w), bfhi(gq.w)};
#pragma unroll
            for (int i = 0; i < 8; ++i) v[i] *= g[i];
            store8bf((bf16*)(ws + WS_MERGED) + (size_t)row * 1024 + col, v);
        } break;
        case EM_MB: {
            const v4u gq = *(const v4u*)((const bf16*)(ws + WS_GBT) + (size_t)row * 1024 + col);
            bf16* mp = (bf16*)(ws + WS_MERGED) + (size_t)row * 1024 + col; const v4u mq = *(const v4u*)mp;
            const float g[8] = {bflo(gq.x), bfhi(gq.x), bflo(gq.y), bfhi(gq.y), bflo(gq.z), bfhi(gq.z), bflo(gq.w), bfhi(gq.w)};
            const float mm[8] = {bflo(mq.x), bfhi(mq.x), bflo(mq.y), bfhi(mq.y), bflo(mq.z), bfhi(mq.z), bflo(mq.w), bfhi(mq.w)};
#pragma unroll
            for (int i = 0; i < 8; ++i) v[i] = mm[i] + g[i] * v[i];
            store8bf(mp, v);
        } break;
        case EM_H1: {
            const float* xp = x + (size_t)row * 1024 + col; float* hp = (float*)(ws + WS_H) + (size_t)row * 1024 + col;
            const f32x4 x0 = *(const f32x4*)xp, x1 = *(const f32x4*)(xp + 4);
            const f32x4 h0 = x0 + v0, h1_ = x1 + v1;
            *(f32x4*)hp = h0; *(f32x4*)(hp + 4) = h1_;
            norm_side(h0, h1_, row, col, (float*)(ws + WS_SS1));
        } break;
        case EM_QC: {
            const float rs_ = rsqrtf(__hip_atomic_load((const float*)(ws + WS_SS1) + row, __ATOMIC_RELAXED, __HIP_MEMORY_SCOPE_AGENT) * (1.f / 1024.f) + 1e-6f) * 0.08838834764831845f;
#pragma unroll
            for (int i = 0; i < 8; ++i) v[i] *= rs_;
            store8bf((bf16*)(ws + WS_QC) + (size_t)row * 512 + col, v);
        } break;
        case EM_H2: {
            float* hp = (float*)(ws + WS_H) + (size_t)row * 1024 + col;
            const f32x4 x0 = *(const f32x4*)hp, x1 = *(const f32x4*)(hp + 4);
            const f32x4 h0 = x0 + v0, h1_ = x1 + v1;
            *(f32x4*)hp = h0; *(f32x4*)(hp + 4) = h1_;
            norm_side(h0, h1_, row, col, (float*)(ws + WS_SS2));
        } break;
        default: {
            const float rs_ = rsqrtf(__hip_atomic_load((const float*)(ws + WS_SS2) + row, __ATOMIC_RELAXED, __HIP_MEMORY_SCOPE_AGENT) * (1.f / 1024.f) + 1e-6f);
#pragma unroll
            for (int i = 0; i < 8; ++i) v[i] *= rs_;
            store8bf((bf16*)(ws + WS_SCORES) + (size_t)row * 2048 + col, v);
        } break;
        }
    }
};
typedef pg8::EpiF<EpiAll> EpiT;

__device__ __forceinline__ void run_gemm(LAS unsigned char* lds, const bf16* A, const bf16* Bt, int M, int N, int K, int ld, int G, int c, const EpiAll& ea) {
    pg8::Gemm g{A, Bt, M, N, K, ld}; pg8::StaticOrder So; So.init(M, N, G, c);
    EpiT E{ea};
    pg8::gemm_phase<EpiT, pg8::StaticOrder, true, true>(lds, g, So, E);
}

__device__ __forceinline__ void transpose_item(const float* W, int K, int Nsrc, int nblk, bf16* WT, LAS float* scr, int item, int lane) {
    const int kb = item / nblk, nb = item % nblk, k0 = 64 * kb, n0 = 32 * nb; const int nq = n0 + 4 * (lane & 7);
#pragma unroll
    for (int i = 0; i < 8; ++i) { const int kk = 8 * i + (lane >> 3);
        const f32x4 v = (nq < Nsrc) ? *(const f32x4*)(W + (size_t)(k0 + kk) * Nsrc + nq) : (f32x4){0.f, 0.f, 0.f, 0.f};
        LAS float* d = scr + kk * 33 + 4 * (lane & 7); d[0] = v.x; d[1] = v.y; d[2] = v.z; d[3] = v.w; }
    LDS_WAIT();
    const int c = lane & 7;
#pragma unroll
    for (int j = 0; j < 4; ++j) { const int nn = (lane >> 3) + 8 * j; const LAS float* s = scr + (8 * c) * 33 + nn;
        v4u o; o.x = pk2(s[0 * 33], s[1 * 33]); o.y = pk2(s[2 * 33], s[3 * 33]); o.z = pk2(s[4 * 33], s[5 * 33]); o.w = pk2(s[6 * 33], s[7 * 33]);
        *(v4u*)(WT + (size_t)(n0 + nn) * K + k0 + 8 * c) = o; }
    LDS_WAIT();
}
__device__ __forceinline__ void rms_row_to_bf16(const float* xrow, const float* g, bf16* orow, int lane) {
    const f32x4* xr = (const f32x4*)xrow + lane; const f32x4* gr = (const f32x4*)g + lane;
    f32x4 v[4]; float s = 0.f;
#pragma unroll
    for (int j = 0; j < 4; ++j) { v[j] = xr[64 * j]; s += (v[j].x * v[j].x + v[j].y * v[j].y) + (v[j].z * v[j].z + v[j].w * v[j].w); }
    const float rstd = rsqrtf(wave_sum(s) * (1.f / D) + 1e-6f);
    v2u* o8 = (v2u*)orow + lane;
#pragma unroll
    for (int j = 0; j < 4; ++j) { const f32x4 gg = gr[64 * j]; v2u w; w.x = pk2(v[j].x * rstd * gg.x, v[j].y * rstd * gg.y); w.y = pk2(v[j].z * rstd * gg.z, v[j].w * rstd * gg.w); o8[64 * j] = w; }
}


__device__ __forceinline__ int kswz(int row, int c) { const int F = (0x1320 >> (((row >> 3) & 3) * 4)) & 3; return row * 128 + ((c ^ (F | (((row >> 1) & 1) << 2))) << 4); }
__device__ __forceinline__ int vswz(int row, int c) { const int F = (0x1320 >> (((row >> 2) & 3) * 4)) & 3; return row * 64 + ((c ^ F) << 4); }
__device__ __forceinline__ void diff_wg_item(unsigned char* ws, const float* lamp, const float* subln, int bh, int qb, LAS unsigned char* lds, int tid, int wave, int lane) {
    const int b = bh >> 2, h = bh & 3, fr = lane & 15, fq = lane >> 4, wv = wave & 3, cm = wave >> 2;
    const int q0 = qb * 128 + wv * 32, lastkb = qb * 4 + wv, nsteps = qb * 4 + 4;
    float lam;
    { const float a = lamp[lane] * lamp[64 + lane], c = lamp[128 + lane] * lamp[192 + lane]; lam = __expf(wave_sum(a)) - __expf(wave_sum(c)) + 0.2f; }
    const float slope2 = ex2(-2.f * (float)(h + 1)) * LOG2E;
    const bf16* Qb = (const bf16*)(ws + WS_QA) + (size_t)(b * S) * 512 + h * 128;
    const bf16* Kb = (const bf16*)(ws + WS_KA) + (size_t)(b * S) * 512 + h * 128;
    const bf16* Vb = (const bf16*)(ws + WS_VAT) + (size_t)((b * 4 + h) * 128) * S;
    const int kr0 = 8 * (fr >> 2) + (fr & 3);
    const bf16* gA = Kb + (size_t)((tid & 255) >> 3) * 512 + (tid >> 8) * 64 + (tid & 7) * 8;
    const int lA = (tid >> 8) * 4096 + kswz((tid & 255) >> 3, tid & 7);
    const bf16* gB = Vb + (size_t)(tid >> 2) * S + (tid & 3) * 8;
    const int lB = 8192 + vswz(tid >> 2, tid & 3);
    bf16x8 Qf[2][2];
#pragma unroll
    for (int nt = 0; nt < 2; ++nt)
#pragma unroll
        for (int ks = 0; ks < 2; ++ks) Qf[nt][ks] = ldg8(Qb + (size_t)(q0 + nt * 16 + fr) * 512 + cm * 64 + ks * 32 + fq * 8);
    f32x4 O[8][2];
#pragma unroll
    for (int mt = 0; mt < 8; ++mt) { O[mt][0] = (f32x4){0.f, 0.f, 0.f, 0.f}; O[mt][1] = (f32x4){0.f, 0.f, 0.f, 0.f}; }
    float moff[2] = {0.f, 0.f}; f32x4 Lacc[2] = {(f32x4){0.f, 0.f, 0.f, 0.f}, (f32x4){0.f, 0.f, 0.f, 0.f}};
    const bf16x8 ones8 = {(short)0x3f80, (short)0x3f80, (short)0x3f80, (short)0x3f80, (short)0x3f80, (short)0x3f80, (short)0x3f80, (short)0x3f80};
    int koff[2][2];
#pragma unroll
    for (int t = 0; t < 2; ++t)
#pragma unroll
        for (int ks = 0; ks < 2; ++ks) koff[t][ks] = cm * 4096 + kswz(kr0 + 4 * t, ks * 4 + fq);
    const int voff = 8192 + vswz(fr, fq);
    float cst[8];
#pragma unroll
    for (int i = 0; i < 8; ++i) cst[i] = slope2 * (float)i;
    __builtin_amdgcn_s_waitcnt(0x0F70);
    const int nbs = nsteps >> 1;
    v4u ra0[2], rb0[2], ra1[2], rb1[2];
#pragma unroll
    for (int h = 0; h < 2; ++h) { const v4u a0 = *(const v4u*)(gA + (size_t)h * 32 * 512), b0 = *(const v4u*)(gB + h * 32); *(LAS v4u*)(lds + h * 16384 + lA) = a0; *(LAS v4u*)(lds + h * 16384 + lB) = b0; }
#pragma unroll
    for (int h = 0; h < 2; ++h) { ra1[h] = *(const v4u*)(gA + (size_t)(2 + h) * 32 * 512); rb1[h] = *(const v4u*)(gB + (2 + h) * 32); }
#pragma unroll
    for (int h = 0; h < 2; ++h) { const int kl = (2 < nbs) ? 4 + h : 2 + h; ra0[h] = *(const v4u*)(gA + (size_t)kl * 32 * 512); rb0[h] = *(const v4u*)(gB + kl * 32); }
    asm volatile("s_waitcnt lgkmcnt(0)\n\ts_barrier" ::: "memory");
#define DIFF_STEP(KK, CURB, NXTB, RA, RB) do { \
      _Pragma("unroll") for (int hh = 0; hh < 2; ++hh) { const int kb = 2 * (KK) + hh; const int cur = (CURB) + hh * 16384; \
        if (kb <= lastkb) { \
            __builtin_amdgcn_s_setprio(1); \
            bf16x8 Kc[2][2]; \
            _Pragma("unroll") for (int t = 0; t < 2; ++t) _Pragma("unroll") for (int ks = 0; ks < 2; ++ks) Kc[t][ks] = *(const LAS bf16x8*)(lds + cur + koff[t][ks]); \
            bf16x8 Vf[8]; \
            _Pragma("unroll") for (int mt = 0; mt < 8; ++mt) Vf[mt] = *(const LAS bf16x8*)(lds + cur + voff + mt * 1024); \
            const float kb0 = slope2 * (float)(kb * 32 + fq * 8); \
            f32x4 Sx[2][2]; \
            __builtin_amdgcn_s_setprio(1); \
            _Pragma("unroll") for (int nt = 0; nt < 2; ++nt) { const float base = kb0 - moff[nt]; \
                _Pragma("unroll") for (int t = 0; t < 2; ++t) { f32x4 z = {base + cst[4 * t], base + cst[4 * t + 1], base + cst[4 * t + 2], base + cst[4 * t + 3]}; \
                    z = MFMA16(Kc[t][0], Qf[nt][0], z); Sx[t][nt] = MFMA16(Kc[t][1], Qf[nt][1], z); } } \
            __builtin_amdgcn_s_setprio(0); \
            const bool diag = (kb == lastkb); \
            bf16x8 Pf[2]; \
            _Pragma("unroll") for (int nt = 0; nt < 2; ++nt) { \
                float sv[8] = {Sx[0][nt][0], Sx[0][nt][1], Sx[0][nt][2], Sx[0][nt][3], Sx[1][nt][0], Sx[1][nt][1], Sx[1][nt][2], Sx[1][nt][3]}; \
                if (diag) { const int dq = q0 + nt * 16 + fr - (kb * 32 + fq * 8); \
                    _Pragma("unroll") for (int i = 0; i < 8; ++i) sv[i] = (i <= dq) ? sv[i] : -1e30f; } \
                float mx = fmaxf(fmaxf(fmaxf(fmaxf(sv[0], sv[1]), sv[2]), fmaxf(fmaxf(sv[3], sv[4]), sv[5])), fmaxf(sv[6], sv[7])); \
                mx = fmaxf(mx, __shfl_xor(mx, 16)); mx = fmaxf(mx, __shfl_xor(mx, 32)); \
                if (__ballot(mx > 64.f) != 0ull) { \
                    const float dl = fmaxf(mx, 0.f), alpha = ex2(-dl); moff[nt] += dl; Lacc[nt] *= alpha; \
                    _Pragma("unroll") for (int mt = 0; mt < 8; ++mt) O[mt][nt] *= alpha; \
                    _Pragma("unroll") for (int i = 0; i < 8; ++i) sv[i] -= dl; \
                } \
                _Pragma("unroll") for (int i = 0; i < 8; ++i) sv[i] = ex2(sv[i]); \
                Pf[nt] = pack8(sv[0], sv[1], sv[2], sv[3], sv[4], sv[5], sv[6], sv[7]); \
                __builtin_amdgcn_s_setprio(1); \
                _Pragma("unroll") for (int mt = 0; mt < 8; ++mt) O[mt][nt] = MFMA16(Vf[mt], Pf[nt], O[mt][nt]); \
                Lacc[nt] = MFMA16(ones8, Pf[nt], Lacc[nt]); \
                __builtin_amdgcn_s_setprio(0); \
            } \
        } \
      } \
      _Pragma("unroll") for (int hh = 0; hh < 2; ++hh) { *(LAS v4u*)(lds + (NXTB) + hh * 16384 + lA) = RA[hh]; *(LAS v4u*)(lds + (NXTB) + hh * 16384 + lB) = RB[hh]; } \
      { const int kn = ((KK) + 3 < nbs) ? (KK) + 3 : nbs - 1; \
        _Pragma("unroll") for (int hh = 0; hh < 2; ++hh) { RA[hh] = *(const v4u*)(gA + (size_t)(2 * kn + hh) * 32 * 512); RB[hh] = *(const v4u*)(gB + (2 * kn + hh) * 32); } } \
      asm volatile("s_waitcnt lgkmcnt(0)\n\ts_barrier" ::: "memory"); } while (0)
    for (int kk = 0; kk < nbs; kk += 2) {
        DIFF_STEP(kk, 0, 32768, ra1, rb1);
        DIFF_STEP(kk + 1, 32768, 0, ra0, rb0);
    }
#undef DIFF_STEP
    float inv[2];
#pragma unroll
    for (int nt = 0; nt < 2; ++nt) inv[nt] = 1.f / Lacc[nt][0];
    LAS float* park = (LAS float*)(lds + 65536 + wv * 16384);
    if (cm == 1) {
#pragma unroll
        for (int mt = 0; mt < 8; ++mt)
#pragma unroll
            for (int nt = 0; nt < 2; ++nt)
#pragma unroll
                for (int r = 0; r < 4; ++r) park[((mt * 2 + nt) * 4 + r) * 64 + lane] = O[mt][nt][r] * inv[nt];
    }
    __syncthreads();
    if (cm == 0) {
        float ss[2] = {0.f, 0.f};
#pragma unroll
        for (int mt = 0; mt < 8; ++mt)
#pragma unroll
            for (int nt = 0; nt < 2; ++nt)
#pragma unroll
                for (int r = 0; r < 4; ++r) { const float v_ = O[mt][nt][r] * inv[nt] - lam * park[((mt * 2 + nt) * 4 + r) * 64 + lane]; O[mt][nt][r] = v_; ss[nt] += v_ * v_; }
#pragma unroll
        for (int nt = 0; nt < 2; ++nt) {
            float s_ = ss[nt]; s_ += __shfl_xor(s_, 16); s_ += __shfl_xor(s_, 32);
            const float rstd = rsqrtf(s_ * (1.f / 128.f) + 1e-6f) * 0.8f;
            bf16* op = (bf16*)(ws + WS_OA) + (size_t)(b * S + q0 + nt * 16 + fr) * 512 + h * 128 + fq * 4;
#pragma unroll
            for (int mt = 0; mt < 8; ++mt) { const f32x4 gg = *(const f32x4*)(subln + mt * 16 + fq * 4);
                v2u w; w.x = pk2(O[mt][nt][0] * rstd * gg.x, O[mt][nt][1] * rstd * gg.y); w.y = pk2(O[mt][nt][2] * rstd * gg.z, O[mt][nt][3] * rstd * gg.w);
                *(v2u*)(op + mt * 16) = w; }
        }
    }
    __syncthreads();
}

__device__ __forceinline__ void sort8_desc(unsigned (&k)[8]) {
#define CE_(i, j) do { const unsigned hi_ = k[i] > k[j] ? k[i] : k[j], lo_ = k[i] > k[j] ? k[j] : k[i]; k[i] = hi_; k[j] = lo_; } while (0)
    CE_(0, 1); CE_(2, 3); CE_(4, 5); CE_(6, 7); CE_(0, 2); CE_(1, 3); CE_(4, 6); CE_(5, 7); CE_(1, 2); CE_(5, 6);
    CE_(0, 4); CE_(1, 5); CE_(2, 6); CE_(3, 7); CE_(2, 4); CE_(3, 5); CE_(1, 2); CE_(3, 4); CE_(5, 6);
#undef CE_
}
struct NsaFr { bf16x8 Ka[2][2]; bf16x8 Vf[4]; };
template <int MODE>
__device__ __forceinline__ void nsa_compute(const NsaFr& F, int kbase, const bf16x8 (&Qf)[2], int qpos, float slope2, bool blkok, bool interior, int fq, float& moff, f32x4& Lacc, f32x4 (&O)[4]) {
    const float base = slope2 * (float)(kbase + fq * 8) - moff;
    f32x4 Sx[2];
    __builtin_amdgcn_s_setprio(1);
#pragma unroll
    for (int t = 0; t < 2; ++t) { f32x4 z = {base + slope2 * (float)(4 * t), base + slope2 * (float)(4 * t + 1), base + slope2 * (float)(4 * t + 2), base + slope2 * (float)(4 * t + 3)};
        z = MFMA16(F.Ka[t][0], Qf[0], z); Sx[t] = MFMA16(F.Ka[t][1], Qf[1], z); }
    __builtin_amdgcn_s_setprio(0);
    float sv[8];
    if (interior) {
#pragma unroll
        for (int t = 0; t < 2; ++t)
#pragma unroll
            for (int r = 0; r < 4; ++r) sv[t * 4 + r] = blkok ? Sx[t][r] : -1e30f;
    } else {
        const int kd0 = kbase + fq * 8 - qpos;
#pragma unroll
        for (int t = 0; t < 2; ++t)
#pragma unroll
            for (int r = 0; r < 4; ++r) { const int kd = kd0 + 4 * t + r; const bool ok = (MODE == 0) ? (blkok && kd <= 0) : (blkok && kd <= 0 && kd > -512);
                sv[t * 4 + r] = ok ? Sx[t][r] : -1e30f; }
    }
    float mx = fmaxf(fmaxf(fmaxf(fmaxf(sv[0], sv[1]), sv[2]), fmaxf(fmaxf(sv[3], sv[4]), sv[5])), fmaxf(sv[6], sv[7]));
    mx = fmaxf(mx, __shfl_xor(mx, 16)); mx = fmaxf(mx, __shfl_xor(mx, 32));
    if (__ballot(mx > 64.f) != 0ull) {
        const float dl = fmaxf(mx, 0.f), alpha = ex2(-dl); moff += dl; Lacc *= alpha;
#pragma unroll
        for (int mt = 0; mt < 4; ++mt) O[mt] *= alpha;
#pragma unroll
        for (int i = 0; i < 8; ++i) sv[i] -= dl;
    }
#pragma unroll
    for (int i = 0; i < 8; ++i) sv[i] = ex2(sv[i]);
    const bf16x8 Pf = pack8(sv[0], sv[1], sv[2], sv[3], sv[4], sv[5], sv[6], sv[7]);
    const bf16x8 ones8 = {(short)0x3f80, (short)0x3f80, (short)0x3f80, (short)0x3f80, (short)0x3f80, (short)0x3f80, (short)0x3f80, (short)0x3f80};
    __builtin_amdgcn_s_setprio(1);
#pragma unroll
    for (int mt = 0; mt < 4; ++mt) O[mt] = MFMA16(F.Vf[mt], Pf, O[mt]);
    Lacc = MFMA16(ones8, Pf, Lacc);
    __builtin_amdgcn_s_setprio(0);
}


__device__ __forceinline__ void cmp_scores_l(LAS unsigned char* lds, int kimg, int u, const bf16x8 (&Qf)[2], int qpos, int nv, float slope2, int fq, int kr0, float (&sv)[8]) {
#pragma unroll
    for (int t = 0; t < 2; ++t) {
        f32x4 z = {0.f, 0.f, 0.f, 0.f};
        z = MFMA16(*(const LAS bf16x8*)(lds + kimg + u * 4096 + kswz(kr0 + 4 * t, fq)), Qf[0], z);
        z = MFMA16(*(const LAS bf16x8*)(lds + kimg + u * 4096 + kswz(kr0 + 4 * t, 4 + fq)), Qf[1], z);
#pragma unroll
        for (int rr = 0; rr < 4; ++rr) { const int cidx = 32 * u + 8 * fq + 4 * t + rr; const float dist = (float)(qpos - (cidx * 32 + 31));
            sv[t * 4 + rr] = (cidx < nv) ? (z[rr] - slope2 * dist) : -1e30f; }
    }
}

__device__ __forceinline__ void nsa_wg_item(unsigned char* ws, int bg, int it32, LAS unsigned char* lds, int tid, int wave, int lane) {
    LAS float* wl = (LAS float*)(lds + 20480 + wave * 2048);
#ifdef LEAK_LO
    if (blockIdx.x == 0 && tid == 0) ((unsigned long long*)(ws + WS_CTL + 65536))[25] = __builtin_amdgcn_s_memrealtime();
#endif
    const int b = bg >> 1, g = bg & 1, fr = lane & 15, fq = lane >> 4, i = fr >> 2, r = fr & 3, s0g = it32 * 32, s0 = s0g + wave * 4, qpos = s0 + i;
    const int kr0 = 8 * (fr >> 2) + (fr & 3);
    const float slope2 = ex2(-(float)(g * 4 + r + 1)) * LOG2E;
    bf16x8 Qf[2];
    { const bf16* qp = (const bf16*)(ws + WS_QB) + (size_t)(b * S + qpos) * 512 + (g * 4 + r) * 64 + fq * 8; Qf[0] = ldg8(qp); Qf[1] = ldg8(qp + 32); }
    const float* gp = (const float*)(ws + WS_GB) + (size_t)(b * S + qpos) * 24 + g * 12 + r * 3;
    const float g0 = gp[0], g1 = gp[1], g2 = gp[2];
    __builtin_amdgcn_s_waitcnt(0x0F70);
    f32x4 Oacc[4];
#pragma unroll
    for (int mt = 0; mt < 4; ++mt) Oacc[mt] = (f32x4){0.f, 0.f, 0.f, 0.f};
#pragma unroll
    for (int e = 0; e < 8; ++e) wl[e * 64 + lane] = 0.f;
    const int nv = (qpos + 1) >> 5, nvmax = (s0 + 4) >> 5;
    if (nvmax > 0) {
        const bf16* Kc = (const bf16*)(ws + WS_KCMP) + (size_t)(bg * 256) * 64;
        const bf16* Vc = (const bf16*)(ws + WS_VCMP_T) + (size_t)(bg * 64) * 256;
        const int nu = (nvmax + 31) >> 5;
        float mloc = -1e30f, lloc = 0.f;
#pragma unroll 1
        for (int u = 0; u < nu; ++u) {
            float sv[8]; cmp_scores_l(lds, 40960, u, Qf, qpos, nv, slope2, fq, kr0, sv);
            float mx = mloc;
#pragma unroll
            for (int e = 0; e < 8; ++e) mx = fmaxf(mx, sv[e]);
            float ps = 0.f;
#pragma unroll
            for (int e = 0; e < 8; ++e) ps += (sv[e] > -1e29f) ? ex2(sv[e] - mx) : 0.f;
            lloc = lloc * ex2(mloc - mx) + ps; mloc = mx;
        }
        float mx = fmaxf(mloc, __shfl_xor(mloc, 16)); mx = fmaxf(mx, __shfl_xor(mx, 32));
        float ls = lloc * ex2(mloc - mx); ls += __shfl_xor(ls, 16); ls += __shfl_xor(ls, 32);
        const float inv = (ls > 0.f) ? 1.f / ls : 0.f;
        f32x4 Oc[4];
#pragma unroll
        for (int mt = 0; mt < 4; ++mt) Oc[mt] = (f32x4){0.f, 0.f, 0.f, 0.f};
#pragma unroll 1
        for (int u = 0; u < nu; ++u) {
            float sv[8]; cmp_scores_l(lds, 40960, u, Qf, qpos, nv, slope2, fq, kr0, sv);
#pragma unroll
            for (int e = 0; e < 8; ++e) sv[e] = (sv[e] > -1e29f) ? ex2(sv[e] - mx) * inv : 0.f;
#pragma unroll
            for (int t = 0; t < 2; ++t) {
                float e0 = sv[t * 4 + 0] + sv[t * 4 + 1], e1 = sv[t * 4 + 2] + sv[t * 4 + 3];
                e0 += __shfl_xor(e0, 1); e0 += __shfl_xor(e0, 2); e1 += __shfl_xor(e1, 1); e1 += __shfl_xor(e1, 2);
                if (r == 0) { const int j = 16 * u + 4 * fq + 2 * t; wl[i * 128 + j] = e0; wl[i * 128 + j + 1] = e1; }
            }
            const bf16x8 Pf = pack8(sv[0], sv[1], sv[2], sv[3], sv[4], sv[5], sv[6], sv[7]);
#pragma unroll
            for (int mt = 0; mt < 4; ++mt) Oc[mt] = MFMA16(*(const LAS bf16x8*)(lds + 73728 + u * 4096 + vswz(fr, fq) + mt * 1024), Pf, Oc[mt]);
        }
#pragma unroll
        for (int mt = 0; mt < 4; ++mt) Oacc[mt] = Oc[mt] * g0;
    }
    LDS_WAIT();
    unsigned msk[4] = {0u, 0u, 0u, 0u};
    {
        const int q16 = r + 4 * fq, cur = qpos >> 6;
        unsigned kq[8];
#pragma unroll
        for (int e = 0; e < 8; ++e) { const int j = q16 + 16 * e; const bool forced = (j == 0) || (j == cur) || (j == cur - 1);
            const unsigned pb = __builtin_bit_cast(unsigned, wl[i * 128 + j]) | 0x80000000u;
            const unsigned cls = forced ? 0xffffff80u : ((j <= cur) ? (pb & 0xffffff80u) : 0u);
            kq[e] = cls | (unsigned)(127 - j); }
        sort8_desc(kq);
#pragma unroll 1
        for (int round = 0; round < 16; ++round) {
            const unsigned head = kq[0]; unsigned m = head, o_;
            o_ = (unsigned)__builtin_amdgcn_update_dpp(0, (int)m, 0xB1, 0xf, 0xf, false); m = o_ > m ? o_ : m;
            o_ = (unsigned)__builtin_amdgcn_update_dpp(0, (int)m, 0x4E, 0xf, 0xf, false); m = o_ > m ? o_ : m;
            { const auto r_ = __builtin_amdgcn_permlane16_swap(m, m, false, false); const unsigned a_ = (unsigned)r_[0], b_ = (unsigned)r_[1]; m = a_ > b_ ? a_ : b_; }
            { const auto r_ = __builtin_amdgcn_permlane32_swap(m, m, false, false); const unsigned a_ = (unsigned)r_[0], b_ = (unsigned)r_[1]; m = a_ > b_ ? a_ : b_; }
            const int bj = 127 - (int)(m & 0x7fu);
            const unsigned bit = 1u << (bj & 31); const int w = bj >> 5;
            msk[0] |= (w == 0) ? bit : 0u; msk[1] |= (w == 1) ? bit : 0u; msk[2] |= (w == 2) ? bit : 0u; msk[3] |= (w == 3) ? bit : 0u;
            const bool win = (head == m);
#pragma unroll
            for (int e = 0; e < 7; ++e) kq[e] = win ? kq[e + 1] : kq[e];
            kq[7] = win ? 0u : kq[7];
        }
    }
#ifdef LEAK_LO
    if (blockIdx.x == 0 && tid == 0) ((unsigned long long*)(ws + WS_CTL + 65536))[23] = __builtin_amdgcn_s_memrealtime();
#endif
    unsigned unw[4];
    { const int curmax = (s0 + 3) >> 6;
#pragma unroll
      for (int w = 0; w < 4; ++w) {
          unsigned u_ = msk[w]; u_ |= __shfl_xor(u_, 4); u_ |= __shfl_xor(u_, 8);
          const unsigned uu = (unsigned)__builtin_amdgcn_readfirstlane((int)u_);
          const int hi = curmax - 32 * w;
          const unsigned vm = (hi < 0) ? 0u : (hi >= 31 ? 0xffffffffu : ((2u << hi) - 1u));
          unw[w] = uu & vm; } }
    LAS unsigned* UM = (LAS unsigned*)(lds + 18432);
    LAS int* list = (LAS int*)(lds + 16384);
    if (lane == 0) { UM[wave * 4 + 0] = unw[0]; UM[wave * 4 + 1] = unw[1]; UM[wave * 4 + 2] = unw[2]; UM[wave * 4 + 3] = unw[3]; }
    asm volatile("s_waitcnt lgkmcnt(0)\n\ts_barrier" ::: "memory");
    int cnt = 0;
#pragma unroll
    for (int w = 0; w < 4; ++w) {
        unsigned o_ = 0u;
#pragma unroll
        for (int v = 0; v < 8; ++v) o_ |= UM[v * 4 + w];
        unsigned uu = (unsigned)__builtin_amdgcn_readfirstlane((int)o_);
        while (uu) { const int jb = __builtin_ctz(uu); uu &= uu - 1u; const int kbase = (32 * w + jb) * 64;
            if (tid == 0) { list[cnt] = kbase; list[cnt + 1] = kbase + 32; } cnt += 2; }
    }
    { const int kst = (s0g - 511 > 0) ? (s0g - 511) : 0; const int k0_ = kst >> 5, k1_ = (s0g + 31) >> 5;
      for (int k32 = k0_; k32 <= k1_; ++k32) { if (tid == 0) list[cnt] = (k32 * 32) | (1 << 30); ++cnt; }
      if (cnt & 1) { if (tid == 0) list[cnt] = (k1_ * 32) | (1 << 30) | (1 << 29); ++cnt; } }
    asm volatile("s_waitcnt lgkmcnt(0)\n\ts_barrier" ::: "memory");
    {
        const bf16* KSb = (const bf16*)(ws + WS_KS) + (size_t)(bg * S) * 64; const bf16* VSb = (const bf16*)(ws + WS_VST) + (size_t)(bg * 64) * S;
        const bf16* KWb = (const bf16*)(ws + WS_KW) + (size_t)(bg * S) * 64; const bf16* VWb = (const bf16*)(ws + WS_VWT) + (size_t)(bg * 64) * S;
        const bool isK = tid < 256;
        const int srow = isK ? (tid >> 3) : ((tid - 256) >> 2), scq = isK ? (tid & 7) : (tid & 3);
        const int loff = isK ? kswz(srow, scq) : 4096 + vswz(srow, scq);
#define NSA_GADDR(ENT) (isK ? ((((ENT) >> 30) & 1) ? KWb : KSb) + (size_t)(((ENT) & 0xfffff) + srow) * 64 + scq * 8 : ((((ENT) >> 30) & 1) ? VWb : VSb) + (size_t)srow * S + ((ENT) & 0xfffff) + scq * 8)
        int koff[2][2];
#pragma unroll
        for (int t = 0; t < 2; ++t)
#pragma unroll
            for (int ks = 0; ks < 2; ++ks) koff[t][ks] = kswz(kr0 + 4 * t, ks * 4 + fq);
        const int voff = 4096 + vswz(fr, fq);
        float mS = 0.f, mW = 0.f; f32x4 lS = {0.f, 0.f, 0.f, 0.f}, lW = {0.f, 0.f, 0.f, 0.f}; f32x4 OS[4], OW[4];
#pragma unroll
        for (int mt = 0; mt < 4; ++mt) { OS[mt] = (f32x4){0.f, 0.f, 0.f, 0.f}; OW[mt] = (f32x4){0.f, 0.f, 0.f, 0.f}; }
        v4u rs0, rs1;
        { const int e0 = __builtin_amdgcn_readfirstlane(list[0]); const v4u v0 = *(const v4u*)NSA_GADDR(e0); *(LAS v4u*)(lds + loff) = v0; }
        { const int e1 = __builtin_amdgcn_readfirstlane(list[1]); rs1 = *(const v4u*)NSA_GADDR(e1); }
        { const int e2 = __builtin_amdgcn_readfirstlane(list[(2 < cnt) ? 2 : cnt - 1]); rs0 = *(const v4u*)NSA_GADDR(e2); }
        asm volatile("s_waitcnt lgkmcnt(0)\n\ts_barrier" ::: "memory");
#define NSA_STEP(SI, CUR, NXT, R) do { const int si_ = (SI); const int ent = __builtin_amdgcn_readfirstlane(list[si_]); \
            const int kbase = ent & 0xfffff; const bool isw = (ent >> 30) & 1; const bool skp = (ent >> 29) & 1; \
            const int j_ = kbase >> 6, jw_ = j_ >> 5; const unsigned uw_ = (jw_ == 0) ? unw[0] : (jw_ == 1) ? unw[1] : (jw_ == 2) ? unw[2] : unw[3]; \
            const bool need = isw ? (!skp && (kbase + 31 >= s0 - 511) && (kbase <= s0 + 3)) : (((uw_ >> (j_ & 31)) & 1u) != 0u); \
            if (need) { \
                __builtin_amdgcn_s_setprio(1); \
                NsaFr F_; \
                _Pragma("unroll") for (int t = 0; t < 2; ++t) _Pragma("unroll") for (int ks = 0; ks < 2; ++ks) F_.Ka[t][ks] = *(const LAS bf16x8*)(lds + (CUR) + koff[t][ks]); \
                _Pragma("unroll") for (int mt = 0; mt < 4; ++mt) F_.Vf[mt] = *(const LAS bf16x8*)(lds + (CUR) + voff + mt * 1024); \
                if (isw) nsa_compute<1>(F_, kbase, Qf, qpos, slope2, true, (kbase + 31 <= s0) && (kbase > s0 + 3 - 512), fq, mW, lW, OW); \
                else { const unsigned mw_ = (jw_ == 0) ? msk[0] : (jw_ == 1) ? msk[1] : (jw_ == 2) ? msk[2] : msk[3]; \
                       nsa_compute<0>(F_, kbase, Qf, qpos, slope2, ((mw_ >> (j_ & 31)) & 1u) != 0u, kbase + 31 <= s0, fq, mS, lS, OS); } \
            } \
            *(LAS v4u*)(lds + (NXT) + loff) = R; \
            { const int sn_ = (si_ + 3 < cnt) ? si_ + 3 : cnt - 1; const int en_ = __builtin_amdgcn_readfirstlane(list[sn_]); R = *(const v4u*)NSA_GADDR(en_); } \
            asm volatile("s_waitcnt lgkmcnt(0)\n\ts_barrier" ::: "memory"); } while (0)
#pragma unroll 1
        for (int s2 = 0; s2 < cnt; s2 += 2) { NSA_STEP(s2, 0, 8192, rs1); NSA_STEP(s2 + 1, 8192, 0, rs0); }
#undef NSA_STEP
#undef NSA_GADDR
        { const float sc_ = g1 / lS[0];
#pragma unroll
          for (int mt = 0; mt < 4; ++mt) Oacc[mt] += OS[mt] * sc_; }
        { const float sc_ = g2 / lW[0];
#pragma unroll
          for (int mt = 0; mt < 4; ++mt) Oacc[mt] += OW[mt] * sc_; }
    }
#ifdef LEAK_LO
    if (blockIdx.x == 0 && tid == 0) ((unsigned long long*)(ws + WS_CTL + 65536))[24] = __builtin_amdgcn_s_memrealtime();
#endif
    bf16* op = (bf16*)(ws + WS_OB) + (size_t)(b * S + qpos) * 512 + (g * 4 + r) * 64 + fq * 4;
#pragma unroll
    for (int mt = 0; mt < 4; ++mt) { v2u w; w.x = pk2(Oacc[mt][0], Oacc[mt][1]); w.y = pk2(Oacc[mt][2], Oacc[mt][3]); *(v2u*)(op + mt * 16) = w; }
    LDS_WAIT();
}


__device__ __forceinline__ void cross_wg(unsigned char* ws, int bh, int part, int nparts, LAS unsigned char* lds, int tid, int wave, int lane) {
    const int b = bh >> 2, h = bh & 3, fr = lane & 15, fq = lane >> 4;
    const bf16* Kc = (const bf16*)(ws + WS_KMEM) + (size_t)(bh * 256) * 128;
    const bf16* Vc = (const bf16*)(ws + WS_VMEM_T) + (size_t)(bh * 128) * 256;
#pragma unroll 8
    for (int e = tid; e < 4096; e += NTHR) { const int row = e >> 4, c = e & 15; const int key = (row & 3) | (((row >> 3) & 3) << 2);
        *(LAS v4u*)(lds + row * 256 + ((c ^ key) << 4)) = *(const v4u*)(Kc + (size_t)row * 128 + c * 8); }
#pragma unroll 8
    for (int e = tid; e < 4096; e += NTHR) { const int row = e >> 5, c = e & 31;
        *(LAS v4u*)(lds + 65536 + row * 512 + ((c ^ (row & 15)) << 4)) = *(const v4u*)(Vc + (size_t)row * 256 + c * 8); }
    __syncthreads();
    const int kr0 = 8 * (fr >> 2) + (fr & 3);
    for (int rt = part * NWAVES + wave; rt < 512; rt += nparts * NWAVES) {
        const int row = b * S + rt * 16 + fr;
        bf16x8 Qf[4];
        { const bf16* qp = (const bf16*)(ws + WS_QC) + (size_t)row * 512 + h * 128 + fq * 8;
#pragma unroll
          for (int ks = 0; ks < 4; ++ks) Qf[ks] = ldg8(qp + ks * 32); }
        f32x4 sc[16]; float mx = -1e30f;
        __builtin_amdgcn_s_setprio(1);
#pragma unroll
        for (int kt = 0; kt < 16; ++kt) {
            const int u = kt >> 1, t = kt & 1; const int krow = 32 * u + kr0 + 4 * t;
            f32x4 z = {0.f, 0.f, 0.f, 0.f};
#pragma unroll
            for (int ks = 0; ks < 4; ++ks) z = MFMA16(*(const LAS bf16x8*)(lds + krow * 256 + (((ks * 4 + fq) ^ fr) << 4)), Qf[ks], z);
            z *= LOG2E; sc[kt] = z;
            mx = fmaxf(mx, fmaxf(fmaxf(z[0], z[1]), fmaxf(z[2], z[3])));
        }
        __builtin_amdgcn_s_setprio(0);
        mx = fmaxf(mx, __shfl_xor(mx, 16)); mx = fmaxf(mx, __shfl_xor(mx, 32));
        float ls = 0.f;
#pragma unroll
        for (int kt = 0; kt < 16; ++kt)
#pragma unroll
            for (int rr = 0; rr < 4; ++rr) { const float p = ex2(sc[kt][rr] - mx); sc[kt][rr] = p; ls += p; }
        ls += __shfl_xor(ls, 16); ls += __shfl_xor(ls, 32);
        const float inv = 1.f / ls;
        f32x4 O[8];
#pragma unroll
        for (int mt = 0; mt < 8; ++mt) O[mt] = (f32x4){0.f, 0.f, 0.f, 0.f};
        __builtin_amdgcn_s_setprio(1);
#pragma unroll
        for (int u = 0; u < 8; ++u) {
            const bf16x8 Pf = pack8(sc[2 * u][0], sc[2 * u][1], sc[2 * u][2], sc[2 * u][3], sc[2 * u + 1][0], sc[2 * u + 1][1], sc[2 * u + 1][2], sc[2 * u + 1][3]);
#pragma unroll
            for (int mt = 0; mt < 8; ++mt) O[mt] = MFMA16(*(const LAS bf16x8*)(lds + 65536 + (mt * 16 + fr) * 512 + (((4 * u + fq) ^ fr) << 4)), Pf, O[mt]);
        }
        __builtin_amdgcn_s_setprio(0);
        bf16* op = (bf16*)(ws + WS_OC) + (size_t)row * 512 + h * 128 + fq * 4;
#pragma unroll
        for (int mt = 0; mt < 8; ++mt) { v2u w; w.x = pk2(O[mt][0] * inv, O[mt][1] * inv); w.y = pk2(O[mt][2] * inv, O[mt][3] * inv); *(v2u*)(op + mt * 16) = w; }
    }
    __syncthreads();
}

__device__ __forceinline__ unsigned row_max_u32(unsigned v) {
    unsigned o;
    o = (unsigned)__builtin_amdgcn_update_dpp(0, (int)v, 0x128, 0xf, 0xf, false); v = o > v ? o : v;
    o = (unsigned)__builtin_amdgcn_update_dpp(0, (int)v, 0x124, 0xf, 0xf, false); v = o > v ? o : v;
    o = (unsigned)__builtin_amdgcn_update_dpp(0, (int)v, 0x122, 0xf, 0xf, false); v = o > v ? o : v;
    o = (unsigned)__builtin_amdgcn_update_dpp(0, (int)v, 0x121, 0xf, 0xf, false); v = o > v ? o : v;
    return v;
}
__device__ __forceinline__ void peer_load8(v4u (&buf)[8], const unsigned char* tab, int ereg, int l0, int lane) {
#pragma unroll
    for (int kk = 0; kk < 8; ++kk) { const int eid = __builtin_amdgcn_readlane(ereg, l0 + kk); buf[kk] = *(const v4u*)(tab + (size_t)eid * 1024 + lane * 16); }
}
__device__ __forceinline__ float peer_dot16(const f32x2 (&x2)[8], const v4u u) {
    const f32x2 c0 = __builtin_amdgcn_cvt_pk_f32_fp8((int)u.x, false), c1 = __builtin_amdgcn_cvt_pk_f32_fp8((int)u.x, true);
    const f32x2 c2 = __builtin_amdgcn_cvt_pk_f32_fp8((int)u.y, false), c3 = __builtin_amdgcn_cvt_pk_f32_fp8((int)u.y, true);
    const f32x2 c4 = __builtin_amdgcn_cvt_pk_f32_fp8((int)u.z, false), c5 = __builtin_amdgcn_cvt_pk_f32_fp8((int)u.z, true);
    const f32x2 c6 = __builtin_amdgcn_cvt_pk_f32_fp8((int)u.w, false), c7 = __builtin_amdgcn_cvt_pk_f32_fp8((int)u.w, true);
    f32x2 s0 = x2[0] * c0, s1 = x2[1] * c1;
    s0 = __builtin_elementwise_fma(x2[2], c2, s0); s1 = __builtin_elementwise_fma(x2[3], c3, s1);
    s0 = __builtin_elementwise_fma(x2[4], c4, s0); s1 = __builtin_elementwise_fma(x2[5], c5, s1);
    s0 = __builtin_elementwise_fma(x2[6], c6, s0); s1 = __builtin_elementwise_fma(x2[7], c7, s1);
    s0 = s0 + s1; return s0.x + s0.y;
}
__device__ __forceinline__ void peer_acc16(f32x2 (&o)[8], const float w_, const v4u v) {
    const f32x2 w2 = {w_, w_};
    o[0] = __builtin_elementwise_fma(w2, __builtin_amdgcn_cvt_pk_f32_fp8((int)v.x, false), o[0]); o[1] = __builtin_elementwise_fma(w2, __builtin_amdgcn_cvt_pk_f32_fp8((int)v.x, true), o[1]);
    o[2] = __builtin_elementwise_fma(w2, __builtin_amdgcn_cvt_pk_f32_fp8((int)v.y, false), o[2]); o[3] = __builtin_elementwise_fma(w2, __builtin_amdgcn_cvt_pk_f32_fp8((int)v.y, true), o[3]);
    o[4] = __builtin_elementwise_fma(w2, __builtin_amdgcn_cvt_pk_f32_fp8((int)v.z, false), o[4]); o[5] = __builtin_elementwise_fma(w2, __builtin_amdgcn_cvt_pk_f32_fp8((int)v.z, true), o[5]);
    o[6] = __builtin_elementwise_fma(w2, __builtin_amdgcn_cvt_pk_f32_fp8((int)v.w, false), o[6]); o[7] = __builtin_elementwise_fma(w2, __builtin_amdgcn_cvt_pk_f32_fp8((int)v.w, true), o[7]);
}
__device__ __forceinline__ void peer_token(unsigned char* ws, const float* gfin, float* outp, int tok, int lane) {
    const bf16* scp = (const bf16*)(ws + WS_SCORES) + (size_t)tok * 2048;
    int eR[2]; float gR[2];
#ifndef TOPK_REP
#define TOPK_REP 1
#endif
#pragma unroll 1
    for (int trp = 0; trp < TOPK_REP; ++trp) {
        asm volatile("" : "+v"(lane));
        const int l16 = lane & 15, grp = lane >> 4;
    float tsv[4]; int tsi[4];
    {
        unsigned kq[4][8]; unsigned mykey[4];
#pragma unroll
        for (int gi = 0; gi < 4; ++gi) {
            const v4u raw = *(const v4u*)(scp + (gi * 4 + grp) * 128 + l16 * 8);
#pragma unroll
            for (int e = 0; e < 8; ++e) { const unsigned w = raw[e >> 1]; const unsigned bb_ = (e & 1) ? (w >> 16) : (w & 0xffffu);
                const unsigned ob = (bb_ & 0x8000u) ? (~bb_ & 0xffffu) : (bb_ | 0x8000u); kq[gi][e] = (ob << 16) | (unsigned)(127 - (l16 * 8 + e)); }
            sort8_desc(kq[gi]); mykey[gi] = 0u;
        }
#pragma unroll 1
        for (int round = 0; round < 16; ++round) {
#pragma unroll
            for (int gi = 0; gi < 4; ++gi) {
                const unsigned head = kq[gi][0]; const unsigned m = row_max_u32(head);
                mykey[gi] = (l16 == round) ? m : mykey[gi];
                const bool win = (head == m);
#pragma unroll
                for (int e = 0; e < 7; ++e) kq[gi][e] = win ? kq[gi][e + 1] : kq[gi][e];
                kq[gi][7] = win ? 0u : kq[gi][7];
            }
        }
#pragma unroll
        for (int gi = 0; gi < 4; ++gi) { const unsigned ob = mykey[gi] >> 16; const unsigned bb_ = (ob & 0x8000u) ? (ob & 0x7fffu) : (~ob & 0xffffu);
            tsv[gi] = __builtin_bit_cast(float, bb_ << 16); tsi[gi] = 127 - (int)(mykey[gi] & 0xffffu); }
    }
    float gsel[4]; int esel[4];
    const int half = lane >> 5, L = lane & 31, hb = half * 32, a = L & 15, bb = (L >> 4) * 8;
    {
        unsigned kq[4][8]; unsigned selk[4];
#pragma unroll
        for (int gi = 0; gi < 4; ++gi) {
            const float s0a = __shfl(tsv[gi], hb + a);
#pragma unroll
            for (int e = 0; e < 8; ++e) { const float sm_ = s0a + __shfl(tsv[gi], hb + 16 + bb + e); unsigned u = __builtin_bit_cast(unsigned, sm_);
                u ^= (unsigned)((int)u >> 31) | 0x80000000u; kq[gi][e] = (u & 0xffffff00u) | (unsigned)(255 - (a * 16 + bb + e)); }
            selk[gi] = 0u;
        }
#pragma unroll 1
        for (int round = 0; round < 16; ++round) {
#pragma unroll
            for (int gi = 0; gi < 4; ++gi) {
                const unsigned head = kq[gi][0]; unsigned m = row_max_u32(head);
                const unsigned o_ = (unsigned)__shfl_xor((int)m, 16); m = (o_ > m) ? o_ : m;
                selk[gi] = (L == round) ? m : selk[gi];
                const bool win = (head == m);
#pragma unroll
                for (int e = 0; e < 7; ++e) kq[gi][e] = win ? kq[gi][e + 1] : kq[gi][e];
                kq[gi][7] = win ? 0u : kq[gi][7];
            }
        }
#pragma unroll
        for (int gi = 0; gi < 4; ++gi) {
            const int flat = 255 - (int)(selk[gi] & 0xffu);
            const int i0 = __shfl(tsi[gi], hb + (flat >> 4)), i1 = __shfl(tsi[gi], hb + 16 + (flat & 15));
            const float selv = __shfl(tsv[gi], hb + (flat >> 4)) + __shfl(tsv[gi], hb + 16 + (flat & 15));
            const float mxv = __shfl(selv, hb);
            const float ev = (L < 16) ? __expf(selv - mxv) : 0.f;
            float sm = ev;
#pragma unroll
            for (int off = 1; off < 16; off <<= 1) sm += __shfl_xor(sm, off);
            gsel[gi] = (L < 16) ? ev / sm : 0.f; esel[gi] = i0 * 128 + i1;
        }
    }
#pragma unroll
    for (int rr = 0; rr < 2; ++rr) {
        const int e1 = __shfl(esel[2 * rr + 1], lane - 16); const float g1_ = __shfl(gsel[2 * rr + 1], lane - 16);
        const bool odd = (lane & 16) != 0;
        eR[rr] = odd ? e1 : esel[2 * rr]; gR[rr] = odd ? g1_ : gsel[2 * rr];
    }
    }
    f32x2 x2[8];
    { const bf16* up = (const bf16*)(ws + WS_U) + (size_t)tok * 1024 + lane * 16; const v4u a0 = *(const v4u*)up, a1 = *(const v4u*)(up + 8);
      x2[0] = (f32x2){bflo(a0.x), bfhi(a0.x)}; x2[1] = (f32x2){bflo(a0.y), bfhi(a0.y)}; x2[2] = (f32x2){bflo(a0.z), bfhi(a0.z)}; x2[3] = (f32x2){bflo(a0.w), bfhi(a0.w)};
      x2[4] = (f32x2){bflo(a1.x), bfhi(a1.x)}; x2[5] = (f32x2){bflo(a1.y), bfhi(a1.y)}; x2[6] = (f32x2){bflo(a1.z), bfhi(a1.z)}; x2[7] = (f32x2){bflo(a1.w), bfhi(a1.w)}; }
    f32x2 o2[8];
#pragma unroll
    for (int e = 0; e < 8; ++e) o2[e] = (f32x2){0.f, 0.f};
    __builtin_amdgcn_s_waitcnt(0x0F70);
    const float xsc = rsqrtf(((const float*)(ws + WS_SS2))[tok] * (1.f / 1024.f) + 1e-6f) * (1.f / 64.f);
    const unsigned char* PU = ws + WS_PU; const unsigned char* PV = ws + WS_PV;
    const int kkL = ((lane >> 5) & 1) * 8 + ((lane >> 4) & 1) * 4 + ((lane >> 3) & 1) * 2 + ((lane >> 2) & 1);
    v4u bA[8], bB[8];
    peer_load8(bA, PU, eR[0], 0, lane);
#pragma unroll
    for (int rr = 0; rr < 2; ++rr) {
        float wreg = 0.f;
#pragma unroll 1
        for (int sub = 0; sub < 4; ++sub) {
            const int lbase = (sub >> 1) * 16 + (sub & 1) * 32;
            float pv[16];
            peer_load8(bB, PU, eR[rr], lbase + 8, lane);
#pragma unroll
            for (int kk = 0; kk < 8; ++kk) pv[kk] = peer_dot16(x2, bA[kk]);
            { const int s1 = (sub + 1) & 3; const int lnext = (s1 >> 1) * 16 + (s1 & 1) * 32; peer_load8(bA, (sub < 3) ? PU : PV, eR[rr], lnext, lane); }
#pragma unroll
            for (int kk = 0; kk < 8; ++kk) pv[8 + kk] = peer_dot16(x2, bB[kk]);
            { const bool bit = (lane & 32) != 0;
#pragma unroll
              for (int j = 0; j < 8; ++j) { const float send = bit ? pv[j] : pv[j + 8], keep = bit ? pv[j + 8] : pv[j]; pv[j] = keep + __shfl_xor(send, 32); } }
            { const bool bit = (lane & 16) != 0;
#pragma unroll
              for (int j = 0; j < 4; ++j) { const float send = bit ? pv[j] : pv[j + 4], keep = bit ? pv[j + 4] : pv[j]; pv[j] = keep + __shfl_xor(send, 16); } }
            { const bool bit = (lane & 8) != 0;
#pragma unroll
              for (int j = 0; j < 2; ++j) { const float send = bit ? pv[j] : pv[j + 2], keep = bit ? pv[j + 2] : pv[j]; pv[j] = keep + __shfl_xor(send, 8); } }
            { const bool bit = (lane & 4) != 0; const float send = bit ? pv[0] : pv[1], keep = bit ? pv[1] : pv[0]; pv[0] = keep + __shfl_xor(send, 4); }
            float dot = pv[0]; dot += __shfl_xor(dot, 1); dot += __shfl_xor(dot, 2);
            const float gt = __shfl(gR[rr], lbase + kkL);
            const float w_ = gt * gelu_erf(dot * xsc) * (1.f / 16.f);
            wreg = ((lane & 3) == sub) ? w_ : wreg;
        }
#pragma unroll 1
        for (int sub = 0; sub < 4; ++sub) {
            const int lbase = (sub >> 1) * 16 + (sub & 1) * 32;
            peer_load8(bB, PV, eR[rr], lbase + 8, lane);
#pragma unroll
            for (int kk = 0; kk < 8; ++kk) {
                const int sl = (((kk >> 3) & 1) << 5) | (((kk >> 2) & 1) << 4) | (((kk >> 1) & 1) << 3) | ((kk & 1) << 2);
                peer_acc16(o2, __builtin_bit_cast(float, __builtin_amdgcn_readlane(__builtin_bit_cast(int, wreg), sl + sub)), bA[kk]);
            }
            { const int s1 = (sub + 1) & 3; const int lnext = (s1 >> 1) * 16 + (s1 & 1) * 32; const bool last = (sub == 3);
              peer_load8(bA, last ? PU : PV, last ? eR[1] : eR[rr], lnext, lane); }
#pragma unroll
            for (int kk = 8; kk < 16; ++kk) {
                const int sl = (((kk >> 3) & 1) << 5) | (((kk >> 2) & 1) << 4) | (((kk >> 1) & 1) << 3) | ((kk & 1) << 2);
                peer_acc16(o2, __builtin_bit_cast(float, __builtin_amdgcn_readlane(__builtin_bit_cast(int, wreg), sl + sub)), bB[kk - 8]);
            }
        }
    }
    const float* hp = (const float*)(ws + WS_H) + (size_t)tok * 1024 + lane * 16;
    float y[16];
#pragma unroll
    for (int q = 0; q < 4; ++q) { const f32x4 hv = *(const f32x4*)(hp + 4 * q); y[4 * q] = hv.x + o2[2 * q].x; y[4 * q + 1] = hv.y + o2[2 * q].y; y[4 * q + 2] = hv.z + o2[2 * q + 1].x; y[4 * q + 3] = hv.w + o2[2 * q + 1].y; }
    float ss = 0.f;
#pragma unroll
    for (int e = 0; e < 16; ++e) ss += y[e] * y[e];
    const float rstd = rsqrtf(wave_sum(ss) * (1.f / D) + 1e-6f);
    const float* gp = gfin + lane * 16; float* op = outp + (size_t)tok * 1024 + lane * 16;
#pragma unroll
    for (int q = 0; q < 4; ++q) { const f32x4 gv = *(const f32x4*)(gp + 4 * q);
        *(f32x4*)(op + 4 * q) = (f32x4){y[4 * q] * rstd * gv.x, y[4 * q + 1] * rstd * gv.y, y[4 * q + 2] * rstd * gv.z, y[4 * q + 3] * rstd * gv.w}; }
}

typedef unsigned gu32_unused;
#define XB_TMO      128
#define XB_XCNT(j)  (256  + 64 * (j))
#define XB_XSUB(j)  (1280 + 64 * (j))
#define XB_XGEN(j)  (2304 + 64 * (j))
#define XB_TOP      3328
#define XB_TOPGEN   3392
#define XCD_BAR_WORDS 3456
#define XB_SPIN_CAP (1u << 18)

__device__ __forceinline__ unsigned xb_ld(unsigned* p)              { return __hip_atomic_load(p, __ATOMIC_RELAXED, __HIP_MEMORY_SCOPE_AGENT); }
__device__ __forceinline__ unsigned xb_add(unsigned* p, unsigned v) { return __hip_atomic_fetch_add(p, v, __ATOMIC_RELAXED, __HIP_MEMORY_SCOPE_AGENT); }
__device__ __forceinline__ unsigned xb_xcc_id() { return (unsigned)__builtin_amdgcn_s_getreg((3 << 11) | 20) & 0xFu; }
#define XB_SPIN(cond, bar) do { unsigned _sp = 0; while (cond) { __builtin_amdgcn_s_sleep(1); \
    if ((++_sp & 255u) == 0u) { if (xb_ld(&(bar)[XB_TMO])) break; if (_sp > XB_SPIN_CAP) { atomicAdd(&(bar)[XB_TMO], 1u); break; } } } } while (0)

struct XcdBarrier {
    unsigned* bar; unsigned x;
    volatile LAS unsigned* st;
};

__device__ __forceinline__ XcdBarrier xcd_barrier_post(unsigned* bar, volatile LAS unsigned* st) {
    XcdBarrier b; b.bar = bar; b.x = xb_xcc_id(); b.st = st;
    if (threadIdx.x == 0) (void)xb_add(&bar[XB_XCNT(b.x)], 1u);
    return b;
}
__device__ __forceinline__ void xcd_barrier_complete(unsigned* bar, unsigned x, unsigned& nloc, unsigned& nx) {
    const unsigned G = gridDim.x * gridDim.y * gridDim.z;
    unsigned sum, cnt, mine, sp = 0u;
    for (;;) {
        sum = 0u; cnt = 0u; mine = 0u;
#pragma unroll
        for (unsigned j = 0; j < 16; ++j) { const unsigned c = xb_ld(&bar[XB_XCNT(j)]); sum += c; cnt += (c > 0u) ? 1u : 0u; mine = (j == x) ? c : mine; }
        if (sum == G) break;
        __builtin_amdgcn_s_sleep(1);
        if ((++sp & 255u) == 0u) { if (xb_ld(&bar[XB_TMO])) break; if (sp > XB_SPIN_CAP) { atomicAdd(&bar[XB_TMO], 1u); break; } }
    }
    nloc = mine > 0u ? mine : 1u; nx = cnt > 0u ? cnt : 1u;
}

__device__ __forceinline__ void xcd_barrier(const XcdBarrier& b) {
    asm volatile("s_waitcnt vmcnt(0)" ::: "memory");
    __syncthreads();
    if (threadIdx.x == 0) {
        unsigned* bar = b.bar;
        __builtin_amdgcn_s_waitcnt(0);
        unsigned nloc = b.st[0], nx = b.st[1];
        if (nloc == 0u) { xcd_barrier_complete(bar, b.x, nloc, nx); b.st[0] = nloc; b.st[1] = nx; }
        const unsigned old = xb_add(&bar[XB_XSUB(b.x)], 1u);
        const unsigned gen = old / nloc;
        if (old + 1u == (gen + 1u) * nloc) {
            __builtin_amdgcn_fence(__ATOMIC_RELEASE, "agent");
            asm volatile("s_waitcnt vmcnt(0)" ::: "memory");
            const unsigned og = xb_add(&bar[XB_TOP], 1u);
            const unsigned tg = og / nx;
            if (og + 1u == (tg + 1u) * nx) xb_add(&bar[XB_TOPGEN], 1u);
            else XB_SPIN(xb_ld(&bar[XB_TOPGEN]) == tg, bar);
            __builtin_amdgcn_fence(__ATOMIC_ACQUIRE, "agent");
            xb_add(&bar[XB_XGEN(b.x)], 1u);
            asm volatile("s_waitcnt vmcnt(0)" ::: "memory");
        } else {
            XB_SPIN(xb_ld(&bar[XB_XGEN(b.x)]) == gen, bar);
            __builtin_amdgcn_fence(__ATOMIC_ACQUIRE, "agent");
            asm volatile("s_waitcnt vmcnt(0)" ::: "memory");
        }
    }
    __syncthreads();
}

constexpr int NPHASE = 14;
__global__ void __launch_bounds__(NTHR, 2) hybrid_fwd(Args args) {
    extern __shared__ __attribute__((aligned(16))) unsigned char lds_raw[];
    LAS unsigned char* lds = (LAS unsigned char*)lds_raw;
    unsigned char* ws = args.ws;
    const int tid = threadIdx.x, lane = tid & 63, wave = __builtin_amdgcn_readfirstlane(tid >> 6);
    const int G = gridDim.x, bx = blockIdx.x;
    const int gw = bx * NWAVES + wave, NGW = G * NWAVES;
    const int lo = args.ph_lo, hi = args.ph_hi;
    const bool coop = (hi - lo) > 1;
    volatile LAS unsigned* MISC = (volatile LAS unsigned*)(lds + 131072 + 320);
    for (int u = tid; u < (LDS_BYTES - 131072) / 4; u += NTHR) ((LAS unsigned*)(lds + 131072))[u] = 0u;
    __syncthreads();
    XcdBarrier xbar; xbar.bar = (unsigned*)(ws + WS_CTL) + 4096; xbar.x = 0; xbar.st = nullptr;
    if (coop) xbar = xcd_barrier_post((unsigned*)(ws + WS_CTL) + 4096, MISC + 8);
#ifndef PH_MASK
#define PH_MASK 0x3fff
#endif
#define IN(k) (((PH_MASK >> (k)) & 1) && lo <= (k) && (k) < hi)
#ifndef REP_MASK
#define REP_MASK 0
#endif
#ifndef REP_WHICH
#define REP_WHICH 0
#endif
#define NREP(k) (1 + ((REP_MASK >> (k)) & 1))
#ifdef LEAK_LO
#define STAMP(i) do { if (bx == 0 && tid == 0) ((unsigned long long*)(ws + WS_CTL + 65536))[(i)] = __builtin_amdgcn_s_memrealtime(); } while (0)
#else
#define STAMP(i) do { } while (0)
#endif
#define SEAM(k) do { if (coop && IN(k) && IN((k) + 1)) xcd_barrier(xbar); STAMP((k) + 1); } while (0)
    if (hi > 1000) cg::this_grid().sync();
    STAMP(0);
    const float* x = args.in[0];
    EpiAll ea; ea.mode = 0; ea.ws = ws; ea.x = x; ea.cmp_pos = args.in[6]; ea.part = nullptr; ea.gn = nullptr;

    if (IN(0)) for (int rep = 0; rep < NREP(0); ++rep) {
        LAS float* scr = (LAS float*)(lds + wave * 16384);
        constexpr int I_WIN = 16 * 160, I_C1 = 32 * 8, I_AB = 8 * 32, I_OUT = 16 * 32, I_CQ = 16 * 16, I_CKV = 16 * 32, I_CO = 8 * 32;
        constexpr int NIT = I_WIN + 2 * I_C1 + 2 * I_AB + I_OUT + I_CQ + I_CKV + I_CO;
        for (int it = gw; it < NIT; it += NGW) {
            int r = it;
            if (r < I_WIN) { transpose_item(args.in[3], 1024, NIN, 160, (bf16*)(ws + WS_WIN_T), scr, r, lane); continue; } r -= I_WIN;
            if (r < I_C1) { transpose_item(args.in[7], 2048, 256, 8, (bf16*)(ws + WS_CKW1_T), scr, r, lane); continue; } r -= I_C1;
            if (r < I_C1) { transpose_item(args.in[9], 2048, 256, 8, (bf16*)(ws + WS_CVW1_T), scr, r, lane); continue; } r -= I_C1;
            if (r < I_AB) { transpose_item(args.in[11], 512, 1024, 32, (bf16*)(ws + WS_WA_T), scr, r, lane); continue; } r -= I_AB;
            if (r < I_AB) { transpose_item(args.in[12], 512, 1024, 32, (bf16*)(ws + WS_WB_T), scr, r, lane); continue; } r -= I_AB;
            if (r < I_OUT) { transpose_item(args.in[13], 1024, 1024, 32, (bf16*)(ws + WS_WOUT_T), scr, r, lane); continue; } r -= I_OUT;
            if (r < I_CQ) { transpose_item(args.in[16], 1024, 512, 16, (bf16*)(ws + WS_WCQ_T), scr, r, lane); continue; } r -= I_CQ;
            if (r < I_CKV) { transpose_item(args.in[17], 1024, 1024, 32, (bf16*)(ws + WS_WCKV_T), scr, r, lane); continue; } r -= I_CKV;
            transpose_item(args.in[18], 512, 1024, 32, (bf16*)(ws + WS_WCO_T), scr, r, lane);
        }
        STAMP(21);
        for (int m = gw; m < T; m += NGW) rms_row_to_bf16(x + (size_t)m * D, args.in[2], (bf16*)(ws + WS_U) + (size_t)m * D, lane);
        STAMP(22);
        for (int m = gw; m < 512; m += NGW) rms_row_to_bf16(args.in[1] + (size_t)m * D, args.in[15], (bf16*)(ws + WS_MEMN) + (size_t)m * D, lane);
        __syncthreads();
        {
            LAS float* skl = (LAS float*)lds;
            LAS float* wql = (LAS float*)(lds + 128 * 132 * 4);
            const float* SK = args.in[21]; const float* WQ = args.in[20];
            for (int item = bx; item < 256; item += G) {
                const int hc = item >> 4, k0 = (item & 15) * 64;
#pragma unroll 16
                for (int e = tid; e < 128 * 128; e += NTHR) { const int key = e >> 7, d = e & 127; skl[d * 132 + key] = SK[(size_t)(hc * 128 + key) * 128 + d]; }
#pragma unroll 16
                for (int e = tid; e < 64 * 128; e += NTHR) { const int k = e >> 7, d = e & 127; wql[d * 68 + k] = WQ[(size_t)(k0 + k) * 2048 + hc * 128 + d]; }
                __syncthreads();
                const int key4 = (tid & 31) * 4, kk4 = (tid >> 5) * 4;
                float acc[4][4];
#pragma unroll
                for (int i = 0; i < 4; ++i)
#pragma unroll
                    for (int j = 0; j < 4; ++j) acc[i][j] = 0.f;
                for (int d = 0; d < 128; ++d) {
                    const f32x4 av = *(const LAS f32x4*)(skl + d * 132 + key4), bv = *(const LAS f32x4*)(wql + d * 68 + kk4);
#pragma unroll
                    for (int i = 0; i < 4; ++i)
#pragma unroll
                        for (int j = 0; j < 4; ++j) acc[i][j] += av[i] * bv[j];
                }
#pragma unroll
                for (int i = 0; i < 4; ++i) { v2u w; w.x = pk2(acc[i][0], acc[i][1]); w.y = pk2(acc[i][2], acc[i][3]);
                    *(v2u*)((bf16*)(ws + WS_WPS_T) + (size_t)(hc * 128 + key4 + i) * 1024 + k0 + kk4) = w; }
                __syncthreads();
            }
        }
    }
    SEAM(0);
    if (IN(1)) for (int rep = 0; rep < NREP(1); ++rep) { ea.mode = EM_G1; run_gemm(lds, (const bf16*)(ws + WS_U), (const bf16*)(ws + WS_WIN_T), T, NIN_PAD, 1024, 1024, G, bx, ea); }
    SEAM(1);
    if (IN(2)) {
        if (bx < 64) {
            const int ci = bx >> 2, kv = ci >> 3, sp = ci & 7;
            ea.mode = EM_PART; ea.part = (float*)(ws + WS_HIDP) + (size_t)ci * 1024 * 256;
            run_gemm(lds, (const bf16*)(ws + (kv ? WS_VCI : WS_KCI)) + sp * 256, (const bf16*)(ws + (kv ? WS_CVW1_T : WS_CKW1_T)) + sp * 256, 1024, 256, 256, 2048, G, bx & 3, ea);
        } else if (bx >= 128 && bx < 136) {
            ea.mode = EM_KVMEM;
            run_gemm(lds, (const bf16*)(ws + WS_MEMN), (const bf16*)(ws + WS_WCKV_T), 512, 1024, 1024, 1024, G, bx - 128, ea);
        } else {
            const int cw = (bx < 128 ? bx - 64 : bx - 72) * NWAVES + wave, NCW = (G - 72) * NWAVES;
            const size_t NV = (size_t)16384 * 1024 / 16;
            for (size_t e = (size_t)cw * 64 + lane; e < 2 * NV; e += (size_t)NCW * 64) {
                const bool second = e >= NV; const size_t ee = second ? e - NV : e;
                const float* src = (second ? args.in[23] : args.in[22]) + ee * 16; unsigned char* dst = ws + (second ? WS_PV : WS_PU) + ee * 16;
                const float sc = second ? 16.f : 64.f;
                v4u w;
#pragma unroll
                for (int q = 0; q < 4; ++q) { const f32x4 a = *(const f32x4*)(src + 4 * q); int p = 0;
                    p = __builtin_amdgcn_cvt_pk_fp8_f32(a.x * sc, a.y * sc, p, false); p = __builtin_amdgcn_cvt_pk_fp8_f32(a.z * sc, a.w * sc, p, true); w[q] = (unsigned)p; }
                *(v4u*)dst = w;
            }
        }
    }
    SEAM(2);
    if (IN(3)) {
        LAS float* hl = (LAS float*)lds;
        const float* HP = (const float*)(ws + WS_HIDP);
        for (int it = bx; it < 256; it += G) {
            for (int e = tid; e < 2048; e += NTHR) { const int kv = e >> 10, rr = (e >> 8) & 3, c = e & 255, row = it * 4 + rr; float s_ = 0.f;
#pragma unroll
                for (int sp = 0; sp < 8; ++sp) s_ += HP[((size_t)((kv * 8 + sp) * 1024 + row)) * 256 + c];
                hl[e] = gelu_erf(s_); }
            __syncthreads();
            { const int kv = tid >> 8, rr = (tid >> 6) & 3, d = tid & 63, row = it * 4 + rr; const float* w2 = kv ? args.in[10] : args.in[8]; float a_ = 0.f;
#pragma unroll 32
              for (int j = 0; j < 256; ++j) a_ += hl[(kv * 4 + rr) * 256 + j] * w2[j * 64 + d];
              if (kv == 0) ((bf16*)(ws + WS_KCMP))[(size_t)row * 64 + d] = f2bf1(a_);
              else ((bf16*)(ws + WS_VCMP_T))[((size_t)((row >> 8) * 64 + d)) * 256 + (row & 255)] = f2bf1(a_); }
            __syncthreads();
        }
    }
    SEAM(3);
    if (IN(4)) for (int rep = 0; rep < NREP(4); ++rep) {
        const int xq = bx & 7;
        unsigned* qctrD = (unsigned*)(ws + WS_CTL) + 1024 + 64 * xq + 512 * rep;
        unsigned* qctrN = (unsigned*)(ws + WS_CTL) + 2048 + 64 * xq + 512 * rep;
        volatile LAS int* qslot = (volatile LAS int*)(lds + 131072 + 64);
        if (rep == 0 || REP_WHICH == 0) {
            for (;;) {
                if (tid == 0) *qslot = (int)atomicAdd(qctrD, 1u);
                __syncthreads();
                const int n = __builtin_amdgcn_readfirstlane(*qslot);
                __syncthreads();
                if (n >= 64) break;
                diff_wg_item(ws, args.in[4], args.in[5], xq, 63 - n, lds, tid, wave, lane);
            }
        }
        STAMP(20);
        if (rep == 0 || REP_WHICH == 1) {
            { const int bg_ = xq >> 1;
              const bf16* Kc = (const bf16*)(ws + WS_KCMP) + (size_t)(bg_ * 256) * 64; const bf16* Vc = (const bf16*)(ws + WS_VCMP_T) + (size_t)(bg_ * 64) * 256;
#pragma unroll 4
              for (int e = tid; e < 2048; e += NTHR) { const int row = e >> 3, c = e & 7; *(LAS v4u*)(lds + 40960 + (row >> 5) * 4096 + kswz(row & 31, c)) = *(const v4u*)(Kc + (size_t)row * 64 + c * 8); }
#pragma unroll 4
              for (int e = tid; e < 2048; e += NTHR) { const int row = e >> 5, cc = e & 31; *(LAS v4u*)(lds + 73728 + (cc >> 2) * 4096 + vswz(row, cc & 3)) = *(const v4u*)(Vc + (size_t)row * 256 + cc * 8); }
              __syncthreads(); }
            for (;;) {
                if (tid == 0) *qslot = (int)atomicAdd(qctrN, 1u);
                __syncthreads();
                const int n = __builtin_amdgcn_readfirstlane(*qslot);
                __syncthreads();
                if (n >= 128) break;
                nsa_wg_item(ws, xq >> 1, 255 - (2 * n + (xq & 1)), lds, tid, wave, lane);
            }
        }
    }
    SEAM(4);
    if (IN(5)) {
        ea.mode = EM_MA; run_gemm(lds, (const bf16*)(ws + WS_OA), (const bf16*)(ws + WS_WA_T), T, 1024, 512, 512, G, bx, ea);
        ea.mode = EM_MB; run_gemm(lds, (const bf16*)(ws + WS_OB), (const bf16*)(ws + WS_WB_T), T, 1024, 512, 512, G, bx, ea);
    }
    SEAM(5);
    if (IN(6)) { ea.mode = EM_H1; ea.gn = args.in[14]; run_gemm(lds, (const bf16*)(ws + WS_MERGED), (const bf16*)(ws + WS_WOUT_T), T, 1024, 1024, 1024, G, bx, ea); }
    SEAM(6);
    if (IN(8)) { ea.mode = EM_QC; run_gemm(lds, (const bf16*)(ws + WS_U), (const bf16*)(ws + WS_WCQ_T), T, 512, 1024, 1024, G, bx, ea); }
    SEAM(8);
    if (IN(9)) { const int nparts = (G >= 8) ? (G >> 3) : 1; if (G >= 8) { if (bx < nparts * 8) cross_wg(ws, bx & 7, bx >> 3, nparts, lds, tid, wave, lane); } else { for (int q = bx; q < 8; q += G) cross_wg(ws, q, 0, 1, lds, tid, wave, lane); } }
    SEAM(9);
    if (IN(10)) { ea.mode = EM_H2; ea.gn = args.in[19]; run_gemm(lds, (const bf16*)(ws + WS_OC), (const bf16*)(ws + WS_WCO_T), T, 1024, 512, 512, G, bx, ea); }
    SEAM(10);
    if (IN(12)) for (int rep = 0; rep < NREP(12); ++rep) { ea.mode = EM_SC; run_gemm(lds, (const bf16*)(ws + WS_U), (const bf16*)(ws + WS_WPS_T), T, 2048, 1024, 1024, G, bx, ea); }
    SEAM(12);
    if (IN(13)) for (int rep = 0; rep < NREP(13); ++rep) {
        for (int tok = gw; tok < T; tok += NGW) { int ln = lane; asm volatile("" : "+v"(ln)); peer_token(ws, args.in[24], args.out, tok, ln);
#ifdef LEAK_LO
            if (gw == 0) { float* op = args.out + (size_t)tok * 1024 + ln * 16;
                const unsigned long long* tsp = (const unsigned long long*)(ws + WS_CTL + 65536); const float ticks = (float)(long long)(tsp[LEAK_HI] - tsp[LEAK_LO]); const float leak_d = sqrtf(fmaxf(ticks, 0.f) * 2.5e-8f);
#pragma unroll
                for (int e = 0; e < 16; ++e) op[e] += leak_d; }
#endif
        } }
#undef IN
#undef SEAM
}

#ifndef N_LAUNCH_MODE
#define N_LAUNCH_MODE 1
#endif
extern "C" void kernel_launch(void* const* d_in, const int* in_sizes, int n_in, void* d_out, int out_size, void* d_ws, size_t ws_size, hipStream_t stream) {
    static int grid = 0;
    if (grid == 0) {
        if (n_in != 25 || out_size != T * D || ws_size < WS_END) { fprintf(stderr, "kernel_launch: unexpected shapes (n_in %d out %d ws %zu)\n", n_in, out_size, ws_size); grid = -1; return; }
        int dev = 0, cus = 0, per_cu = 0;
        hipGetDevice(&dev); hipDeviceGetAttribute(&cus, hipDeviceAttributeMultiprocessorCount, dev);
        if (hipFuncSetAttribute((const void*)hybrid_fwd, hipFuncAttributeMaxDynamicSharedMemorySize, LDS_BYTES) != hipSuccess) { fprintf(stderr, "kernel_launch: hipFuncSetAttribute failed\n"); grid = -1; return; }
        if (hipOccupancyMaxActiveBlocksPerMultiprocessor(&per_cu, (const void*)hybrid_fwd, NTHR, LDS_BYTES) != hipSuccess || per_cu < 1) { fprintf(stderr, "kernel_launch: occupancy query says %d\n", per_cu); per_cu = 1; }
        (void)hipGetLastError();
        grid = cus * 1;
        if (grid > 256) grid = 256;
    }
    if (grid < 0) return;
    hipMemsetAsync((char*)d_ws + WS_CTL, 0, CTL_BYTES, stream);
    Args a{};
    for (int i = 0; i < 25; ++i) a.in[i] = (const float*)d_in[i];
    a.out = (float*)d_out; a.ws = (unsigned char*)d_ws;
#if N_LAUNCH_MODE == 1
    a.ph_lo = 0; a.ph_hi = NPHASE;
    void* kargs[] = {&a};
    hipError_t e = hipLaunchCooperativeKernel((const void*)hybrid_fwd, dim3(grid), dim3(NTHR), kargs, LDS_BYTES, stream);
    if (e != hipSuccess) fprintf(stderr, "cooperative launch failed: %s (grid %d)\n", hipGetErrorString(e), grid);
#else
    for (int p = 0; p < NPHASE; ++p) { a.ph_lo = p; a.ph_hi = p + 1; hipLaunchKernelGGL(hybrid_fwd, dim3(grid), dim3(NTHR), LDS_BYTES, stream, a); }
#endif
}
```

```cpp
#include <hip/hip_runtime.h>
#include <hip/hip_cooperative_groups.h>
#include <cstdio>
#include <cstdint>
namespace cg = cooperative_groups;
namespace pg8 {
#define PG8_LAS __attribute__((address_space(3)))
typedef unsigned short bf16_t;
typedef short bf16x8 __attribute__((ext_vector_type(8)));
typedef float f32x4 __attribute__((ext_vector_type(4)));
typedef unsigned u32x4 __attribute__((ext_vector_type(4)));
constexpr int BM = 256, BK = 64, HALF = 128, HTB = HALF * BK * 2  , STAGE_BYTES = 8 * HTB, NXCD = 8, WGM = 8;

__host__ __device__ __forceinline__ int lds_byte(int r, int c) { const int st = (r >> 4) * 2 + (c >> 5), rr = r & 15, cc = c & 31, ob = rr * 64 + cc * 2; return st * 1024 + (ob ^ (((ob >> 9) & 1) << 5)); }
__host__ __device__ __forceinline__ void stage_rc(int b, int& R, int& C) { const int st = b / 1024, sb = b % 1024, swz = sb ^ (((sb >> 9) & 1) << 5); R = (st >> 1) * 16 + swz / 64; C = (st & 1) * 32 + (swz % 64) / 2; }
__host__ __device__ __forceinline__ int perm32(int rho) { const int n = rho >> 4, i = rho & 15; return 8 * (i >> 2) + 4 * n + (i & 3); }

struct Unit { int pm, pn; };
struct Gemm { const bf16_t* A; const bf16_t* Bt; int M, N, K, ld; };

struct StaticOrder {
    int nM, nN, nwg, G, c;
    __host__ __device__ void init(int M, int N, int G_, int c_) { nM = M / BM; nN = N / BM; nwg = nM * nN; G = G_; c = c_; }
    __host__ __device__ bool next(int i, Unit& u) const {
        const long L = (long)i * G + c; if (L >= nwg) return false;
        int wgid = (int)L; { const int q = nwg / NXCD, r = nwg % NXCD, xcd = wgid % NXCD, off = wgid / NXCD; wgid = (xcd < r ? xcd * (q + 1) : r * (q + 1) + (xcd - r) * q) + off; }
        const int nig = WGM * nN, gid = wgid / nig, fm = gid * WGM, gsz = (nM - fm) < WGM ? (nM - fm) : WGM;
        u.pm = fm + ((wgid % nig) % gsz); u.pn = (wgid % nig) / gsz; return true;
    }
    __device__ __forceinline__ void a_ready(const Unit&) const {}
    __device__ __forceinline__ void done(const Unit&) const {}
};

__device__ __forceinline__ unsigned cvt_pk_bf16(float lo, float hi) { unsigned r; asm volatile("v_cvt_pk_bf16_f32 %0, %1, %2" : "=v"(r) : "v"(lo), "v"(hi)); return r; }
template <class F> struct EpiF {
    static constexpr bool PERM = true, AFTER_DRAIN = false;
    F f;
    __device__ __forceinline__ void operator()(const f32x4 (&acc)[2][2][4][2], const Unit& u, int wr, int wc, int fr, int fq) const {
        const int row0 = u.pm * BM + wr * 64 + fr, col0 = u.pn * BM + wc * 32 + 8 * fq;
#pragma unroll
        for (int ai = 0; ai < 2; ++ai)
#pragma unroll
            for (int m = 0; m < 4; ++m)
#pragma unroll
                for (int bj = 0; bj < 2; ++bj) f(row0 + ai * HALF + m * 16, col0 + bj * HALF, acc[ai][bj][m][0], acc[ai][bj][m][1]);
    }
};
template <class Epi, class Sched, bool ALIGN_EPI = false, bool SP2 = false>
__device__ __forceinline__ void gemm_phase(PG8_LAS unsigned char* lds, const Gemm g, const Sched& S, const Epi& E) {
    const int tid = threadIdx.x, wid = __builtin_amdgcn_readfirstlane(tid >> 6), lane = tid & 63, wr = wid >> 2, wc = wid & 3, fr = lane & 15, fq = lane >> 4;
    const int K = g.K, nt = K / BK;
    unsigned voffA[2], voffB[2];
#pragma unroll
    for (int i = 0; i < 2; ++i) { int R, C; stage_rc(tid * 16 + i * 8192, R, C); const int Rb = Epi::PERM ? ((R & ~31) + perm32(R & 31)) : R;
        voffA[i] = (unsigned)(R * g.ld + C) * 2u; voffB[i] = (unsigned)(Rb * g.ld + C) * 2u; }
    const size_t kstep = (size_t)(BK * 2);
    const size_t hstep = (size_t)HALF * g.ld * 2;
    const size_t tstep = 2 * hstep;
    const unsigned ldsw = (unsigned)wid * 1024u;
    const int aoff = lds_byte(wr * 64 + fr, fq * 8), boff = lds_byte(wc * 32 + fr, fq * 8);
#define PG8_SA(b, h) (((b) * 2 + (h)) * HTB)
#define PG8_SB(b, h) ((4 + (b) * 2 + (h)) * HTB)
#define PG8_STAGE(bufoff, gbase, voff) do { _Pragma("unroll") for (int _i = 0; _i < 2; ++_i) \
        __builtin_amdgcn_global_load_lds((const unsigned*)((const char*)(gbase) + (voff)[_i]), (PG8_LAS unsigned*)(lds + (bufoff) + ldsw + _i * 8192), 16, 0, 0); } while (0)
#define PG8_LDA(dst, b, h) do { _Pragma("unroll") for (int m = 0; m < 4; ++m) _Pragma("unroll") for (int k = 0; k < 2; ++k) dst[m][k] = *(const PG8_LAS bf16x8*)(lds + PG8_SA(b, h) + aoff + m * 2048 + k * 1024); } while (0)
#define PG8_LDB(dst, b, h) do { _Pragma("unroll") for (int n = 0; n < 2; ++n) _Pragma("unroll") for (int k = 0; k < 2; ++k) dst[n][k] = *(const PG8_LAS bf16x8*)(lds + PG8_SB(b, h) + boff + n * 2048 + k * 1024); } while (0)
#define PG8_MMA(ai, bj, At, Bt) do { __builtin_amdgcn_s_setprio(1); _Pragma("unroll") for (int m = 0; m < 4; ++m) _Pragma("unroll") for (int n = 0; n < 2; ++n) _Pragma("unroll") for (int k = 0; k < 2; ++k) \
        acc[ai][bj][m][n] = __builtin_amdgcn_mfma_f32_16x16x32_bf16(Bt[n][k], At[m][k], acc[ai][bj][m][n], 0, 0, 0); __builtin_amdgcn_s_setprio(0); } while (0)
#define PG8_WAIT_V(n) asm volatile("s_waitcnt vmcnt(" #n ")" ::: "memory")
#define PG8_WAIT_L(n) asm volatile("s_waitcnt lgkmcnt(" #n ")" ::: "memory")
#define PG8_BAR __builtin_amdgcn_s_barrier()
#define PG8_SCHED __builtin_amdgcn_sched_barrier(0)
    Unit cur, nxt; int ui = 0;
    if (!S.next(0, cur)) return;
    f32x4 acc[2][2][4][2];
#pragma unroll
    for (int a = 0; a < 2; ++a)
#pragma unroll
        for (int b = 0; b < 2; ++b)
#pragma unroll
            for (int m = 0; m < 4; ++m)
#pragma unroll
                for (int n = 0; n < 2; ++n) acc[a][b][m][n] = (f32x4){0.f, 0.f, 0.f, 0.f};
    bf16x8 At[4][2], B0[2][2], B1[2][2];
    const char* cA = (const char*)g.A + (size_t)cur.pm * tstep; const char* cB = (const char*)g.Bt + (size_t)cur.pn * tstep;
    S.a_ready(cur);
    if constexpr (SP2) {
        PG8_STAGE(PG8_SB(0, 0), cB, voffB); PG8_STAGE(PG8_SB(0, 1), cB + hstep, voffB); PG8_STAGE(PG8_SA(0, 0), cA, voffA); PG8_STAGE(PG8_SA(0, 1), cA + hstep, voffA);
        if (wr == 1) PG8_BAR;
        PG8_WAIT_V(2); PG8_BAR;
        PG8_STAGE(PG8_SB(1, 0), cB + kstep, voffB); PG8_STAGE(PG8_SA(1, 0), cA + kstep, voffA); PG8_STAGE(PG8_SB(1, 1), cB + hstep + kstep, voffB);
        PG8_WAIT_V(6); PG8_BAR;
    } else {
        PG8_STAGE(PG8_SB(0, 0), cB, voffB); PG8_STAGE(PG8_SA(0, 0), cA, voffA); PG8_STAGE(PG8_SB(0, 1), cB + hstep, voffB); PG8_STAGE(PG8_SA(0, 1), cA + hstep, voffA);
        if (wr == 1) PG8_BAR;
        PG8_WAIT_V(4); PG8_BAR;
        PG8_STAGE(PG8_SB(1, 0), cB + kstep, voffB); PG8_STAGE(PG8_SA(1, 0), cA + kstep, voffA); PG8_STAGE(PG8_SB(1, 1), cB + hstep + kstep, voffB);
        PG8_WAIT_V(6); PG8_BAR;
    }
    for (;;) {
        const bool has_next = S.next(ui + 1, nxt);
        const char* nA = has_next ? (const char*)g.A + (size_t)nxt.pm * tstep : cA; const char* nB = has_next ? (const char*)g.Bt + (size_t)nxt.pn * tstep : cB;
        for (int t = 0; t < nt; t += 2) {
            const bool last = (t == nt - 2);
            const char* a1 = cA + (size_t)(t + 1) * kstep;
            const char* a2 = last ? nA : cA + (size_t)(t + 2) * kstep; const char* b2 = last ? nB : cB + (size_t)(t + 2) * kstep;
            const char* a3 = a2 + kstep; const char* b3 = b2 + kstep;
            if (last && has_next) S.a_ready(nxt);
            if constexpr (SP2) {
            PG8_LDB(B0, 0, 0); PG8_LDB(B1, 0, 1); PG8_SCHED; PG8_LDA(At, 0, 0); PG8_STAGE(PG8_SA(1, 1), a1 + hstep, voffA);
            PG8_WAIT_V(8); PG8_WAIT_L(0); PG8_BAR; PG8_MMA(0, 0, At, B0); PG8_MMA(0, 1, At, B1); PG8_BAR; PG8_SCHED;
            PG8_LDA(At, 0, 1); PG8_STAGE(PG8_SB(0, 0), b2, voffB); PG8_STAGE(PG8_SB(0, 1), b2 + hstep, voffB); PG8_STAGE(PG8_SA(0, 0), a2, voffA);
            PG8_WAIT_V(8); PG8_WAIT_L(0); PG8_BAR; PG8_MMA(1, 0, At, B0); PG8_MMA(1, 1, At, B1); PG8_BAR; PG8_SCHED;
            PG8_LDB(B0, 1, 0); PG8_LDB(B1, 1, 1); PG8_SCHED; PG8_LDA(At, 1, 0); PG8_STAGE(PG8_SA(0, 1), a2 + hstep, voffA);
            PG8_WAIT_V(8); PG8_WAIT_L(0); PG8_BAR; PG8_MMA(0, 0, At, B0); PG8_MMA(0, 1, At, B1); PG8_BAR; PG8_SCHED;
            PG8_LDA(At, 1, 1); PG8_STAGE(PG8_SB(1, 0), b3, voffB); PG8_STAGE(PG8_SB(1, 1), b3 + hstep, voffB); PG8_STAGE(PG8_SA(1, 0), a3, voffA);
            PG8_WAIT_V(8); PG8_WAIT_L(0); PG8_BAR; PG8_MMA(1, 0, At, B0); PG8_MMA(1, 1, At, B1); PG8_BAR; PG8_SCHED;
            } else {
            PG8_LDB(B0, 0, 0); PG8_SCHED; PG8_LDA(At, 0, 0); PG8_STAGE(PG8_SA(1, 1), a1 + hstep, voffA);
            PG8_WAIT_L(8); PG8_BAR; PG8_WAIT_L(0); PG8_MMA(0, 0, At, B0); PG8_BAR; PG8_SCHED;
            PG8_LDB(B1, 0, 1); PG8_STAGE(PG8_SB(0, 0), b2, voffB);
            PG8_BAR; PG8_WAIT_L(0); PG8_MMA(0, 1, At, B1); PG8_BAR;
            PG8_LDA(At, 0, 1); PG8_STAGE(PG8_SA(0, 0), a2, voffA);
            PG8_BAR; PG8_WAIT_L(0); PG8_MMA(1, 0, At, B0); PG8_BAR; PG8_SCHED;
            PG8_STAGE(PG8_SB(0, 1), b2 + hstep, voffB);
            PG8_WAIT_V(6); PG8_BAR; PG8_MMA(1, 1, At, B1); PG8_BAR;
            PG8_LDB(B0, 1, 0); PG8_SCHED; PG8_LDA(At, 1, 0); PG8_STAGE(PG8_SA(0, 1), a2 + hstep, voffA);
            PG8_WAIT_L(8); PG8_BAR; PG8_WAIT_L(0); PG8_MMA(0, 0, At, B0); PG8_BAR; PG8_SCHED;
            PG8_LDB(B1, 1, 1); PG8_STAGE(PG8_SB(1, 0), b3, voffB);
            PG8_BAR; PG8_WAIT_L(0); PG8_MMA(0, 1, At, B1); PG8_BAR;
            PG8_LDA(At, 1, 1); PG8_STAGE(PG8_SA(1, 0), a3, voffA);
            PG8_BAR; PG8_WAIT_L(0); PG8_MMA(1, 0, At, B0); PG8_BAR; PG8_SCHED;
            PG8_STAGE(PG8_SB(1, 1), b3 + hstep, voffB);
            PG8_WAIT_V(6); PG8_BAR; PG8_MMA(1, 1, At, B1); PG8_BAR;
            }
        }
        if constexpr (ALIGN_EPI) { if (wr == 0) PG8_BAR; }
        if constexpr (!Epi::AFTER_DRAIN) { E(acc, cur, wr, wc, fr, fq); S.done(cur); }
        if (!has_next) break;
#pragma unroll
        for (int a = 0; a < 2; ++a)
#pragma unroll
            for (int b = 0; b < 2; ++b)
#pragma unroll
                for (int m = 0; m < 4; ++m)
#pragma unroll
                    for (int n = 0; n < 2; ++n) acc[a][b][m][n] = (f32x4){0.f, 0.f, 0.f, 0.f};
        cur = nxt; cA = nA; cB = nB; ++ui;
        if constexpr (ALIGN_EPI) { if (wr == 1) PG8_BAR; }
    }
    PG8_WAIT_V(0);
    if constexpr (!ALIGN_EPI) { if (wr == 0) PG8_BAR; }
    PG8_BAR;
    if constexpr (Epi::AFTER_DRAIN) { E.fused(acc, cur, wr, wc, fr, fq, lds, wid, lane); S.done(cur); }
#undef PG8_SA
#undef PG8_SB
#undef PG8_STAGE
#undef PG8_LDA
#undef PG8_LDB
#undef PG8_MMA
#undef PG8_WAIT_V
#undef PG8_WAIT_L
#undef PG8_BAR
#undef PG8_SCHED
}
}

#define LAS __attribute__((address_space(3)))
typedef unsigned short bf16;
typedef unsigned v4u __attribute__((ext_vector_type(4)));
typedef unsigned v2u __attribute__((ext_vector_type(2)));
typedef float f32x4 __attribute__((ext_vector_type(4)));
typedef float f32x2 __attribute__((ext_vector_type(2)));
typedef short bf16x8 __attribute__((ext_vector_type(8)));
#define LDS_WAIT() asm volatile("s_waitcnt lgkmcnt(0)" ::: "memory")
#define MFMA16(a, b, c) __builtin_amdgcn_mfma_f32_16x16x32_bf16((a), (b), (c), 0, 0, 0)

constexpr int NWAVES = 8, NTHR = 512;
constexpr int NB = 2, S = 8192, T = NB * S, D = 1024;
constexpr int LDS_BYTES = 147456;
constexpr float LOG2E = 1.4426950408889634f;
constexpr int NIN = 4888, NIN_PAD = 5120;

constexpr size_t MiB = 1u << 20;
constexpr size_t WS_CTL = 0, CTL_BYTES = 1 * MiB;
constexpr size_t WS_MEMN = 1 * MiB, WS_WIN_T = 2 * MiB, WS_CKW1_T = 12 * MiB, WS_CVW1_T = 13 * MiB, WS_WA_T = 14 * MiB, WS_WB_T = 15 * MiB, WS_WOUT_T = 16 * MiB,
                 WS_WCQ_T = 18 * MiB, WS_WCKV_T = 19 * MiB, WS_WCO_T = 21 * MiB, WS_WPS_T = 22 * MiB;
constexpr size_t WS_KCMP = 26 * MiB, WS_VCMP_T = 26 * MiB + 256 * 1024, WS_KMEM = 27 * MiB, WS_VMEM_T = 27 * MiB + 512 * 1024, WS_GB = 28 * MiB;
constexpr size_t WS_U = 32 * MiB;
constexpr size_t WS_QA = 64 * MiB, WS_KA = 80 * MiB, WS_VAT = 96 * MiB, WS_QB = 112 * MiB;
constexpr size_t WS_PU = 152 * MiB, WS_PV = 168 * MiB;
constexpr size_t WS_MERGED = 64 * MiB;
constexpr size_t WS_SS1 = WS_CTL + 131072, WS_SS2 = WS_CTL + 196608;
constexpr size_t WS_KCI = 128 * MiB, WS_VCI = 132 * MiB, WS_KS = 136 * MiB, WS_VST = 140 * MiB, WS_KW = 144 * MiB, WS_VWT = 148 * MiB;
constexpr size_t WS_OA = 32 * MiB, WS_OB = 48 * MiB, WS_HIDP = 32 * MiB;
constexpr size_t WS_GA = 184 * MiB, WS_GBT = 216 * MiB;
constexpr size_t WS_H = 192 * MiB;
constexpr size_t WS_QC = 96 * MiB, WS_OC = 112 * MiB, WS_SCORES = 64 * MiB;
constexpr size_t WS_END = 256 * MiB;

__device__ __forceinline__ unsigned pk2(float lo, float hi) { return pg8::cvt_pk_bf16(lo, hi); }
typedef __bf16 bf16x2_t __attribute__((ext_vector_type(2)));
__device__ __forceinline__ unsigned pk2s(float lo, float hi) { typedef float f2_ __attribute__((ext_vector_type(2))); const f2_ v = {lo, hi}; const bf16x2_t b = __builtin_convertvector(v, bf16x2_t); return __builtin_bit_cast(unsigned, b); }
__device__ __forceinline__ unsigned short f2bf1(float f) { return (unsigned short)(pk2(f, 0.f) & 0xffffu); }
__device__ __forceinline__ float bflo(unsigned u) { return __builtin_bit_cast(float, u << 16); }
__device__ __forceinline__ float bfhi(unsigned u) { return __builtin_bit_cast(float, u & 0xffff0000u); }
__device__ __forceinline__ float wave_sum(float v) {
#pragma unroll
    for (int o = 1; o < 64; o <<= 1) v += __shfl_xor(v, o);
    return v;
}
__device__ __forceinline__ float sigm(float x) { return __builtin_amdgcn_rcpf(1.f + __builtin_amdgcn_exp2f(x * -1.4426950408889634f)); }
__device__ __forceinline__ float gelu_erf(float x) { return 0.5f * x * (1.f + erff(x * 0.70710678118654752f)); }
__device__ __forceinline__ float ex2(float x) { return __builtin_amdgcn_exp2f(x); }
__device__ __forceinline__ float gelu_poly(float v) {
    const float t = __builtin_amdgcn_rcpf(__builtin_fabsf(v) * 0.2316418882f + 1.0f);
    float q = t * 0.5307027145f + (-0.7265760135f); q = q * t + 0.7107068705f; q = q * t + (-0.142248368f); q = q * t + 0.127414796f; q = q * t;
    const float m = v * (q * __builtin_amdgcn_exp2f((v * v) * (-0.72134752044f)));
    return v < 0.f ? m : v - m;
}
__device__ __forceinline__ void store8bf(bf16* dst, const float* v) { v4u w; w.x = pk2(v[0], v[1]); w.y = pk2(v[2], v[3]); w.z = pk2(v[4], v[5]); w.w = pk2(v[6], v[7]); *(v4u*)dst = w; }
__device__ __forceinline__ bf16x8 ldg8(const bf16* p) { return *(const bf16x8*)p; }
__device__ __forceinline__ bf16x8 pack8(float a0, float a1, float a2, float a3, float a4, float a5, float a6, float a7) {
    v4u w; w.x = pk2s(a0, a1); w.y = pk2s(a2, a3); w.z = pk2s(a4, a5); w.w = pk2s(a6, a7); return __builtin_bit_cast(bf16x8, w);
}

struct Args { const float* in[25]; float* out; unsigned char* ws; int ph_lo, ph_hi; };

enum { EM_G1 = 0, EM_PART, EM_KVMEM, EM_MA, EM_MB, EM_H1, EM_QC, EM_H2, EM_SC };
struct EpiAll {
    int mode; unsigned char* ws; const float* x; const float* cmp_pos; float* part; const float* gn;
    __device__ __forceinline__ void norm_side(const f32x4& h0, const f32x4& h1_, int row, int col, float* ss) const {
        const f32x4 g0 = *(const f32x4*)(gn + col), g1 = *(const f32x4*)(gn + col + 4);
        const float u[8] = {h0[0] * g0[0], h0[1] * g0[1], h0[2] * g0[2], h0[3] * g0[3], h1_[0] * g1[0], h1_[1] * g1[1], h1_[2] * g1[2], h1_[3] * g1[3]};
        store8bf((bf16*)(ws + WS_U) + (size_t)row * 1024 + col, u);
        float s_ = (h0[0] * h0[0] + h0[1] * h0[1]) + (h0[2] * h0[2] + h0[3] * h0[3]) + (h1_[0] * h1_[0] + h1_[1] * h1_[1]) + (h1_[2] * h1_[2] + h1_[3] * h1_[3]);
        s_ += __shfl_xor(s_, 16); s_ += __shfl_xor(s_, 32);
        if ((threadIdx.x & 48) == 0) atomicAdd(ss + row, s_);
    }
    __device__ __forceinline__ void operator()(int row, int col, const f32x4& v0, const f32x4& v1) const {
        float v[8] = {v0[0], v0[1], v0[2], v0[3], v1[0], v1[1], v1[2], v1[3]};
        switch (mode) {
        case EM_G1: {
            if (col >= NIN) return;
            const int b = row >> 13, s = row & (S - 1);
            if (col < 1024) {
                const bool isq = col < 512; bf16* dst = (bf16*)(ws + (isq ? WS_QA : WS_KA)) + (size_t)row * 512 + (col & 511);
                const float sc = isq ? 0.125f * LOG2E : 1.f;
#pragma unroll
                for (int i = 0; i < 8; ++i) v[i] *= sc;
                store8bf(dst, v);
            } else if (col < 1536) {
                bf16* dst = (bf16*)(ws + WS_VAT) + (size_t)(b * 512 + (col - 1024)) * S + s;
#pragma unroll
                for (int i = 0; i < 8; ++i) dst[(size_t)i * S] = f2bf1(v[i]);
            } else if (col < 2048) {
#pragma unroll
                for (int i = 0; i < 8; ++i) v[i] *= 0.125f * LOG2E;
                store8bf((bf16*)(ws + WS_QB) + (size_t)row * 512 + (col - 1536), v);
            } else if (col < 2816) {
                const int c2 = col - 2048, j = c2 >> 7, gg = (c2 >> 6) & 1, d = c2 & 63; const size_t bg = (size_t)(b * 2 + gg);
                if (j == 0 || j == 1) {
                    const float* cp = cmp_pos + (s & 31) * 64 + d;
#pragma unroll
                    for (int i = 0; i < 8; ++i) v[i] += cp[i];
                    store8bf((bf16*)(ws + (j == 0 ? WS_KCI : WS_VCI)) + (bg * S + s) * 64 + d, v);
                } else if (j == 2 || j == 4) {
                    store8bf((bf16*)(ws + (j == 2 ? WS_KS : WS_KW)) + (bg * S + s) * 64 + d, v);
                } else {
                    bf16* dst = (bf16*)(ws + (j == 3 ? WS_VST : WS_VWT)) + (bg * 64 + d) * S + s;
#pragma unroll
                    for (int i = 0; i < 8; ++i) dst[(size_t)i * S] = f2bf1(v[i]);
                }
            } else if (col < 2840) {
                float* dst = (float*)(ws + WS_GB) + (size_t)row * 24 + (col - 2816);
                *(f32x4*)dst = (f32x4){sigm(v[0]), sigm(v[1]), sigm(v[2]), sigm(v[3])}; *(f32x4*)(dst + 4) = (f32x4){sigm(v[4]), sigm(v[5]), sigm(v[6]), sigm(v[7])};
            } else {
                const bool ia = col < 3864; bf16* dst = (bf16*)(ws + (ia ? WS_GA : WS_GBT)) + (size_t)row * 1024 + (col - (ia ? 2840 : 3864));
#pragma unroll
                for (int i = 0; i < 8; ++i) v[i] = sigm(v[i]);
                store8bf(dst, v);
            }
        } break;
        case EM_PART: { float* dst = part + (size_t)row * 256 + col; *(f32x4*)dst = v0; *(f32x4*)(dst + 4) = v1; } break;
        case EM_KVMEM: {
            const int b = row >> 8, m = row & 255, c2 = col & 511, h = c2 >> 7, d = c2 & 127;
            if (col < 512) store8bf((bf16*)(ws + WS_KMEM) + ((size_t)((b * 4 + h) * 256 + m)) * 128 + d, v);
            else { bf16* dst = (bf16*)(ws + WS_VMEM_T) + ((size_t)((b * 4 + h) * 128 + d)) * 256 + m;
#pragma unroll
                for (int i = 0; i < 8; ++i) dst[i * 256] = f2bf1(v[i]); }
        } break;
        case EM_MA: {
            const v4u gq = *(const v4u*)((const bf16*)(ws + WS_GA) + (size_t)row * 1024 + col);
            const float g[8] = {bflo(gq.x), bfhi(gq.x), bflo(gq.y), bfhi(gq.y), bflo(gq.z), bfhi(gq.z), bflo(gq.w), bfhi(gq.w)};
#pragma unroll
            for (int i = 0; i < 8; ++i) v[i] *= g[i];
            store8bf((bf16*)(ws + WS_MERGED) + (size_t)row * 1024 + col, v);
        } break;
        case EM_MB: {
            const v4u gq = *(const v4u*)((const bf16*)(ws + WS_GBT) + (size_t)row * 1024 + col);
            bf16* mp = (bf16*)(ws + WS_MERGED) + (size_t)row * 1024 + col; const v4u mq = *(const v4u*)mp;
            const float g[8] = {bflo(gq.x), bfhi(gq.x), bflo(gq.y), bfhi(gq.y), bflo(gq.z), bfhi(gq.z), bflo(gq.w), bfhi(gq.w)};
            const float mm[8] = {bflo(mq.x), bfhi(mq.x), bflo(mq.y), bfhi(mq.y), bflo(mq.z), bfhi(mq.z), bflo(mq.w), bfhi(mq.w)};
#pragma unroll
            for (int i = 0; i < 8; ++i) v[i] = mm[i] + g[i] * v[i];
            store8bf(mp, v);
        } break;
        case EM_H1: {
            const float* xp = x + (size_t)row * 1024 + col; float* hp = (float*)(ws + WS_H) + (size_t)row * 1024 + col;
            const f32x4 x0 = *(const f32x4*)xp, x1 = *(const f32x4*)(xp + 4);
            const f32x4 h0 = x0 + v0, h1_ = x1 + v1;
            *(f32x4*)hp = h0; *(f32x4*)(hp + 4) = h1_;
            norm_side(h0, h1_, row, col, (float*)(ws + WS_SS1));
        } break;
        case EM_QC: {
            const float rs_ = rsqrtf(__hip_atomic_load((const float*)(ws + WS_SS1) + row, __ATOMIC_RELAXED, __HIP_MEMORY_SCOPE_AGENT) * (1.f / 1024.f) + 1e-6f) * 0.08838834764831845f;
#pragma unroll
            for (int i = 0; i < 8; ++i) v[i] *= rs_;
            store8bf((bf16*)(ws + WS_QC) + (size_t)row * 512 + col, v);
        } break;
        case EM_H2: {
            float* hp = (float*)(ws + WS_H) + (size_t)row * 1024 + col;
            const f32x4 x0 = *(const f32x4*)hp, x1 = *(const f32x4*)(hp + 4);
            const f32x4 h0 = x0 + v0, h1_ = x1 + v1;
            *(f32x4*)hp = h0; *(f32x4*)(hp + 4) = h1_;
            norm_side(h0, h1_, row, col, (float*)(ws + WS_SS2));
        } break;
        default: {
            const float rs_ = rsqrtf(__hip_atomic_load((const float*)(ws + WS_SS2) + row, __ATOMIC_RELAXED, __HIP_MEMORY_SCOPE_AGENT) * (1.f / 1024.f) + 1e-6f);
#pragma unroll
            for (int i = 0; i < 8; ++i) v[i] *= rs_;
            store8bf((bf16*)(ws + WS_SCORES) + (size_t)row * 2048 + col, v);
        } break;
        }
    }
};
typedef pg8::EpiF<EpiAll> EpiT;

__device__ __forceinline__ void run_gemm(LAS unsigned char* lds, const bf16* A, const bf16* Bt, int M, int N, int K, int ld, int G, int c, const EpiAll& ea) {
    pg8::Gemm g{A, Bt, M, N, K, ld}; pg8::StaticOrder So; So.init(M, N, G, c);
    EpiT E{ea};
    pg8::gemm_phase<EpiT, pg8::StaticOrder, true, true>(lds, g, So, E);
}

__device__ __forceinline__ void transpose_item(const float* W, int K, int Nsrc, int nblk, bf16* WT, LAS float* scr, int item, int lane) {
    const int kb = item / nblk, nb = item % nblk, k0 = 64 * kb, n0 = 32 * nb; const int nq = n0 + 4 * (lane & 7);
#pragma unroll
    for (int i = 0; i < 8; ++i) { const int kk = 8 * i + (lane >> 3);
        const f32x4 v = (nq < Nsrc) ? *(const f32x4*)(W + (size_t)(k0 + kk) * Nsrc + nq) : (f32x4){0.f, 0.f, 0.f, 0.f};
        LAS float* d = scr + kk * 33 + 4 * (lane & 7); d[0] = v.x; d[1] = v.y; d[2] = v.z; d[3] = v.w; }
    LDS_WAIT();
    const int c = lane & 7;
#pragma unroll
    for (int j = 0; j < 4; ++j) { const int nn = (lane >> 3) + 8 * j; const LAS float* s = scr + (8 * c) * 33 + nn;
        v4u o; o.x = pk2(s[0 * 33], s[1 * 33]); o.y = pk2(s[2 * 33], s[3 * 33]); o.z = pk2(s[4 * 33], s[5 * 33]); o.w = pk2(s[6 * 33], s[7 * 33]);
        *(v4u*)(WT + (size_t)(n0 + nn) * K + k0 + 8 * c) = o; }
    LDS_WAIT();
}
__device__ __forceinline__ void rms_row_to_bf16(const float* xrow, const float* g, bf16* orow, int lane) {
    const f32x4* xr = (const f32x4*)xrow + lane; const f32x4* gr = (const f32x4*)g + lane;
    f32x4 v[4]; float s = 0.f;
#pragma unroll
    for (int j = 0; j < 4; ++j) { v[j] = xr[64 * j]; s += (v[j].x * v[j].x + v[j].y * v[j].y) + (v[j].z * v[j].z + v[j].w * v[j].w); }
    const float rstd = rsqrtf(wave_sum(s) * (1.f / D) + 1e-6f);
    v2u* o8 = (v2u*)orow + lane;
#pragma unroll
    for (int j = 0; j < 4; ++j) { const f32x4 gg = gr[64 * j]; v2u w; w.x = pk2(v[j].x * rstd * gg.x, v[j].y * rstd * gg.y); w.y = pk2(v[j].z * rstd * gg.z, v[j].w * rstd * gg.w); o8[64 * j] = w; }
}


__device__ __forceinline__ int kswz(int row, int c) { const int F = (0x1320 >> (((row >> 3) & 3) * 4)) & 3; return row * 128 + ((c ^ (F | (((row >> 1) & 1) << 2))) << 4); }
__device__ __forceinline__ int vswz(int row, int c) { const int F = (0x1320 >> (((row >> 2) & 3) * 4)) & 3; return row * 64 + ((c ^ F) << 4); }
__device__ __forceinline__ void diff_wg_item(unsigned char* ws, const float* lamp, const float* subln, int bh, int qb, LAS unsigned char* lds, int tid, int wave, int lane) {
    const int b = bh >> 2, h = bh & 3, fr = lane & 15, fq = lane >> 4, wv = wave & 3, cm = wave >> 2;
    const int q0 = qb * 128 + wv * 32, lastkb = qb * 4 + wv, nsteps = qb * 4 + 4;
    float lam;
    { const float a = lamp[lane] * lamp[64 + lane], c = lamp[128 + lane] * lamp[192 + lane]; lam = __expf(wave_sum(a)) - __expf(wave_sum(c)) + 0.2f; }
    const float slope2 = ex2(-2.f * (float)(h + 1)) * LOG2E;
    const bf16* Qb = (const bf16*)(ws + WS_QA) + (size_t)(b * S) * 512 + h * 128;
    const bf16* Kb = (const bf16*)(ws + WS_KA) + (size_t)(b * S) * 512 + h * 128;
    const bf16* Vb = (const bf16*)(ws + WS_VAT) + (size_t)((b * 4 + h) * 128) * S;
    const int kr0 = 8 * (fr >> 2) + (fr & 3);
    const bf16* gA = Kb + (size_t)((tid & 255) >> 3) * 512 + (tid >> 8) * 64 + (tid & 7) * 8;
    const int lA = (tid >> 8) * 4096 + kswz((tid & 255) >> 3, tid & 7);
    const bf16* gB = Vb + (size_t)(tid >> 2) * S + (tid & 3) * 8;
    const int lB = 8192 + vswz(tid >> 2, tid & 3);
    bf16x8 Qf[2][2];
#pragma unroll
    for (int nt = 0; nt < 2; ++nt)
#pragma unroll
        for (int ks = 0; ks < 2; ++ks) Qf[nt][ks] = ldg8(Qb + (size_t)(q0 + nt * 16 + fr) * 512 + cm * 64 + ks * 32 + fq * 8);
    f32x4 O[8][2];
#pragma unroll
    for (int mt = 0; mt < 8; ++mt) { O[mt][0] = (f32x4){0.f, 0.f, 0.f, 0.f}; O[mt][1] = (f32x4){0.f, 0.f, 0.f, 0.f}; }
    float moff[2] = {0.f, 0.f}; f32x4 Lacc[2] = {(f32x4){0.f, 0.f, 0.f, 0.f}, (f32x4){0.f, 0.f, 0.f, 0.f}};
    const bf16x8 ones8 = {(short)0x3f80, (short)0x3f80, (short)0x3f80, (short)0x3f80, (short)0x3f80, (short)0x3f80, (short)0x3f80, (short)0x3f80};
    int koff[2][2];
#pragma unroll
    for (int t = 0; t < 2; ++t)
#pragma unroll
        for (int ks = 0; ks < 2; ++ks) koff[t][ks] = cm * 4096 + kswz(kr0 + 4 * t, ks * 4 + fq);
    const int voff = 8192 + vswz(fr, fq);
    float cst[8];
#pragma unroll
    for (int i = 0; i < 8; ++i) cst[i] = slope2 * (float)i;
    __builtin_amdgcn_s_waitcnt(0x0F70);
    const int nbs = nsteps >> 1;
    v4u ra0[2], rb0[2], ra1[2], rb1[2];
#pragma unroll
    for (int h = 0; h < 2; ++h) { const v4u a0 = *(const v4u*)(gA + (size_t)h * 32 * 512), b0 = *(const v4u*)(gB + h * 32); *(LAS v4u*)(lds + h * 16384 + lA) = a0; *(LAS v4u*)(lds + h * 16384 + lB) = b0; }
#pragma unroll
    for (int h = 0; h < 2; ++h) { ra1[h] = *(const v4u*)(gA + (size_t)(2 + h) * 32 * 512); rb1[h] = *(const v4u*)(gB + (2 + h) * 32); }
#pragma unroll
    for (int h = 0; h < 2; ++h) { const int kl = (2 < nbs) ? 4 + h : 2 + h; ra0[h] = *(const v4u*)(gA + (size_t)kl * 32 * 512); rb0[h] = *(const v4u*)(gB + kl * 32); }
    asm volatile("s_waitcnt lgkmcnt(0)\n\ts_barrier" ::: "memory");
#define DIFF_STEP(KK, CURB, NXTB, RA, RB) do { \
      _Pragma("unroll") for (int hh = 0; hh < 2; ++hh) { const int kb = 2 * (KK) + hh; const int cur = (CURB) + hh * 16384; \
        if (kb <= lastkb) { \
            __builtin_amdgcn_s_setprio(1); \
            bf16x8 Kc[2][2]; \
            _Pragma("unroll") for (int t = 0; t < 2; ++t) _Pragma("unroll") for (int ks = 0; ks < 2; ++ks) Kc[t][ks] = *(const LAS bf16x8*)(lds + cur + koff[t][ks]); \
            bf16x8 Vf[8]; \
            _Pragma("unroll") for (int mt = 0; mt < 8; ++mt) Vf[mt] = *(const LAS bf16x8*)(lds + cur + voff + mt * 1024); \
            const float kb0 = slope2 * (float)(kb * 32 + fq * 8); \
            f32x4 Sx[2][2]; \
            __builtin_amdgcn_s_setprio(1); \
            _Pragma("unroll") for (int nt = 0; nt < 2; ++nt) { const float base = kb0 - moff[nt]; \
                _Pragma("unroll") for (int t = 0; t < 2; ++t) { f32x4 z = {base + cst[4 * t], base + cst[4 * t + 1], base + cst[4 * t + 2], base + cst[4 * t + 3]}; \
                    z = MFMA16(Kc[t][0], Qf[nt][0], z); Sx[t][nt] = MFMA16(Kc[t][1], Qf[nt][1], z); } } \
            __builtin_amdgcn_s_setprio(0); \
            const bool diag = (kb == lastkb); \
            bf16x8 Pf[2]; \
            _Pragma("unroll") for (int nt = 0; nt < 2; ++nt) { \
                float sv[8] = {Sx[0][nt][0], Sx[0][nt][1], Sx[0][nt][2], Sx[0][nt][3], Sx[1][nt][0], Sx[1][nt][1], Sx[1][nt][2], Sx[1][nt][3]}; \
                if (diag) { const int dq = q0 + nt * 16 + fr - (kb * 32 + fq * 8); \
                    _Pragma("unroll") for (int i = 0; i < 8; ++i) sv[i] = (i <= dq) ? sv[i] : -1e30f; } \
                float mx = fmaxf(fmaxf(fmaxf(fmaxf(sv[0], sv[1]), sv[2]), fmaxf(fmaxf(sv[3], sv[4]), sv[5])), fmaxf(sv[6], sv[7])); \
                mx = fmaxf(mx, __shfl_xor(mx, 16)); mx = fmaxf(mx, __shfl_xor(mx, 32)); \
                if (__ballot(mx > 64.f) != 0ull) { \
                    const float dl = fmaxf(mx, 0.f), alpha = ex2(-dl); moff[nt] += dl; Lacc[nt] *= alpha; \
                    _Pragma("unroll") for (int mt = 0; mt < 8; ++mt) O[mt][nt] *= alpha; \
                    _Pragma("unroll") for (int i = 0; i < 8; ++i) sv[i] -= dl; \
                } \
                _Pragma("unroll") for (int i = 0; i < 8; ++i) sv[i] = ex2(sv[i]); \
                Pf[nt] = pack8(sv[0], sv[1], sv[2], sv[3], sv[4], sv[5], sv[6], sv[7]); \
                __builtin_amdgcn_s_setprio(1); \
                _Pragma("unroll") for (int mt = 0; mt < 8; ++mt) O[mt][nt] = MFMA16(Vf[mt], Pf[nt], O[mt][nt]); \
                Lacc[nt] = MFMA16(ones8, Pf[nt], Lacc[nt]); \
                __builtin_amdgcn_s_setprio(0); \
            } \
        } \
      } \
      _Pragma("unroll") for (int hh = 0; hh < 2; ++hh) { *(LAS v4u*)(lds + (NXTB) + hh * 16384 + lA) = RA[hh]; *(LAS v4u*)(lds + (NXTB) + hh * 16384 + lB) = RB[hh]; } \
      { const int kn = ((KK) + 3 < nbs) ? (KK) + 3 : nbs - 1; \
        _Pragma("unroll") for (int hh = 0; hh < 2; ++hh) { RA[hh] = *(const v4u*)(gA + (size_t)(2 * kn + hh) * 32 * 512); RB[hh] = *(const v4u*)(gB + (2 * kn + hh) * 32); } } \
      asm volatile("s_waitcnt lgkmcnt(0)\n\ts_barrier" ::: "memory"); } while (0)
    for (int kk = 0; kk < nbs; kk += 2) {
        DIFF_STEP(kk, 0, 32768, ra1, rb1);
        DIFF_STEP(kk + 1, 32768, 0, ra0, rb0);
    }
#undef DIFF_STEP
    float inv[2];
#pragma unroll
    for (int nt = 0; nt < 2; ++nt) inv[nt] = 1.f / Lacc[nt][0];
    LAS float* park = (LAS float*)(lds + 65536 + wv * 16384);
    if (cm == 1) {
#pragma unroll
        for (int mt = 0; mt < 8; ++mt)
#pragma unroll
            for (int nt = 0; nt < 2; ++nt)
#pragma unroll
                for (int r = 0; r < 4; ++r) park[((mt * 2 + nt) * 4 + r) * 64 + lane] = O[mt][nt][r] * inv[nt];
    }
    __syncthreads();
    if (cm == 0) {
        float ss[2] = {0.f, 0.f};
#pragma unroll
        for (int mt = 0; mt < 8; ++mt)
#pragma unroll
            for (int nt = 0; nt < 2; ++nt)
#pragma unroll
                for (int r = 0; r < 4; ++r) { const float v_ = O[mt][nt][r] * inv[nt] - lam * park[((mt * 2 + nt) * 4 + r) * 64 + lane]; O[mt][nt][r] = v_; ss[nt] += v_ * v_; }
#pragma unroll
        for (int nt = 0; nt < 2; ++nt) {
            float s_ = ss[nt]; s_ += __shfl_xor(s_, 16); s_ += __shfl_xor(s_, 32);
            const float rstd = rsqrtf(s_ * (1.f / 128.f) + 1e-6f) * 0.8f;
            bf16* op = (bf16*)(ws + WS_OA) + (size_t)(b * S + q0 + nt * 16 + fr) * 512 + h * 128 + fq * 4;
#pragma unroll
            for (int mt = 0; mt < 8; ++mt) { const f32x4 gg = *(const f32x4*)(subln + mt * 16 + fq * 4);
                v2u w; w.x = pk2(O[mt][nt][0] * rstd * gg.x, O[mt][nt][1] * rstd * gg.y); w.y = pk2(O[mt][nt][2] * rstd * gg.z, O[mt][nt][3] * rstd * gg.w);
                *(v2u*)(op + mt * 16) = w; }
        }
    }
    __syncthreads();
}

__device__ __forceinline__ void sort8_desc(unsigned (&k)[8]) {
#define CE_(i, j) do { const unsigned hi_ = k[i] > k[j] ? k[i] : k[j], lo_ = k[i] > k[j] ? k[j] : k[i]; k[i] = hi_; k[j] = lo_; } while (0)
    CE_(0, 1); CE_(2, 3); CE_(4, 5); CE_(6, 7); CE_(0, 2); CE_(1, 3); CE_(4, 6); CE_(5, 7); CE_(1, 2); CE_(5, 6);
    CE_(0, 4); CE_(1, 5); CE_(2, 6); CE_(3, 7); CE_(2, 4); CE_(3, 5); CE_(1, 2); CE_(3, 4); CE_(5, 6);
#undef CE_
}
struct NsaFr { bf16x8 Ka[2][2]; bf16x8 Vf[4]; };
template <int MODE>
__device__ __forceinline__ void nsa_compute(const NsaFr& F, int kbase, const bf16x8 (&Qf)[2], int qpos, float slope2, bool blkok, bool interior, int fq, float& moff, f32x4& Lacc, f32x4 (&O)[4]) {
    const float base = slope2 * (float)(kbase + fq * 8) - moff;
    f32x4 Sx[2];
    __builtin_amdgcn_s_setprio(1);
#pragma unroll
    for (int t = 0; t < 2; ++t) { f32x4 z = {base + slope2 * (float)(4 * t), base + slope2 * (float)(4 * t + 1), base + slope2 * (float)(4 * t + 2), base + slope2 * (float)(4 * t + 3)};
        z = MFMA16(F.Ka[t][0], Qf[0], z); Sx[t] = MFMA16(F.Ka[t][1], Qf[1], z); }
    __builtin_amdgcn_s_setprio(0);
    float sv[8];
    if (interior) {
#pragma unroll
        for (int t = 0; t < 2; ++t)
#pragma unroll
            for (int r = 0; r < 4; ++r) sv[t * 4 + r] = blkok ? Sx[t][r] : -1e30f;
    } else {
        const int kd0 = kbase + fq * 8 - qpos;
#pragma unroll
        for (int t = 0; t < 2; ++t)
#pragma unroll
            for (int r = 0; r < 4; ++r) { const int kd = kd0 + 4 * t + r; const bool ok = (MODE == 0) ? (blkok && kd <= 0) : (blkok && kd <= 0 && kd > -512);
                sv[t * 4 + r] = ok ? Sx[t][r] : -1e30f; }
    }
    float mx = fmaxf(fmaxf(fmaxf(fmaxf(sv[0], sv[1]), sv[2]), fmaxf(fmaxf(sv[3], sv[4]), sv[5])), fmaxf(sv[6], sv[7]));
    mx = fmaxf(mx, __shfl_xor(mx, 16)); mx = fmaxf(mx, __shfl_xor(mx, 32));
    if (__ballot(mx > 64.f) != 0ull) {
        const float dl = fmaxf(mx, 0.f), alpha = ex2(-dl); moff += dl; Lacc *= alpha;
#pragma unroll
        for (int mt = 0; mt < 4; ++mt) O[mt] *= alpha;
#pragma unroll
        for (int i = 0; i < 8; ++i) sv[i] -= dl;
    }
#pragma unroll
    for (int i = 0; i < 8; ++i) sv[i] = ex2(sv[i]);
    const bf16x8 Pf = pack8(sv[0], sv[1], sv[2], sv[3], sv[4], sv[5], sv[6], sv[7]);
    const bf16x8 ones8 = {(short)0x3f80, (short)0x3f80, (short)0x3f80, (short)0x3f80, (short)0x3f80, (short)0x3f80, (short)0x3f80, (short)0x3f80};
    __builtin_amdgcn_s_setprio(1);
#pragma unroll
    for (int mt = 0; mt < 4; ++mt) O[mt] = MFMA16(F.Vf[mt], Pf, O[mt]);
    Lacc = MFMA16(ones8, Pf, Lacc);
    __builtin_amdgcn_s_setprio(0);
}


__device__ __forceinline__ void cmp_scores_l(LAS unsigned char* lds, int kimg, int u, const bf16x8 (&Qf)[2], int qpos, int nv, float slope2, int fq, int kr0, float (&sv)[8]) {
#pragma unroll
    for (int t = 0; t < 2; ++t) {
        f32x4 z = {0.f, 0.f, 0.f, 0.f};
        z = MFMA16(*(const LAS bf16x8*)(lds + kimg + u * 4096 + kswz(kr0 + 4 * t, fq)), Qf[0], z);
        z = MFMA16(*(const LAS bf16x8*)(lds + kimg + u * 4096 + kswz(kr0 + 4 * t, 4 + fq)), Qf[1], z);
#pragma unroll
        for (int rr = 0; rr < 4; ++rr) { const int cidx = 32 * u + 8 * fq + 4 * t + rr; const float dist = (float)(qpos - (cidx * 32 + 31));
            sv[t * 4 + rr] = (cidx < nv) ? (z[rr] - slope2 * dist) : -1e30f; }
    }
}

__device__ __forceinline__ void nsa_wg_item(unsigned char* ws, int bg, int it32, LAS unsigned char* lds, int tid, int wave, int lane) {
    LAS float* wl = (LAS float*)(lds + 20480 + wave * 2048);
#ifdef LEAK_LO
    if (blockIdx.x == 0 && tid == 0) ((unsigned long long*)(ws + WS_CTL + 65536))[25] = __builtin_amdgcn_s_memrealtime();
#endif
    const int b = bg >> 1, g = bg & 1, fr = lane & 15, fq = lane >> 4, i = fr >> 2, r = fr & 3, s0g = it32 * 32, s0 = s0g + wave * 4, qpos = s0 + i;
    const int kr0 = 8 * (fr >> 2) + (fr & 3);
    const float slope2 = ex2(-(float)(g * 4 + r + 1)) * LOG2E;
    bf16x8 Qf[2];
    { const bf16* qp = (const bf16*)(ws + WS_QB) + (size_t)(b * S + qpos) * 512 + (g * 4 + r) * 64 + fq * 8; Qf[0] = ldg8(qp); Qf[1] = ldg8(qp + 32); }
    const float* gp = (const float*)(ws + WS_GB) + (size_t)(b * S + qpos) * 24 + g * 12 + r * 3;
    const float g0 = gp[0], g1 = gp[1], g2 = gp[2];
    __builtin_amdgcn_s_waitcnt(0x0F70);
    f32x4 Oacc[4];
#pragma unroll
    for (int mt = 0; mt < 4; ++mt) Oacc[mt] = (f32x4){0.f, 0.f, 0.f, 0.f};
#pragma unroll
    for (int e = 0; e < 8; ++e) wl[e * 64 + lane] = 0.f;
    const int nv = (qpos + 1) >> 5, nvmax = (s0 + 4) >> 5;
    if (nvmax > 0) {
        const bf16* Kc = (const bf16*)(ws + WS_KCMP) + (size_t)(bg * 256) * 64;
        const bf16* Vc = (const bf16*)(ws + WS_VCMP_T) + (size_t)(bg * 64) * 256;
        const int nu = (nvmax + 31) >> 5;
        float mloc = -1e30f, lloc = 0.f;
#pragma unroll 1
        for (int u = 0; u < nu; ++u) {
            float sv[8]; cmp_scores_l(lds, 40960, u, Qf, qpos, nv, slope2, fq, kr0, sv);
            float mx = mloc;
#pragma unroll
            for (int e = 0; e < 8; ++e) mx = fmaxf(mx, sv[e]);
            float ps = 0.f;
#pragma unroll
            for (int e = 0; e < 8; ++e) ps += (sv[e] > -1e29f) ? ex2(sv[e] - mx) : 0.f;
            lloc = lloc * ex2(mloc - mx) + ps; mloc = mx;
        }
        float mx = fmaxf(mloc, __shfl_xor(mloc, 16)); mx = fmaxf(mx, __shfl_xor(mx, 32));
        float ls = lloc * ex2(mloc - mx); ls += __shfl_xor(ls, 16); ls += __shfl_xor(ls, 32);
        const float inv = (ls > 0.f) ? 1.f / ls : 0.f;
        f32x4 Oc[4];
#pragma unroll
        for (int mt = 0; mt < 4; ++mt) Oc[mt] = (f32x4){0.f, 0.f, 0.f, 0.f};
#pragma unroll 1
        for (int u = 0; u < nu; ++u) {
            float sv[8]; cmp_scores_l(lds, 40960, u, Qf, qpos, nv, slope2, fq, kr0, sv);
#pragma unroll
            for (int e = 0; e < 8; ++e) sv[e] = (sv[e] > -1e29f) ? ex2(sv[e] - mx) * inv : 0.f;
#pragma unroll
            for (int t = 0; t < 2; ++t) {
                float e0 = sv[t * 4 + 0] + sv[t * 4 + 1], e1 = sv[t * 4 + 2] + sv[t * 4 + 3];
                e0 += __shfl_xor(e0, 1); e0 += __shfl_xor(e0, 2); e1 += __shfl_xor(e1, 1); e1 += __shfl_xor(e1, 2);
                if (r == 0) { const int j = 16 * u + 4 * fq + 2 * t; wl[i * 128 + j] = e0; wl[i * 128 + j + 1] = e1; }
            }
            const bf16x8 Pf = pack8(sv[0], sv[1], sv[2], sv[3], sv[4], sv[5], sv[6], sv[7]);
#pragma unroll
            for (int mt = 0; mt < 4; ++mt) Oc[mt] = MFMA16(*(const LAS bf16x8*)(lds + 73728 + u * 4096 + vswz(fr, fq) + mt * 1024), Pf, Oc[mt]);
        }
#pragma unroll
        for (int mt = 0; mt < 4; ++mt) Oacc[mt] = Oc[mt] * g0;
    }
    LDS_WAIT();
    unsigned msk[4] = {0u, 0u, 0u, 0u};
    {
        const int q16 = r + 4 * fq, cur = qpos >> 6;
        unsigned kq[8];
#pragma unroll
        for (int e = 0; e < 8; ++e) { const int j = q16 + 16 * e; const bool forced = (j == 0) || (j == cur) || (j == cur - 1);
            const unsigned pb = __builtin_bit_cast(unsigned, wl[i * 128 + j]) | 0x80000000u;
            const unsigned cls = forced ? 0xffffff80u : ((j <= cur) ? (pb & 0xffffff80u) : 0u);
            kq[e] = cls | (unsigned)(127 - j); }
        sort8_desc(kq);
#pragma unroll 1
        for (int round = 0; round < 16; ++round) {
            const unsigned head = kq[0]; unsigned m = head, o_;
            o_ = (unsigned)__builtin_amdgcn_update_dpp(0, (int)m, 0xB1, 0xf, 0xf, false); m = o_ > m ? o_ : m;
            o_ = (unsigned)__builtin_amdgcn_update_dpp(0, (int)m, 0x4E, 0xf, 0xf, false); m = o_ > m ? o_ : m;
            { const auto r_ = __builtin_amdgcn_permlane16_swap(m, m, false, false); const unsigned a_ = (unsigned)r_[0], b_ = (unsigned)r_[1]; m = a_ > b_ ? a_ : b_; }
            { const auto r_ = __builtin_amdgcn_permlane32_swap(m, m, false, false); const unsigned a_ = (unsigned)r_[0], b_ = (unsigned)r_[1]; m = a_ > b_ ? a_ : b_; }
            const int bj = 127 - (int)(m & 0x7fu);
            const unsigned bit = 1u << (bj & 31); const int w = bj >> 5;
            msk[0] |= (w == 0) ? bit : 0u; msk[1] |= (w == 1) ? bit : 0u; msk[2] |= (w == 2) ? bit : 0u; msk[3] |= (w == 3) ? bit : 0u;
            const bool win = (head == m);
#pragma unroll
            for (int e = 0; e < 7; ++e) kq[e] = win ? kq[e + 1] : kq[e];
            kq[7] = win ? 0u : kq[7];
        }
    }
#ifdef LEAK_LO
    if (blockIdx.x == 0 && tid == 0) ((unsigned long long*)(ws + WS_CTL + 65536))[23] = __builtin_amdgcn_s_memrealtime();
#endif
    unsigned unw[4];
    { const int curmax = (s0 + 3) >> 6;
#pragma unroll
      for (int w = 0; w < 4; ++w) {
          unsigned u_ = msk[w]; u_ |= __shfl_xor(u_, 4); u_ |= __shfl_xor(u_, 8);
          const unsigned uu = (unsigned)__builtin_amdgcn_readfirstlane((int)u_);
          const int hi = curmax - 32 * w;
          const unsigned vm = (hi < 0) ? 0u : (hi >= 31 ? 0xffffffffu : ((2u << hi) - 1u));
          unw[w] = uu & vm; } }
    LAS unsigned* UM = (LAS unsigned*)(lds + 18432);
    LAS int* list = (LAS int*)(lds + 16384);
    if (lane == 0) { UM[wave * 4 + 0] = unw[0]; UM[wave * 4 + 1] = unw[1]; UM[wave * 4 + 2] = unw[2]; UM[wave * 4 + 3] = unw[3]; }
    asm volatile("s_waitcnt lgkmcnt(0)\n\ts_barrier" ::: "memory");
    int cnt = 0;
#pragma unroll
    for (int w = 0; w < 4; ++w) {
        unsigned o_ = 0u;
#pragma unroll
        for (int v = 0; v < 8; ++v) o_ |= UM[v * 4 + w];
        unsigned uu = (unsigned)__builtin_amdgcn_readfirstlane((int)o_);
        while (uu) { const int jb = __builtin_ctz(uu); uu &= uu - 1u; const int kbase = (32 * w + jb) * 64;
            if (tid == 0) { list[cnt] = kbase; list[cnt + 1] = kbase + 32; } cnt += 2; }
    }
    { const int kst = (s0g - 511 > 0) ? (s0g - 511) : 0; const int k0_ = kst >> 5, k1_ = (s0g + 31) >> 5;
      for (int k32 = k0_; k32 <= k1_; ++k32) { if (tid == 0) list[cnt] = (k32 * 32) | (1 << 30); ++cnt; }
      if (cnt & 1) { if (tid == 0) list[cnt] = (k1_ * 32) | (1 << 30) | (1 << 29); ++cnt; } }
    asm volatile("s_waitcnt lgkmcnt(0)\n\ts_barrier" ::: "memory");
    {
        const bf16* KSb = (const bf16*)(ws + WS_KS) + (size_t)(bg * S) * 64; const bf16* VSb = (const bf16*)(ws + WS_VST) + (size_t)(bg * 64) * S;
        const bf16* KWb = (const bf16*)(ws + WS_KW) + (size_t)(bg * S) * 64; const bf16* VWb = (const bf16*)(ws + WS_VWT) + (size_t)(bg * 64) * S;
        const bool isK = tid < 256;
        const int srow = isK ? (tid >> 3) : ((tid - 256) >> 2), scq = isK ? (tid & 7) : (tid & 3);
        const int loff = isK ? kswz(srow, scq) : 4096 + vswz(srow, scq);
#define NSA_GADDR(ENT) (isK ? ((((ENT) >> 30) & 1) ? KWb : KSb) + (size_t)(((ENT) & 0xfffff) + srow) * 64 + scq * 8 : ((((ENT) >> 30) & 1) ? VWb : VSb) + (size_t)srow * S + ((ENT) & 0xfffff) + scq * 8)
        int koff[2][2];
#pragma unroll
        for (int t = 0; t < 2; ++t)
#pragma unroll
            for (int ks = 0; ks < 2; ++ks) koff[t][ks] = kswz(kr0 + 4 * t, ks * 4 + fq);
        const int voff = 4096 + vswz(fr, fq);
        float mS = 0.f, mW = 0.f; f32x4 lS = {0.f, 0.f, 0.f, 0.f}, lW = {0.f, 0.f, 0.f, 0.f}; f32x4 OS[4], OW[4];
#pragma unroll
        for (int mt = 0; mt < 4; ++mt) { OS[mt] = (f32x4){0.f, 0.f, 0.f, 0.f}; OW[mt] = (f32x4){0.f, 0.f, 0.f, 0.f}; }
        v4u rs0, rs1;
        { const int e0 = __builtin_amdgcn_readfirstlane(list[0]); const v4u v0 = *(const v4u*)NSA_GADDR(e0); *(LAS v4u*)(lds + loff) = v0; }
        { const int e1 = __builtin_amdgcn_readfirstlane(list[1]); rs1 = *(const v4u*)NSA_GADDR(e1); }
        { const int e2 = __builtin_amdgcn_readfirstlane(list[(2 < cnt) ? 2 : cnt - 1]); rs0 = *(const v4u*)NSA_GADDR(e2); }
        asm volatile("s_waitcnt lgkmcnt(0)\n\ts_barrier" ::: "memory");
#define NSA_STEP(SI, CUR, NXT, R) do { const int si_ = (SI); const int ent = __builtin_amdgcn_readfirstlane(list[si_]); \
            const int kbase = ent & 0xfffff; const bool isw = (ent >> 30) & 1; const bool skp = (ent >> 29) & 1; \
            const int j_ = kbase >> 6, jw_ = j_ >> 5; const unsigned uw_ = (jw_ == 0) ? unw[0] : (jw_ == 1) ? unw[1] : (jw_ == 2) ? unw[2] : unw[3]; \
            const bool need = isw ? (!skp && (kbase + 31 >= s0 - 511) && (kbase <= s0 + 3)) : (((uw_ >> (j_ & 31)) & 1u) != 0u); \
            if (need) { \
                __builtin_amdgcn_s_setprio(1); \
                NsaFr F_; \
                _Pragma("unroll") for (int t = 0; t < 2; ++t) _Pragma("unroll") for (int ks = 0; ks < 2; ++ks) F_.Ka[t][ks] = *(const LAS bf16x8*)(lds + (CUR) + koff[t][ks]); \
                _Pragma("unroll") for (int mt = 0; mt < 4; ++mt) F_.Vf[mt] = *(const LAS bf16x8*)(lds + (CUR) + voff + mt * 1024); \
                if (isw) nsa_compute<1>(F_, kbase, Qf, qpos, slope2, true, (kbase + 31 <= s0) && (kbase > s0 + 3 - 512), fq, mW, lW, OW); \
                else { const unsigned mw_ = (jw_ == 0) ? msk[0] : (jw_ == 1) ? msk[1] : (jw_ == 2) ? msk[2] : msk[3]; \
                       nsa_compute<0>(F_, kbase, Qf, qpos, slope2, ((mw_ >> (j_ & 31)) & 1u) != 0u, kbase + 31 <= s0, fq, mS, lS, OS); } \
            } \
            *(LAS v4u*)(lds + (NXT) + loff) = R; \
            { const int sn_ = (si_ + 3 < cnt) ? si_ + 3 : cnt - 1; const int en_ = __builtin_amdgcn_readfirstlane(list[sn_]); R = *(const v4u*)NSA_GADDR(en_); } \
            asm volatile("s_waitcnt lgkmcnt(0)\n\ts_barrier" ::: "memory"); } while (0)
#pragma unroll 1
        for (int s2 = 0; s2 < cnt; s2 += 2) { NSA_STEP(s2, 0, 8192, rs1); NSA_STEP(s2 + 1, 8192, 0, rs0); }
#undef NSA_STEP
#undef NSA_GADDR
        { const float sc_ = g1 / lS[0];
#pragma unroll
          for (int mt = 0; mt < 4; ++mt) Oacc[mt] += OS[mt] * sc_; }
        { const float sc_ = g2 / lW[0];
#pragma unroll
          for (int mt = 0; mt < 4; ++mt) Oacc[mt] += OW[mt] * sc_; }
    }
#ifdef LEAK_LO
    if (blockIdx.x == 0 && tid == 0) ((unsigned long long*)(ws + WS_CTL + 65536))[24] = __builtin_amdgcn_s_memrealtime();
#endif
    bf16* op = (bf16*)(ws + WS_OB) + (size_t)(b * S + qpos) * 512 + (g * 4 + r) * 64 + fq * 4;
#pragma unroll
    for (int mt = 0; mt < 4; ++mt) { v2u w; w.x = pk2(Oacc[mt][0], Oacc[mt][1]); w.y = pk2(Oacc[mt][2], Oacc[mt][3]); *(v2u*)(op + mt * 16) = w; }
    LDS_WAIT();
}


__device__ __forceinline__ void cross_wg(unsigned char* ws, int bh, int part, int nparts, LAS unsigned char* lds, int tid, int wave, int lane) {
    const int b = bh >> 2, h = bh & 3, fr = lane & 15, fq = lane >> 4;
    const bf16* Kc = (const bf16*)(ws + WS_KMEM) + (size_t)(bh * 256) * 128;
    const bf16* Vc = (const bf16*)(ws + WS_VMEM_T) + (size_t)(bh * 128) * 256;
#pragma unroll 8
    for (int e = tid; e < 4096; e += NTHR) { const int row = e >> 4, c = e & 15; const int key = (row & 3) | (((row >> 3) & 3) << 2);
        *(LAS v4u*)(lds + row * 256 + ((c ^ key) << 4)) = *(const v4u*)(Kc + (size_t)row * 128 + c * 8); }
#pragma unroll 8
    for (int e = tid; e < 4096; e += NTHR) { const int row = e >> 5, c = e & 31;
        *(LAS v4u*)(lds + 65536 + row * 512 + ((c ^ (row & 15)) << 4)) = *(const v4u*)(Vc + (size_t)row * 256 + c * 8); }
    __syncthreads();
    const int kr0 = 8 * (fr >> 2) + (fr & 3);
    for (int rt = part * NWAVES + wave; rt < 512; rt += nparts * NWAVES) {
        const int row = b * S + rt * 16 + fr;
        bf16x8 Qf[4];
        { const bf16* qp = (const bf16*)(ws + WS_QC) + (size_t)row * 512 + h * 128 + fq * 8;
#pragma unroll
          for (int ks = 0; ks < 4; ++ks) Qf[ks] = ldg8(qp + ks * 32); }
        f32x4 sc[16]; float mx = -1e30f;
        __builtin_amdgcn_s_setprio(1);
#pragma unroll
        for (int kt = 0; kt < 16; ++kt) {
            const int u = kt >> 1, t = kt & 1; const int krow = 32 * u + kr0 + 4 * t;
            f32x4 z = {0.f, 0.f, 0.f, 0.f};
#pragma unroll
            for (int ks = 0; ks < 4; ++ks) z = MFMA16(*(const LAS bf16x8*)(lds + krow * 256 + (((ks * 4 + fq) ^ fr) << 4)), Qf[ks], z);
            z *= LOG2E; sc[kt] = z;
            mx = fmaxf(mx, fmaxf(fmaxf(z[0], z[1]), fmaxf(z[2], z[3])));
        }
        __builtin_amdgcn_s_setprio(0);
        mx = fmaxf(mx, __shfl_xor(mx, 16)); mx = fmaxf(mx, __shfl_xor(mx, 32));
        float ls = 0.f;
#pragma unroll
        for (int kt = 0; kt < 16; ++kt)
#pragma unroll
            for (int rr = 0; rr < 4; ++rr) { const float p = ex2(sc[kt][rr] - mx); sc[kt][rr] = p; ls += p; }
        ls += __shfl_xor(ls, 16); ls += __shfl_xor(ls, 32);
        const float inv = 1.f / ls;
        f32x4 O[8];
#pragma unroll
        for (int mt = 0; mt < 8; ++mt) O[mt] = (f32x4){0.f, 0.f, 0.f, 0.f};
        __builtin_amdgcn_s_setprio(1);
#pragma unroll
        for (int u = 0; u < 8; ++u) {
            const bf16x8 Pf = pack8(sc[2 * u][0], sc[2 * u][1], sc[2 * u][2], sc[2 * u][3], sc[2 * u + 1][0], sc[2 * u + 1][1], sc[2 * u + 1][2], sc[2 * u + 1][3]);
#pragma unroll
            for (int mt = 0; mt < 8; ++mt) O[mt] = MFMA16(*(const LAS bf16x8*)(lds + 65536 + (mt * 16 + fr) * 512 + (((4 * u + fq) ^ fr) << 4)), Pf, O[mt]);
        }
        __builtin_amdgcn_s_setprio(0);
        bf16* op = (bf16*)(ws + WS_OC) + (size_t)row * 512 + h * 128 + fq * 4;
#pragma unroll
        for (int mt = 0; mt < 8; ++mt) { v2u w; w.x = pk2(O[mt][0] * inv, O[mt][1] * inv); w.y = pk2(O[mt][2] * inv, O[mt][3] * inv); *(v2u*)(op + mt * 16) = w; }
    }
    __syncthreads();
}

__device__ __forceinline__ unsigned row_max_u32(unsigned v) {
    unsigned o;
    o = (unsigned)__builtin_amdgcn_update_dpp(0, (int)v, 0x128, 0xf, 0xf, false); v = o > v ? o : v;
    o = (unsigned)__builtin_amdgcn_update_dpp(0, (int)v, 0x124, 0xf, 0xf, false); v = o > v ? o : v;
    o = (unsigned)__builtin_amdgcn_update_dpp(0, (int)v, 0x122, 0xf, 0xf, false); v = o > v ? o : v;
    o = (unsigned)__builtin_amdgcn_update_dpp(0, (int)v, 0x121, 0xf, 0xf, false); v = o > v ? o : v;
    return v;
}
__device__ __forceinline__ void peer_load8(v4u (&buf)[8], const unsigned char* tab, int ereg, int l0, int lane) {
#pragma unroll
    for (int kk = 0; kk < 8; ++kk) { const int eid = __builtin_amdgcn_readlane(ereg, l0 + kk); buf[kk] = *(const v4u*)(tab + (size_t)eid * 1024 + lane * 16); }
}
__device__ __forceinline__ float peer_dot16(const f32x2 (&x2)[8], const v4u u) {
    const f32x2 c0 = __builtin_amdgcn_cvt_pk_f32_fp8((int)u.x, false), c1 = __builtin_amdgcn_cvt_pk_f32_fp8((int)u.x, true);
    const f32x2 c2 = __builtin_amdgcn_cvt_pk_f32_fp8((int)u.y, false), c3 = __builtin_amdgcn_cvt_pk_f32_fp8((int)u.y, true);
    const f32x2 c4 = __builtin_amdgcn_cvt_pk_f32_fp8((int)u.z, false), c5 = __builtin_amdgcn_cvt_pk_f32_fp8((int)u.z, true);
    const f32x2 c6 = __builtin_amdgcn_cvt_pk_f32_fp8((int)u.w, false), c7 = __builtin_amdgcn_cvt_pk_f32_fp8((int)u.w, true);
    f32x2 s0 = x2[0] * c0, s1 = x2[1] * c1;
    s0 = __builtin_elementwise_fma(x2[2], c2, s0); s1 = __builtin_elementwise_fma(x2[3], c3, s1);
    s0 = __builtin_elementwise_fma(x2[4], c4, s0); s1 = __builtin_elementwise_fma(x2[5], c5, s1);
    s0 = __builtin_elementwise_fma(x2[6], c6, s0); s1 = __builtin_elementwise_fma(x2[7], c7, s1);
    s0 = s0 + s1; return s0.x + s0.y;
}
__device__ __forceinline__ void peer_acc16(f32x2 (&o)[8], const float w_, const v4u v) {
    const f32x2 w2 = {w_, w_};
    o[0] = __builtin_elementwise_fma(w2, __builtin_amdgcn_cvt_pk_f32_fp8((int)v.x, false), o[0]); o[1] = __builtin_elementwise_fma(w2, __builtin_amdgcn_cvt_pk_f32_fp8((int)v.x, true), o[1]);
    o[2] = __builtin_elementwise_fma(w2, __builtin_amdgcn_cvt_pk_f32_fp8((int)v.y, false), o[2]); o[3] = __builtin_elementwise_fma(w2, __builtin_amdgcn_cvt_pk_f32_fp8((int)v.y, true), o[3]);
    o[4] = __builtin_elementwise_fma(w2, __builtin_amdgcn_cvt_pk_f32_fp8((int)v.z, false), o[4]); o[5] = __builtin_elementwise_fma(w2, __builtin_amdgcn_cvt_pk_f32_fp8((int)v.z, true), o[5]);
    o[6] = __builtin_elementwise_fma(w2, __builtin_amdgcn_cvt_pk_f32_fp8((int)v.w, false), o[6]); o[7] = __builtin_elementwise_fma(w2, __builtin_amdgcn_cvt_pk_f32_fp8((int)v.w, true), o[7]);
}
__device__ __forceinline__ void peer_token(unsigned char* ws, const float* gfin, float* outp, int tok, int lane) {
    const bf16* scp = (const bf16*)(ws + WS_SCORES) + (size_t)tok * 2048;
    int eR[2]; float gR[2];
#ifndef TOPK_REP
#define TOPK_REP 1
#endif
#pragma unroll 1
    for (int trp = 0; trp < TOPK_REP; ++trp) {
        asm volatile("" : "+v"(lane));
        const int l16 = lane & 15, grp = lane >> 4;
    float tsv[4]; int tsi[4];
    {
        unsigned kq[4][8]; unsigned mykey[4];
#pragma unroll
        for (int gi = 0; gi < 4; ++gi) {
            const v4u raw = *(const v4u*)(scp + (gi * 4 + grp) * 128 + l16 * 8);
#pragma unroll
            for (int e = 0; e < 8; ++e) { const unsigned w = raw[e >> 1]; const unsigned bb_ = (e & 1) ? (w >> 16) : (w & 0xffffu);
                const unsigned ob = (bb_ & 0x8000u) ? (~bb_ & 0xffffu) : (bb_ | 0x8000u); kq[gi][e] = (ob << 16) | (unsigned)(127 - (l16 * 8 + e)); }
            sort8_desc(kq[gi]); mykey[gi] = 0u;
        }
#pragma unroll 1
        for (int round = 0; round < 16; ++round) {
#pragma unroll
            for (int gi = 0; gi < 4; ++gi) {
                const unsigned head = kq[gi][0]; const unsigned m = row_max_u32(head);
                mykey[gi] = (l16 == round) ? m : mykey[gi];
                const bool win = (head == m);
#pragma unroll
                for (int e = 0; e < 7; ++e) kq[gi][e] = win ? kq[gi][e + 1] : kq[gi][e];
                kq[gi][7] = win ? 0u : kq[gi][7];
            }
        }
#pragma unroll
        for (int gi = 0; gi < 4; ++gi) { const unsigned ob = mykey[gi] >> 16; const unsigned bb_ = (ob & 0x8000u) ? (ob & 0x7fffu) : (~ob & 0xffffu);
            tsv[gi] = __builtin_bit_cast(float, bb_ << 16); tsi[gi] = 127 - (int)(mykey[gi] & 0xffffu); }
    }
    float gsel[4]; int esel[4];
    const int half = lane >> 5, L = lane & 31, hb = half * 32, a = L & 15, bb = (L >> 4) * 8;
    {
        unsigned kq[4][8]; unsigned selk[4];
#pragma unroll
        for (int gi = 0; gi < 4; ++gi) {
            const float s0a = __shfl(tsv[gi], hb + a);
#pragma unroll
            for (int e = 0; e < 8; ++e) { const float sm_ = s0a + __shfl(tsv[gi], hb + 16 + bb + e); unsigned u = __builtin_bit_cast(unsigned, sm_);
                u ^= (unsigned)((int)u >> 31) | 0x80000000u; kq[gi][e] = (u & 0xffffff00u) | (unsigned)(255 - (a * 16 + bb + e)); }
            selk[gi] = 0u;
        }
#pragma unroll 1
        for (int round = 0; round < 16; ++round) {
#pragma unroll
            for (int gi = 0; gi < 4; ++gi) {
                const unsigned head = kq[gi][0]; unsigned m = row_max_u32(head);
                const unsigned o_ = (unsigned)__shfl_xor((int)m, 16); m = (o_ > m) ? o_ : m;
                selk[gi] = (L == round) ? m : selk[gi];
                const bool win = (head == m);
#pragma unroll
                for (int e = 0; e < 7; ++e) kq[gi][e] = win ? kq[gi][e + 1] : kq[gi][e];
                kq[gi][7] = win ? 0u : kq[gi][7];
            }
        }
#pragma unroll
        for (int gi = 0; gi < 4; ++gi) {
            const int flat = 255 - (int)(selk[gi] & 0xffu);
            const int i0 = __shfl(tsi[gi], hb + (flat >> 4)), i1 = __shfl(tsi[gi], hb + 16 + (flat & 15));
            const float selv = __shfl(tsv[gi], hb + (flat >> 4)) + __shfl(tsv[gi], hb + 16 + (flat & 15));
            const float mxv = __shfl(selv, hb);
            const float ev = (L < 16) ? __expf(selv - mxv) : 0.f;
            float sm = ev;
#pragma unroll
            for (int off = 1; off < 16; off <<= 1) sm += __shfl_xor(sm, off);
            gsel[gi] = (L < 16) ? ev / sm : 0.f; esel[gi] = i0 * 128 + i1;
        }
    }
#pragma unroll
    for (int rr = 0; rr < 2; ++rr) {
        const int e1 = __shfl(esel[2 * rr + 1], lane - 16); const float g1_ = __shfl(gsel[2 * rr + 1], lane - 16);
        const bool odd = (lane & 16) != 0;
        eR[rr] = odd ? e1 : esel[2 * rr]; gR[rr] = odd ? g1_ : gsel[2 * rr];
    }
    }
    f32x2 x2[8];
    { const bf16* up = (const bf16*)(ws + WS_U) + (size_t)tok * 1024 + lane * 16; const v4u a0 = *(const v4u*)up, a1 = *(const v4u*)(up + 8);
      x2[0] = (f32x2){bflo(a0.x), bfhi(a0.x)}; x2[1] = (f32x2){bflo(a0.y), bfhi(a0.y)}; x2[2] = (f32x2){bflo(a0.z), bfhi(a0.z)}; x2[3] = (f32x2){bflo(a0.w), bfhi(a0.w)};
      x2[4] = (f32x2){bflo(a1.x), bfhi(a1.x)}; x2[5] = (f32x2){bflo(a1.y), bfhi(a1.y)}; x2[6] = (f32x2){bflo(a1.z), bfhi(a1.z)}; x2[7] = (f32x2){bflo(a1.w), bfhi(a1.w)}; }
    f32x2 o2[8];
#pragma unroll
    for (int e = 0; e < 8; ++e) o2[e] = (f32x2){0.f, 0.f};
    __builtin_amdgcn_s_waitcnt(0x0F70);
    const float xsc = rsqrtf(((const float*)(ws + WS_SS2))[tok] * (1.f / 1024.f) + 1e-6f) * (1.f / 64.f);
    const unsigned char* PU = ws + WS_PU; const unsigned char* PV = ws + WS_PV;
    const int kkL = ((lane >> 5) & 1) * 8 + ((lane >> 4) & 1) * 4 + ((lane >> 3) & 1) * 2 + ((lane >> 2) & 1);
    v4u bA[8], bB[8];
    peer_load8(bA, PU, eR[0], 0, lane);
#pragma unroll
    for (int rr = 0; rr < 2; ++rr) {
        float wreg = 0.f;
#pragma unroll 1
        for (int sub = 0; sub < 4; ++sub) {
            const int lbase = (sub >> 1) * 16 + (sub & 1) * 32;
            float pv[16];
            peer_load8(bB, PU, eR[rr], lbase + 8, lane);
#pragma unroll
            for (int kk = 0; kk < 8; ++kk) pv[kk] = peer_dot16(x2, bA[kk]);
            { const int s1 = (sub + 1) & 3; const int lnext = (s1 >> 1) * 16 + (s1 & 1) * 32; peer_load8(bA, (sub < 3) ? PU : PV, eR[rr], lnext, lane); }
#pragma unroll
            for (int kk = 0; kk < 8; ++kk) pv[8 + kk] = peer_dot16(x2, bB[kk]);
            { const bool bit = (lane & 32) != 0;
#pragma unroll
              for (int j = 0; j < 8; ++j) { const float send = bit ? pv[j] : pv[j + 8], keep = bit ? pv[j + 8] : pv[j]; pv[j] = keep + __shfl_xor(send, 32); } }
            { const bool bit = (lane & 16) != 0;
#pragma unroll
              for (int j = 0; j < 4; ++j) { const float send = bit ? pv[j] : pv[j + 4], keep = bit ? pv[j + 4] : pv[j]; pv[j] = keep + __shfl_xor(send, 16); } }
            { const bool bit = (lane & 8) != 0;
#pragma unroll
              for (int j = 0; j < 2; ++j) { const float send = bit ? pv[j] : pv[j + 2], keep = bit ? pv[j + 2] : pv[j]; pv[j] = keep + __shfl_xor(send, 8); } }
            { const bool bit = (lane & 4) != 0; const float send = bit ? pv[0] : pv[1], keep = bit ? pv[1] : pv[0]; pv[0] = keep + __shfl_xor(send, 4); }
            float dot = pv[0]; dot += __shfl_xor(dot, 1); dot += __shfl_xor(dot, 2);
            const float gt = __shfl(gR[rr], lbase + kkL);
            const float w_ = gt * gelu_poly(dot * xsc) * (1.f / 16.f);
            wreg = ((lane & 3) == sub) ? w_ : wreg;
        }
#pragma unroll 1
        for (int sub = 0; sub < 4; ++sub) {
            const int lbase = (sub >> 1) * 16 + (sub & 1) * 32;
            peer_load8(bB, PV, eR[rr], lbase + 8, lane);
#pragma unroll
            for (int kk = 0; kk < 8; ++kk) {
                const int sl = (((kk >> 3) & 1) << 5) | (((kk >> 2) & 1) << 4) | (((kk >> 1) & 1) << 3) | ((kk & 1) << 2);
                peer_acc16(o2, __builtin_bit_cast(float, __builtin_amdgcn_readlane(__builtin_bit_cast(int, wreg), sl + sub)), bA[kk]);
            }
            { const int s1 = (sub + 1) & 3; const int lnext = (s1 >> 1) * 16 + (s1 & 1) * 32; const bool last = (sub == 3);
              peer_load8(bA, last ? PU : PV, last ? eR[1] : eR[rr], lnext, lane); }
#pragma unroll
            for (int kk = 8; kk < 16; ++kk) {
                const int sl = (((kk >> 3) & 1) << 5) | (((kk >> 2) & 1) << 4) | (((kk >> 1) & 1) << 3) | ((kk & 1) << 2);
                peer_acc16(o2, __builtin_bit_cast(float, __builtin_amdgcn_readlane(__builtin_bit_cast(int, wreg), sl + sub)), bB[kk - 8]);
            }
        }
    }
    const float* hp = (const float*)(ws + WS_H) + (size_t)tok * 1024 + lane * 16;
    float y[16];
#pragma unroll
    for (int q = 0; q < 4; ++q) { const f32x4 hv = *(const f32x4*)(hp + 4 * q); y[4 * q] = hv.x + o2[2 * q].x; y[4 * q + 1] = hv.y + o2[2 * q].y; y[4 * q + 2] = hv.z + o2[2 * q + 1].x; y[4 * q + 3] = hv.w + o2[2 * q + 1].y; }
    float ss = 0.f;
#pragma unroll
    for (int e = 0; e < 16; ++e) ss += y[e] * y[e];
    const float rstd = rsqrtf(wave_sum(ss) * (1.f / D) + 1e-6f);
    const float* gp = gfin + lane * 16; float* op = outp + (size_t)tok * 1024 + lane * 16;
#pragma unroll
    for (int q = 0; q < 4; ++q) { const f32x4 gv = *(const f32x4*)(gp + 4 * q);
        *(f32x4*)(op + 4 * q) = (f32x4){y[4 * q] * rstd * gv.x, y[4 * q + 1] * rstd * gv.y, y[4 * q + 2] * rstd * gv.z, y[4 * q + 3] * rstd * gv.w}; }
}

typedef unsigned gu32_unused;
#define XB_TMO      128
#define XB_XCNT(j)  (256  + 64 * (j))
#define XB_XSUB(j)  (1280 + 64 * (j))
#define XB_XGEN(j)  (2304 + 64 * (j))
#define XB_TOP      3328
#define XB_TOPGEN   3392
#define XCD_BAR_WORDS 3456
#define XB_SPIN_CAP (1u << 18)

__device__ __forceinline__ unsigned xb_ld(unsigned* p)              { return __hip_atomic_load(p, __ATOMIC_RELAXED, __HIP_MEMORY_SCOPE_AGENT); }
__device__ __forceinline__ unsigned xb_add(unsigned* p, unsigned v) { return __hip_atomic_fetch_add(p, v, __ATOMIC_RELAXED, __HIP_MEMORY_SCOPE_AGENT); }
__device__ __forceinline__ unsigned xb_xcc_id() { return (unsigned)__builtin_amdgcn_s_getreg((3 << 11) | 20) & 0xFu; }
#define XB_SPIN(cond, bar) do { unsigned _sp = 0; while (cond) { __builtin_amdgcn_s_sleep(1); \
    if ((++_sp & 255u) == 0u) { if (xb_ld(&(bar)[XB_TMO])) break; if (_sp > XB_SPIN_CAP) { atomicAdd(&(bar)[XB_TMO], 1u); break; } } } } while (0)

struct XcdBarrier {
    unsigned* bar; unsigned x;
    volatile LAS unsigned* st;
};

__device__ __forceinline__ XcdBarrier xcd_barrier_post(unsigned* bar, volatile LAS unsigned* st) {
    XcdBarrier b; b.bar = bar; b.x = xb_xcc_id(); b.st = st;
    if (threadIdx.x == 0) (void)xb_add(&bar[XB_XCNT(b.x)], 1u);
    return b;
}
__device__ __forceinline__ void xcd_barrier_complete(unsigned* bar, unsigned x, unsigned& nloc, unsigned& nx) {
    const unsigned G = gridDim.x * gridDim.y * gridDim.z;
    unsigned sum, cnt, mine, sp = 0u;
    for (;;) {
        sum = 0u; cnt = 0u; mine = 0u;
#pragma unroll
        for (unsigned j = 0; j < 16; ++j) { const unsigned c = xb_ld(&bar[XB_XCNT(j)]); sum += c; cnt += (c > 0u) ? 1u : 0u; mine = (j == x) ? c : mine; }
        if (sum == G) break;
        __builtin_amdgcn_s_sleep(1);
        if ((++sp & 255u) == 0u) { if (xb_ld(&bar[XB_TMO])) break; if (sp > XB_SPIN_CAP) { atomicAdd(&bar[XB_TMO], 1u); break; } }
    }
    nloc = mine > 0u ? mine : 1u; nx = cnt > 0u ? cnt : 1u;
}

__device__ __forceinline__ void xcd_barrier(const XcdBarrier& b) {
    asm volatile("s_waitcnt vmcnt(0)" ::: "memory");
    __syncthreads();
    if (threadIdx.x == 0) {
        unsigned* bar = b.bar;
        __builtin_amdgcn_s_waitcnt(0);
        unsigned nloc = b.st[0], nx = b.st[1];
        if (nloc == 0u) { xcd_barrier_complete(bar, b.x, nloc, nx); b.st[0] = nloc; b.st[1] = nx; }
        const unsigned old = xb_add(&bar[XB_XSUB(b.x)], 1u);
        const unsigned gen = old / nloc;
        if (old + 1u == (gen + 1u) * nloc) {
            __builtin_amdgcn_fence(__ATOMIC_RELEASE, "agent");
            asm volatile("s_waitcnt vmcnt(0)" ::: "memory");
            const unsigned og = xb_add(&bar[XB_TOP], 1u);
            const unsigned tg = og / nx;
            if (og + 1u == (tg + 1u) * nx) xb_add(&bar[XB_TOPGEN], 1u);
            else XB_SPIN(xb_ld(&bar[XB_TOPGEN]) == tg, bar);
            __builtin_amdgcn_fence(__ATOMIC_ACQUIRE, "agent");
            xb_add(&bar[XB_XGEN(b.x)], 1u);
            asm volatile("s_waitcnt vmcnt(0)" ::: "memory");
        } else {
            XB_SPIN(xb_ld(&bar[XB_XGEN(b.x)]) == gen, bar);
            __builtin_amdgcn_fence(__ATOMIC_ACQUIRE, "agent");
            asm volatile("s_waitcnt vmcnt(0)" ::: "memory");
        }
    }
    __syncthreads();
}

constexpr int NPHASE = 14;
__global__ void __launch_bounds__(NTHR, 2) hybrid_fwd(Args args) {
    extern __shared__ __attribute__((aligned(16))) unsigned char lds_raw[];
    LAS unsigned char* lds = (LAS unsigned char*)lds_raw;
    unsigned char* ws = args.ws;
    const int tid = threadIdx.x, lane = tid & 63, wave = __builtin_amdgcn_readfirstlane(tid >> 6);
    const int G = gridDim.x, bx = blockIdx.x;
    const int gw = bx * NWAVES + wave, NGW = G * NWAVES;
    const int lo = args.ph_lo, hi = args.ph_hi;
    const bool coop = (hi - lo) > 1;
    volatile LAS unsigned* MISC = (volatile LAS unsigned*)(lds + 131072 + 320);
    for (int u = tid; u < (LDS_BYTES - 131072) / 4; u += NTHR) ((LAS unsigned*)(lds + 131072))[u] = 0u;
    __syncthreads();
    XcdBarrier xbar; xbar.bar = (unsigned*)(ws + WS_CTL) + 4096; xbar.x = 0; xbar.st = nullptr;
    if (coop) xbar = xcd_barrier_post((unsigned*)(ws + WS_CTL) + 4096, MISC + 8);
#ifndef PH_MASK
#define PH_MASK 0x3fff
#endif
#define IN(k) (((PH_MASK >> (k)) & 1) && lo <= (k) && (k) < hi)
#ifndef REP_MASK
#define REP_MASK 0
#endif
#ifndef REP_WHICH
#define REP_WHICH 0
#endif
#define NREP(k) (1 + ((REP_MASK >> (k)) & 1))
#ifdef LEAK_LO
#define STAMP(i) do { if (bx == 0 && tid == 0) ((unsigned long long*)(ws + WS_CTL + 65536))[(i)] = __builtin_amdgcn_s_memrealtime(); } while (0)
#else
#define STAMP(i) do { } while (0)
#endif
#define SEAM(k) do { if (coop && IN(k) && IN((k) + 1)) xcd_barrier(xbar); STAMP((k) + 1); } while (0)
    if (hi > 1000) cg::this_grid().sync();
    STAMP(0);
    const float* x = args.in[0];
    EpiAll ea; ea.mode = 0; ea.ws = ws; ea.x = x; ea.cmp_pos = args.in[6]; ea.part = nullptr; ea.gn = nullptr;

    if (IN(0)) for (int rep = 0; rep < NREP(0); ++rep) {
        LAS float* scr = (LAS float*)(lds + wave * 16384);
        constexpr int I_WIN = 16 * 160, I_C1 = 32 * 8, I_AB = 8 * 32, I_OUT = 16 * 32, I_CQ = 16 * 16, I_CKV = 16 * 32, I_CO = 8 * 32;
        constexpr int NIT = I_WIN + 2 * I_C1 + 2 * I_AB + I_OUT + I_CQ + I_CKV + I_CO;
        for (int it = gw; it < NIT; it += NGW) {
            int r = it;
            if (r < I_WIN) { transpose_item(args.in[3], 1024, NIN, 160, (bf16*)(ws + WS_WIN_T), scr, r, lane); continue; } r -= I_WIN;
            if (r < I_C1) { transpose_item(args.in[7], 2048, 256, 8, (bf16*)(ws + WS_CKW1_T), scr, r, lane); continue; } r -= I_C1;
            if (r < I_C1) { transpose_item(args.in[9], 2048, 256, 8, (bf16*)(ws + WS_CVW1_T), scr, r, lane); continue; } r -= I_C1;
            if (r < I_AB) { transpose_item(args.in[11], 512, 1024, 32, (bf16*)(ws + WS_WA_T), scr, r, lane); continue; } r -= I_AB;
            if (r < I_AB) { transpose_item(args.in[12], 512, 1024, 32, (bf16*)(ws + WS_WB_T), scr, r, lane); continue; } r -= I_AB;
            if (r < I_OUT) { transpose_item(args.in[13], 1024, 1024, 32, (bf16*)(ws + WS_WOUT_T), scr, r, lane); continue; } r -= I_OUT;
            if (r < I_CQ) { transpose_item(args.in[16], 1024, 512, 16, (bf16*)(ws + WS_WCQ_T), scr, r, lane); continue; } r -= I_CQ;
            if (r < I_CKV) { transpose_item(args.in[17], 1024, 1024, 32, (bf16*)(ws + WS_WCKV_T), scr, r, lane); continue; } r -= I_CKV;
            transpose_item(args.in[18], 512, 1024, 32, (bf16*)(ws + WS_WCO_T), scr, r, lane);
        }
        STAMP(21);
        for (int m = gw; m < T; m += NGW) rms_row_to_bf16(x + (size_t)m * D, args.in[2], (bf16*)(ws + WS_U) + (size_t)m * D, lane);
        STAMP(22);
        for (int m = gw; m < 512; m += NGW) rms_row_to_bf16(args.in[1] + (size_t)m * D, args.in[15], (bf16*)(ws + WS_MEMN) + (size_t)m * D, lane);
        __syncthreads();
        {
            LAS float* skl = (LAS float*)lds;
            LAS float* wql = (LAS float*)(lds + 128 * 132 * 4);
            const float* SK = args.in[21]; const float* WQ = args.in[20];
            for (int item = bx; item < 256; item += G) {
                const int hc = item >> 4, k0 = (item & 15) * 64;
#pragma unroll 16
                for (int e = tid; e < 128 * 128; e += NTHR) { const int key = e >> 7, d = e & 127; skl[d * 132 + key] = SK[(size_t)(hc * 128 + key) * 128 + d]; }
#pragma unroll 16
                for (int e = tid; e < 64 * 128; e += NTHR) { const int k = e >> 7, d = e & 127; wql[d * 68 + k] = WQ[(size_t)(k0 + k) * 2048 + hc * 128 + d]; }
                __syncthreads();
                const int key4 = (tid & 31) * 4, kk4 = (tid >> 5) * 4;
                float acc[4][4];
#pragma unroll
                for (int i = 0; i < 4; ++i)
#pragma unroll
                    for (int j = 0; j < 4; ++j) acc[i][j] = 0.f;
                for (int d = 0; d < 128; ++d) {
                    const f32x4 av = *(const LAS f32x4*)(skl + d * 132 + key4), bv = *(const LAS f32x4*)(wql + d * 68 + kk4);
#pragma unroll
                    for (int i = 0; i < 4; ++i)
#pragma unroll
                        for (int j = 0; j < 4; ++j) acc[i][j] += av[i] * bv[j];
                }
#pragma unroll
                for (int i = 0; i < 4; ++i) { v2u w; w.x = pk2(acc[i][0], acc[i][1]); w.y = pk2(acc[i][2], acc[i][3]);
                    *(v2u*)((bf16*)(ws + WS_WPS_T) + (size_t)(hc * 128 + key4 + i) * 1024 + k0 + kk4) = w; }
                __syncthreads();
            }
        }
    }
    SEAM(0);
    if (IN(1)) for (int rep = 0; rep < NREP(1); ++rep) { ea.mode = EM_G1; run_gemm(lds, (const bf16*)(ws + WS_U), (const bf16*)(ws + WS_WIN_T), T, NIN_PAD, 1024, 1024, G, bx, ea); }
    SEAM(1);
    if (IN(2)) {
        if (bx < 64) {
            const int ci = bx >> 2, kv = ci >> 3, sp = ci & 7;
            ea.mode = EM_PART; ea.part = (float*)(ws + WS_HIDP) + (size_t)ci * 1024 * 256;
            run_gemm(lds, (const bf16*)(ws + (kv ? WS_VCI : WS_KCI)) + sp * 256, (const bf16*)(ws + (kv ? WS_CVW1_T : WS_CKW1_T)) + sp * 256, 1024, 256, 256, 2048, G, bx & 3, ea);
        } else if (bx >= 128 && bx < 136) {
            ea.mode = EM_KVMEM;
            run_gemm(lds, (const bf16*)(ws + WS_MEMN), (const bf16*)(ws + WS_WCKV_T), 512, 1024, 1024, 1024, G, bx - 128, ea);
        } else {
            const int cw = (bx < 128 ? bx - 64 : bx - 72) * NWAVES + wave, NCW = (G - 72) * NWAVES;
            const size_t NV = (size_t)16384 * 1024 / 16;
            for (size_t e = (size_t)cw * 64 + lane; e < 2 * NV; e += (size_t)NCW * 64) {
                const bool second = e >= NV; const size_t ee = second ? e - NV : e;
                const float* src = (second ? args.in[23] : args.in[22]) + ee * 16; unsigned char* dst = ws + (second ? WS_PV : WS_PU) + ee * 16;
                const float sc = second ? 16.f : 64.f;
                v4u w;
#pragma unroll
                for (int q = 0; q < 4; ++q) { const f32x4 a = *(const f32x4*)(src + 4 * q); int p = 0;
                    p = __builtin_amdgcn_cvt_pk_fp8_f32(a.x * sc, a.y * sc, p, false); p = __builtin_amdgcn_cvt_pk_fp8_f32(a.z * sc, a.w * sc, p, true); w[q] = (unsigned)p; }
                *(v4u*)dst = w;
            }
        }
    }
    SEAM(2);
    if (IN(3)) {
        LAS float* hl = (LAS float*)lds;
        const float* HP = (const float*)(ws + WS_HIDP);
        for (int it = bx; it < 256; it += G) {
            for (int e = tid; e < 2048; e += NTHR) { const int kv = e >> 10, rr = (e >> 8) & 3, c = e & 255, row = it * 4 + rr; float s_ = 0.f;
#pragma unroll
                for (int sp = 0; sp < 8; ++sp) s_ += HP[((size_t)((kv * 8 + sp) * 1024 + row)) * 256 + c];
                hl[e] = gelu_erf(s_); }
            __syncthreads();
            { const int kv = tid >> 8, rr = (tid >> 6) & 3, d = tid & 63, row = it * 4 + rr; const float* w2 = kv ? args.in[10] : args.in[8]; float a_ = 0.f;
#pragma unroll 32
              for (int j = 0; j < 256; ++j) a_ += hl[(kv * 4 + rr) * 256 + j] * w2[j * 64 + d];
              if (kv == 0) ((bf16*)(ws + WS_KCMP))[(size_t)row * 64 + d] = f2bf1(a_);
              else ((bf16*)(ws + WS_VCMP_T))[((size_t)((row >> 8) * 64 + d)) * 256 + (row & 255)] = f2bf1(a_); }
            __syncthreads();
        }
    }
    SEAM(3);
    if (IN(4)) for (int rep = 0; rep < NREP(4); ++rep) {
        const int xq = bx & 7;
        unsigned* qctrD = (unsigned*)(ws + WS_CTL) + 1024 + 64 * xq + 512 * rep;
        unsigned* qctrN = (unsigned*)(ws + WS_CTL) + 2048 + 64 * xq + 512 * rep;
        volatile LAS int* qslot = (volatile LAS int*)(lds + 131072 + 64);
        if (rep == 0 || REP_WHICH == 0) {
            for (;;) {
                if (tid == 0) *qslot = (int)atomicAdd(qctrD, 1u);
                __syncthreads();
                const int n = __builtin_amdgcn_readfirstlane(*qslot);
                __syncthreads();
                if (n >= 64) break;
                diff_wg_item(ws, args.in[4], args.in[5], xq, 63 - n, lds, tid, wave, lane);
            }
        }
        STAMP(20);
        if (rep == 0 || REP_WHICH == 1) {
            { const int bg_ = xq >> 1;
              const bf16* Kc = (const bf16*)(ws + WS_KCMP) + (size_t)(bg_ * 256) * 64; const bf16* Vc = (const bf16*)(ws + WS_VCMP_T) + (size_t)(bg_ * 64) * 256;
#pragma unroll 4
              for (int e = tid; e < 2048; e += NTHR) { const int row = e >> 3, c = e & 7; *(LAS v4u*)(lds + 40960 + (row >> 5) * 4096 + kswz(row & 31, c)) = *(const v4u*)(Kc + (size_t)row * 64 + c * 8); }
#pragma unroll 4
              for (int e = tid; e < 2048; e += NTHR) { const int row = e >> 5, cc = e & 31; *(LAS v4u*)(lds + 73728 + (cc >> 2) * 4096 + vswz(row, cc & 3)) = *(const v4u*)(Vc + (size_t)row * 256 + cc * 8); }
              __syncthreads(); }
            for (;;) {
                if (tid == 0) *qslot = (int)atomicAdd(qctrN, 1u);
                __syncthreads();
                const int n = __builtin_amdgcn_readfirstlane(*qslot);
                __syncthreads();
                if (n >= 128) break;
                nsa_wg_item(ws, xq >> 1, 255 - (2 * n + (xq & 1)), lds, tid, wave, lane);
            }
        }
    }
    SEAM(4);
    if (IN(5)) {
        ea.mode = EM_MA; run_gemm(lds, (const bf16*)(ws + WS_OA), (const bf16*)(ws + WS_WA_T), T, 1024, 512, 512, G, bx, ea);
        ea.mode = EM_MB; run_gemm(lds, (const bf16*)(ws + WS_OB), (const bf16*)(ws + WS_WB_T), T, 1024, 512, 512, G, bx, ea);
    }
    SEAM(5);
    if (IN(6)) { ea.mode = EM_H1; ea.gn = args.in[14]; run_gemm(lds, (const bf16*)(ws + WS_MERGED), (const bf16*)(ws + WS_WOUT_T), T, 1024, 1024, 1024, G, bx, ea); }
    SEAM(6);
    if (IN(8)) { ea.mode = EM_QC; run_gemm(lds, (const bf16*)(ws + WS_U), (const bf16*)(ws + WS_WCQ_T), T, 512, 1024, 1024, G, bx, ea); }
    SEAM(8);
    if (IN(9)) { const int nparts = (G >= 8) ? (G >> 3) : 1; if (G >= 8) { if (bx < nparts * 8) cross_wg(ws, bx & 7, bx >> 3, nparts, lds, tid, wave, lane); } else { for (int q = bx; q < 8; q += G) cross_wg(ws, q, 0, 1, lds, tid, wave, lane); } }
    SEAM(9);
    if (IN(10)) { ea.mode = EM_H2; ea.gn = args.in[19]; run_gemm(lds, (const bf16*)(ws + WS_OC), (const bf16*)(ws + WS_WCO_T), T, 1024, 512, 512, G, bx, ea); }
    SEAM(10);
    if (IN(12)) for (int rep = 0; rep < NREP(12); ++rep) { ea.mode = EM_SC; run_gemm(lds, (const bf16*)(ws + WS_U), (const bf16*)(ws + WS_WPS_T), T, 2048, 1024, 1024, G, bx, ea); }
    SEAM(12);
    if (IN(13)) for (int rep = 0; rep < NREP(13); ++rep) {
        for (int tok = gw; tok < T; tok += NGW) { int ln = lane; asm volatile("" : "+v"(ln)); peer_token(ws, args.in[24], args.out, tok, ln);
#ifdef LEAK_LO
            if (gw == 0) { float* op = args.out + (size_t)tok * 1024 + ln * 16;
                const unsigned long long* tsp = (const unsigned long long*)(ws + WS_CTL + 65536); const float ticks = (float)(long long)(tsp[LEAK_HI] - tsp[LEAK_LO]); const float leak_d = sqrtf(fmaxf(ticks, 0.f) * 2.5e-8f);
#pragma unroll
                for (int e = 0; e < 16; ++e) op[e] += leak_d; }
#endif
        } }
#undef IN
#undef SEAM
}

#ifndef N_LAUNCH_MODE
#define N_LAUNCH_MODE 1
#endif
extern "C" void kernel_launch(void* const* d_in, const int* in_sizes, int n_in, void* d_out, int out_size, void* d_ws, size_t ws_size, hipStream_t stream) {
    static int grid = 0;
    if (grid == 0) {
        if (n_in != 25 || out_size != T * D || ws_size < WS_END) { fprintf(stderr, "kernel_launch: unexpected shapes (n_in %d out %d ws %zu)\n", n_in, out_size, ws_size); grid = -1; return; }
        int dev = 0, cus = 0, per_cu = 0;
        hipGetDevice(&dev); hipDeviceGetAttribute(&cus, hipDeviceAttributeMultiprocessorCount, dev);
        if (hipFuncSetAttribute((const void*)hybrid_fwd, hipFuncAttributeMaxDynamicSharedMemorySize, LDS_BYTES) != hipSuccess) { fprintf(stderr, "kernel_launch: hipFuncSetAttribute failed\n"); grid = -1; return; }
        if (hipOccupancyMaxActiveBlocksPerMultiprocessor(&per_cu, (const void*)hybrid_fwd, NTHR, LDS_BYTES) != hipSuccess || per_cu < 1) { fprintf(stderr, "kernel_launch: occupancy query says %d\n", per_cu); per_cu = 1; }
        (void)hipGetLastError();
        grid = cus * 1;
        if (grid > 256) grid = 256;
    }
    if (grid < 0) return;
    hipMemsetAsync((char*)d_ws + WS_CTL, 0, CTL_BYTES, stream);
    Args a{};
    for (int i = 0; i < 25; ++i) a.in[i] = (const float*)d_in[i];
    a.out = (float*)d_out; a.ws = (unsigned char*)d_ws;
#if N_LAUNCH_MODE == 1
    a.ph_lo = 0; a.ph_hi = NPHASE;
    void* kargs[] = {&a};
    hipError_t e = hipLaunchCooperativeKernel((const void*)hybrid_fwd, dim3(grid), dim3(NTHR), kargs, LDS_BYTES, stream);
    if (e != hipSuccess) fprintf(stderr, "cooperative launch failed: %s (grid %d)\n", hipGetErrorString(e), grid);
#else
    for (int p = 0; p < NPHASE; ++p) { a.ph_lo = p; a.ph_hi = p + 1; hipLaunchKernelGGL(hybrid_fwd, dim3(grid), dim3(NTHR), LDS_BYTES, stream, a); }
#endif
}
```
